# Optimizing an MI355X kernel written in HIP

```python
import math
import jax, jax.numpy as jnp
from jax import lax
import numpy as np

D_MODEL = 1024
BATCH = 4
SEQ = 8192
DEPTH = 2

HEAD_DIM = 64
N_HEADS = D_MODEL // HEAD_DIM
N_KV_HEADS = 4
GRID_W = 64
NA_ROWS_MAX = 8
NA_COLS = 16
WINDOW = 128
BLOCK = 128
N_BUCKETS = 32
MAX_EXACT = 8
MAX_DISTANCE = 128
D_FF = 4 * D_MODEL
N_MIXERS = 2
N_A_LAYERS = (DEPTH + 1) // 2
N_B_LAYERS = DEPTH // 2
EPS = 1e-6

kernel_name = "hybrid_natten_swa_sqrelu_encoder"


def rms_norm(x, g):
    xf = x.astype(jnp.float32)
    y = xf * lax.rsqrt(jnp.mean(xf * xf, axis=-1, keepdims=True) + EPS)
    return (y * g.astype(jnp.float32)).astype(x.dtype)


def t5_bucket(rel):
    half = N_BUCKETS // 2
    rel = jnp.asarray(rel, dtype=jnp.int32)
    base = jnp.where(rel > 0, half, 0)
    n = jnp.abs(rel)
    nf = jnp.maximum(n, 1).astype(jnp.float32)
    large = MAX_EXACT + (jnp.log(nf / MAX_EXACT) / math.log(MAX_DISTANCE / MAX_EXACT)
                         * (half - MAX_EXACT)).astype(jnp.int32)
    large = jnp.minimum(large, half - 1)
    return base + jnp.where(n < MAX_EXACT, n, large)


def neighbourhood_attention(h, w_qkv, rpb, w_o):
    B, S, D = h.shape
    rows = S // GRID_W
    kr = min(NA_ROWS_MAX, rows)
    qkv = jnp.einsum('bsd,de->bse', h, w_qkv).reshape(B, rows, GRID_W, 3, N_HEADS, HEAD_DIM)
    q = qkv[..., 0, :, :] * (HEAD_DIM ** -0.5)
    k = qkv[..., 1, :, :]
    v = qkv[..., 2, :, :]
    cols = np.arange(GRID_W)
    col_start = np.clip(cols - NA_COLS // 2, 0, GRID_W - NA_COLS)
    col_idx = col_start[:, None] + np.arange(NA_COLS)[None, :]
    dc = col_idx - cols[:, None] + (NA_COLS - 1)
    rpb_c = rpb[:, :, dc]

    def row_block(args):
        r, q_r = args
        rs = jnp.clip(r - kr // 2, 0, rows - kr)
        k_rows = lax.dynamic_slice_in_dim(k, rs, kr, axis=1)
        v_rows = lax.dynamic_slice_in_dim(v, rs, kr, axis=1)
        k_win = k_rows[:, :, col_idx]
        v_win = v_rows[:, :, col_idx]
        s = jnp.einsum('bchd,brckhd->bhcrk', q_r, k_win).astype(jnp.float32)
        dr = rs + jnp.arange(kr) - r + (NA_ROWS_MAX - 1)
        bias = jnp.transpose(rpb_c[:, dr], (0, 2, 1, 3))
        s = s + bias[None].astype(jnp.float32)
        p = jax.nn.softmax(s.reshape(B, N_HEADS, GRID_W, kr * NA_COLS), axis=-1)
        p = p.reshape(B, N_HEADS, GRID_W, kr, NA_COLS).astype(v.dtype)
        return jnp.einsum('bhcrk,brckhd->bchd', p, v_win)

    q_rows = jnp.moveaxis(q, 1, 0)
    o = lax.map(row_block, (jnp.arange(rows), q_rows))
    o = jnp.moveaxis(o, 0, 1).reshape(B, S, D)
    return jnp.einsum('bsd,de->bse', o, w_o)


def sliding_window_gqa(h, w_qkv, sinks, rel_table, w_o):
    B, S, D = h.shape
    nb = S // BLOCK
    G = N_HEADS // N_KV_HEADS
    kvd = N_KV_HEADS * HEAD_DIM
    qkv = jnp.einsum('bsd,de->bse', h, w_qkv)
    q = qkv[..., :D].reshape(B, nb, BLOCK, N_KV_HEADS, G, HEAD_DIM) * (HEAD_DIM ** -0.5)
    k = qkv[..., D:D + kvd].reshape(B, S, N_KV_HEADS, HEAD_DIM)
    v = qkv[..., D + kvd:].reshape(B, S, N_KV_HEADS, HEAD_DIM)

    def band(t):
        tp = jnp.pad(t, ((0, 0), (BLOCK, BLOCK), (0, 0), (0, 0)))
        tp = tp.reshape(B, nb + 2, BLOCK, N_KV_HEADS, HEAD_DIM)
        return jnp.concatenate([tp[:, :-2], tp[:, 1:-1], tp[:, 2:]], axis=2)

    kb, vb = band(k), band(v)
    s = jnp.einsum('bnqhgd,bnjhd->bhgnqj', q, kb).astype(jnp.float32)
    rel = (np.arange(3 * BLOCK) - BLOCK)[None, :] - np.arange(BLOCK)[:, None]
    key_pos = np.arange(nb)[:, None] * BLOCK + np.arange(3 * BLOCK)[None, :] - BLOCK
    mask = (np.abs(rel) <= WINDOW)[None] & ((key_pos >= 0) & (key_pos < S))[:, None, :]
    bias = jnp.transpose(rel_table[t5_bucket(rel)], (2, 0, 1)).astype(jnp.float32)
    bias = bias.reshape(N_KV_HEADS, G, 1, BLOCK, 3 * BLOCK)
    s = jnp.where(jnp.asarray(mask), s + bias, jnp.finfo(jnp.float32).min)
    sink = sinks.astype(jnp.float32).reshape(1, N_KV_HEADS, G, 1, 1, 1)
    m = jnp.maximum(jnp.max(s, axis=-1, keepdims=True), sink)
    p = jnp.exp(s - m)
    p = p / (jnp.sum(p, axis=-1, keepdims=True) + jnp.exp(sink - m))
    o = jnp.einsum('bhgnqj,bnjhd->bnqhgd', p.astype(v.dtype), vb).reshape(B, S, D)
    return jnp.einsum('bsd,de->bse', o, w_o)


def squared_relu_mlp(h, w_in, w_out):
    u = jnp.square(jax.nn.relu(jnp.einsum('bsd,df->bsf', h, w_in)))
    return jnp.einsum('bsf,fd->bsd', u, w_out)


def setup_inputs(seed: int = 0) -> dict:
    key = jax.random.key(seed)
    ks = jax.random.split(key, 14)
    f32 = jnp.float32
    D = D_MODEL
    kvd = N_KV_HEADS * HEAD_DIM
    res_scale = (2 * DEPTH) ** -0.5
    return {
        "x": jax.random.normal(ks[0], (BATCH, SEQ, D), f32),
        "mix_norm": 1.0 + 0.01 * jax.random.normal(ks[1], (DEPTH, D), f32),
        "mlp_norm": 1.0 + 0.01 * jax.random.normal(ks[2], (DEPTH, D), f32),
        "final_norm": 1.0 + 0.01 * jax.random.normal(ks[3], (D,), f32),
        "na_w_qkv": jax.random.normal(ks[4], (N_A_LAYERS, D, 3 * D), f32) * D ** -0.5,
        "na_rpb": 0.1 * jax.random.normal(ks[5], (N_A_LAYERS, N_HEADS, 2 * NA_ROWS_MAX - 1, 2 * NA_COLS - 1), f32),
        "na_w_o": jax.random.normal(ks[6], (N_A_LAYERS, D, D), f32) * D ** -0.5 * res_scale,
        "swa_w_qkv": jax.random.normal(ks[7], (N_B_LAYERS, D, D + 2 * kvd), f32) * D ** -0.5,
        "swa_sinks": 0.5 * jax.random.normal(ks[8], (N_B_LAYERS, N_HEADS), f32),
        "swa_w_o": jax.random.normal(ks[9], (N_B_LAYERS, D, D), f32) * D ** -0.5 * res_scale,
        "t5_rel_table": 0.1 * jax.random.normal(ks[10], (N_BUCKETS, N_HEADS), f32),
        "mlp_w_in": jax.random.normal(ks[11], (DEPTH, D, D_FF), f32) * D ** -0.5,
        "mlp_w_out": jax.random.normal(ks[12], (DEPTH, D_FF, D), f32) * D_FF ** -0.5 * res_scale,
    }


def reference(x, mix_norm, mlp_norm, final_norm, na_w_qkv, na_rpb, na_w_o,
              swa_w_qkv, swa_sinks, swa_w_o, t5_rel_table, mlp_w_in, mlp_w_out):
    for i in range(DEPTH):
        j = i // N_MIXERS
        h = rms_norm(x, mix_norm[i])
        if i % N_MIXERS == 0:
            x = x + neighbourhood_attention(h, na_w_qkv[j], na_rpb[j], na_w_o[j])
        else:
            x = x + sliding_window_gqa(h, swa_w_qkv[j], swa_sinks[j], t5_rel_table, swa_w_o[j])
        h = rms_norm(x, mlp_norm[i])
        x = x + squared_relu_mlp(h, mlp_w_in[i], mlp_w_out[i])
    return rms_norm(x, final_norm)
```

```cpp
#include <hip/hip_runtime.h>
#include <cstdint>
#include <cstdio>

typedef unsigned short bf16;
constexpr int BATCH = 4, SEQ = 8192, D = 1024, NH = 16, HD = 64, KVH = 4, FF = 4096, M = BATCH * SEQ;
constexpr int GW = 64, ROWS = SEQ / GW, KR = 8, KC = 16, WINDOW = 128;
constexpr float EPS = 1e-6f, LOG2E = 1.4426950408889634f, C2 = 0.125f * LOG2E;
constexpr size_t MiB = 1u << 20;
constexpr size_t WS_CTL = 0, WS_SSQ = 1 * MiB, WS_TBL = 3 * MiB;
constexpr size_t WS_WQKV0 = 4 * MiB, WS_WO0 = 10 * MiB, WS_WIN0 = 12 * MiB, WS_WOUT0 = 20 * MiB, WS_WQKV1 = 28 * MiB, WS_WO1 = 31 * MiB, WS_WIN1 = 33 * MiB, WS_WOUT1 = 41 * MiB;
constexpr size_t WS_XB = 64 * MiB, WS_Q = 128 * MiB, WS_K = 192 * MiB, WS_V = 256 * MiB, WS_H = 128 * MiB, WS_END = 384 * MiB;

__device__ __forceinline__ unsigned f2bf(float f) { unsigned u = __builtin_bit_cast(unsigned, f); return (u + 0x7fffu + ((u >> 16) & 1u)) >> 16; }
__device__ __forceinline__ float bf2f(bf16 b) { return __builtin_bit_cast(float, (unsigned)b << 16); }
__device__ __forceinline__ float wave_sum(float v) {
#pragma unroll
    for (int o = 1; o < 64; o <<= 1) v += __shfl_xor(v, o);
    return v;
}
__device__ __forceinline__ float row_rstd(const float* ssq, int row) {
    const float4* p = (const float4*)(ssq + (size_t)row * 16);
    float4 a = p[0], b = p[1], c = p[2], d = p[3];
    float s = ((a.x + a.y) + (a.z + a.w)) + ((b.x + b.y) + (b.z + b.w)) + ((c.x + c.y) + (c.z + c.w)) + ((d.x + d.y) + (d.z + d.w));
    return 1.0f / sqrtf(s * (1.0f / D) + EPS);
}

__global__ void k_wt(const float* __restrict__ W, const float* __restrict__ g, bf16* __restrict__ Wt, int K, int N) {
    __shared__ float tile[32][33];
    const int n0 = blockIdx.x * 32, k0 = blockIdx.y * 32, tx = threadIdx.x, ty = threadIdx.y;
    for (int i = 0; i < 4; ++i) { const int k = k0 + ty + 8 * i; tile[ty + 8 * i][tx] = W[(size_t)k * N + n0 + tx] * (g ? g[k] : 1.0f); }
    __syncthreads();
    for (int i = 0; i < 4; ++i) { const int n = n0 + ty + 8 * i; Wt[(size_t)n * K + k0 + tx] = (bf16)f2bf(tile[tx][ty + 8 * i]); }
}
__global__ void k_xprep(const float* __restrict__ x, bf16* __restrict__ xb, float* __restrict__ ssq) {
    const int row = blockIdx.x * 4 + (threadIdx.x >> 6), lane = threadIdx.x & 63;
    const float4* xr = (const float4*)(x + (size_t)row * D);
    float s = 0.f;
    for (int j = 0; j < 4; ++j) { float4 v = xr[lane + 64 * j]; s += v.x * v.x + v.y * v.y + v.z * v.z + v.w * v.w;
        uint2 o; o.x = f2bf(v.x) | (f2bf(v.y) << 16); o.y = f2bf(v.z) | (f2bf(v.w) << 16); ((uint2*)(xb + (size_t)row * D))[lane + 64 * j] = o; }
    s = wave_sum(s);
    if (lane < 16) ssq[(size_t)row * 16 + lane] = lane == 0 ? s : 0.f;
}
__global__ void k_ssq(const float* __restrict__ x, float* __restrict__ ssq) {
    const int row = blockIdx.x * 4 + (threadIdx.x >> 6), lane = threadIdx.x & 63;
    const float4* xr = (const float4*)(x + (size_t)row * D);
    float s = 0.f;
    for (int j = 0; j < 4; ++j) { float4 v = xr[lane + 64 * j]; s += v.x * v.x + v.y * v.y + v.z * v.z + v.w * v.w; }
    s = wave_sum(s);
    if (lane < 16) ssq[(size_t)row * 16 + lane] = lane == 0 ? s : 0.f;
}
__global__ void k_final(float* __restrict__ x, const float* __restrict__ ssq, const float* __restrict__ g) {
    const int row = blockIdx.x * 4 + (threadIdx.x >> 6), lane = threadIdx.x & 63;
    const float r = row_rstd(ssq, row);
    float4* xr = (float4*)(x + (size_t)row * D); const float4* gr = (const float4*)g;
    for (int j = 0; j < 4; ++j) { float4 v = xr[lane + 64 * j], gg = gr[lane + 64 * j]; v.x *= r * gg.x; v.y *= r * gg.y; v.z *= r * gg.z; v.w *= r * gg.w; xr[lane + 64 * j] = v; }
}
__global__ void k_tbl(const float* __restrict__ rel_table, const float* __restrict__ sinks, float* __restrict__ tbl) {
    const int i = blockIdx.x * blockDim.x + threadIdx.x;
    if (i < 16 * 257) { const int h = i / 257, rel = i % 257 - 128; const int n = rel < 0 ? -rel : rel; int bk;
        if (n < 8) bk = n; else { const int k = (31 - __clz(n * n)) - 6; bk = 8 + (k < 7 ? k : 7); }
        if (rel > 0) bk += 16;
        tbl[i] = rel_table[bk * 16 + h] * LOG2E; }
    else if (i < 16 * 257 + 16) tbl[i] = sinks[i - 16 * 257] * LOG2E;
}

struct NEpiQKV { bf16 *Q, *Kp, *V; int kvw, pad; const float* ssq;
    __device__ float rowscale(int row) const { return row_rstd(ssq, row); }
    __device__ void operator()(int row, int col, float v) const {
        if (col < D) Q[(size_t)row * D + col] = (bf16)f2bf(v * C2);
        else if (col < D + kvw) Kp[(size_t)row * kvw + col - D] = (bf16)f2bf(v);
        else V[(size_t)row * kvw + col - D - kvw] = (bf16)f2bf(v); } };
struct NEpiRes { const float* base; float* out; bf16* xb;
    __device__ float rowscale(int) const { return 1.f; }
    __device__ void operator()(int row, int col, float v) const { const size_t o = (size_t)row * D + col; const float xn = base[o] + v; out[o] = xn; xb[o] = (bf16)f2bf(xn); } };
struct NEpiUp { bf16* Hh; const float* ssq;
    __device__ float rowscale(int row) const { return row_rstd(ssq, row); }
    __device__ void operator()(int row, int col, float v) const { const float r = v > 0.f ? v : 0.f; Hh[(size_t)row * FF + col] = (bf16)f2bf(r * r); } };

template <class Epi> __global__ void __launch_bounds__(256) k_gemm(const bf16* __restrict__ A, const bf16* __restrict__ Bt, int N, int K, Epi epi) {
    __shared__ float As[32][68], Bs[32][68];
    const int t = threadIdx.x, m0 = blockIdx.y * 64, n0 = blockIdx.x * 64, ty = t >> 4, tx = t & 15;
    const int lr = t >> 2, lk = (t & 3) * 8;
    float acc[4][4] = {};
    for (int k0 = 0; k0 < K; k0 += 32) {
        const uint4 av = *(const uint4*)(A + (size_t)(m0 + lr) * K + k0 + lk), bv = *(const uint4*)(Bt + (size_t)(n0 + lr) * K + k0 + lk);
        const unsigned aw[4] = {av.x, av.y, av.z, av.w}, bw[4] = {bv.x, bv.y, bv.z, bv.w};
        __syncthreads();
        for (int i = 0; i < 4; ++i) { As[lk + 2 * i][lr] = __builtin_bit_cast(float, aw[i] << 16); As[lk + 2 * i + 1][lr] = __builtin_bit_cast(float, aw[i] & 0xffff0000u);
                                      Bs[lk + 2 * i][lr] = __builtin_bit_cast(float, bw[i] << 16); Bs[lk + 2 * i + 1][lr] = __builtin_bit_cast(float, bw[i] & 0xffff0000u); }
        __syncthreads();
#pragma unroll 8
        for (int k = 0; k < 32; ++k) { const float4 a = *(const float4*)&As[k][ty * 4], b = *(const float4*)&Bs[k][tx * 4];
            const float aa[4] = {a.x, a.y, a.z, a.w}, bb[4] = {b.x, b.y, b.z, b.w};
#pragma unroll
            for (int i = 0; i < 4; ++i)
#pragma unroll
                for (int j = 0; j < 4; ++j) acc[i][j] += aa[i] * bb[j]; }
    }
    for (int i = 0; i < 4; ++i) { const int row = m0 + ty * 4 + i; const float rs = epi.rowscale(row);
        for (int j = 0; j < 4; ++j) epi(row, n0 + tx * 4 + j, acc[i][j] * rs); }
}

__global__ void __launch_bounds__(128) k_na(const bf16* __restrict__ Q, const bf16* __restrict__ Kp, const bf16* __restrict__ V, const float* __restrict__ rpb, bf16* __restrict__ O) {
    __shared__ float q[64], p[128], red[4], part[128];
    const int m = blockIdx.x >> 4, h = blockIdx.x & 15, t = threadIdx.x;
    const int b = m / SEQ, s = m % SEQ, r = s / GW, c = s % GW;
    int rs = r - KR / 2; rs = rs < 0 ? 0 : (rs > ROWS - KR ? ROWS - KR : rs);
    int cs = c - KC / 2; cs = cs < 0 ? 0 : (cs > GW - KC ? GW - KC : cs);
    if (t < 64) q[t] = bf2f(Q[(size_t)m * D + h * HD + t]);
    __syncthreads();
    const int i = t >> 4, j = t & 15;
    const int km = b * SEQ + (rs + i) * GW + cs + j;
    const bf16* kp = Kp + (size_t)km * D + h * HD;
    float sc = 0.f;
    for (int d = 0; d < 64; ++d) sc += q[d] * bf2f(kp[d]);
    sc += rpb[(h * 15 + (rs + i - r + 7)) * 31 + (cs + j - c + 15)] * LOG2E;
    float mx = sc;
    for (int o = 1; o < 64; o <<= 1) mx = fmaxf(mx, __shfl_xor(mx, o));
    if ((t & 63) == 0) red[t >> 6] = mx;
    __syncthreads();
    mx = fmaxf(red[0], red[1]);
    const float pe = exp2f(sc - mx);
    p[t] = pe;
    float sm = wave_sum(pe);
    if ((t & 63) == 0) red[2 + (t >> 6)] = sm;
    __syncthreads();
    sm = red[2] + red[3];
    const int d = t & 63, hf = t >> 6;
    float o = 0.f;
    for (int kk = 0; kk < 64; ++kk) { const int k2 = hf * 64 + kk; const int km2 = b * SEQ + (rs + (k2 >> 4)) * GW + cs + (k2 & 15);
        o += p[k2] * bf2f(V[(size_t)km2 * D + h * HD + d]); }
    part[t] = o;
    __syncthreads();
    if (t < 64) O[(size_t)m * D + h * HD + t] = (bf16)f2bf((part[t] + part[t + 64]) / sm);
}
__global__ void __launch_bounds__(320) k_swa(const bf16* __restrict__ Q, const bf16* __restrict__ Kp, const bf16* __restrict__ V, const float* __restrict__ tbl, bf16* __restrict__ O) {
    __shared__ float q[64], p[320], red[16], part[320];
    const int m = blockIdx.x >> 4, h = blockIdx.x & 15, t = threadIdx.x, kv = h >> 2;
    const int b = m / SEQ, s = m % SEQ;
    if (t < 64) q[t] = bf2f(Q[(size_t)m * D + h * HD + t]);
    __syncthreads();
    const int pos = s - WINDOW + t; const bool valid = t < 257 && pos >= 0 && pos < SEQ;
    float sc = -INFINITY;
    if (valid) { const bf16* kp = Kp + (size_t)(b * SEQ + pos) * 256 + kv * HD; sc = 0.f;
        for (int d = 0; d < 64; ++d) sc += q[d] * bf2f(kp[d]);
        sc += tbl[h * 257 + t]; }
    const float sink2 = tbl[16 * 257 + h];
    float mx = sc;
    for (int o = 1; o < 64; o <<= 1) mx = fmaxf(mx, __shfl_xor(mx, o));
    if ((t & 63) == 0) red[t >> 6] = mx;
    __syncthreads();
    mx = sink2; for (int w = 0; w < 5; ++w) mx = fmaxf(mx, red[w]);
    const float pe = valid ? exp2f(sc - mx) : 0.f;
    p[t] = pe;
    float sm = wave_sum(pe);
    if ((t & 63) == 0) red[8 + (t >> 6)] = sm;
    __syncthreads();
    sm = exp2f(sink2 - mx); for (int w = 0; w < 5; ++w) sm += red[8 + w];
    const int d = t & 63, g = t >> 6;
    float o = 0.f;
    for (int kk = 0; kk < 64; ++kk) { const int k2 = g * 64 + kk; const int pos2 = s - WINDOW + k2;
        if (k2 < 257 && pos2 >= 0 && pos2 < SEQ) o += p[k2] * bf2f(V[(size_t)(b * SEQ + pos2) * 256 + kv * HD + d]); }
    part[t] = o;
    __syncthreads();
    if (t < 64) O[(size_t)m * D + h * HD + t] = (bf16)f2bf((part[t] + part[t + 64] + part[t + 128] + part[t + 192] + part[t + 256]) / sm);
}

extern "C" void kernel_launch(void* const* d_in, const int* in_sizes, int n_in, void* d_out, int out_size, void* d_ws, size_t ws_size, hipStream_t stream) {
    if (n_in != 13 || in_sizes[0] != M * D || out_size != M * D || ws_size < WS_END) { fprintf(stderr, "kernel_launch: unexpected shapes (n_in %d in0 %d out %d ws %zu)\n", n_in, n_in > 0 ? in_sizes[0] : -1, out_size, ws_size); return; }
    const float* x = (const float*)d_in[0]; const float* mix_norm = (const float*)d_in[1]; const float* mlp_norm = (const float*)d_in[2]; const float* final_norm = (const float*)d_in[3];
    const float* na_w_qkv = (const float*)d_in[4]; const float* na_rpb = (const float*)d_in[5]; const float* na_w_o = (const float*)d_in[6];
    const float* swa_w_qkv = (const float*)d_in[7]; const float* swa_sinks = (const float*)d_in[8]; const float* swa_w_o = (const float*)d_in[9];
    const float* t5 = (const float*)d_in[10]; const float* w_in = (const float*)d_in[11]; const float* w_out = (const float*)d_in[12];
    unsigned char* ws = (unsigned char*)d_ws; float* out = (float*)d_out;
    float* ssq = (float*)(ws + WS_SSQ); float* tbl = (float*)(ws + WS_TBL);
    bf16 *Wqkv0 = (bf16*)(ws + WS_WQKV0), *Wo0 = (bf16*)(ws + WS_WO0), *Win0 = (bf16*)(ws + WS_WIN0), *Wout0 = (bf16*)(ws + WS_WOUT0);
    bf16 *Wqkv1 = (bf16*)(ws + WS_WQKV1), *Wo1 = (bf16*)(ws + WS_WO1), *Win1 = (bf16*)(ws + WS_WIN1), *Wout1 = (bf16*)(ws + WS_WOUT1);
    bf16 *XB = (bf16*)(ws + WS_XB), *Qb = (bf16*)(ws + WS_Q), *Kb = (bf16*)(ws + WS_K), *Vb = (bf16*)(ws + WS_V), *Hb = (bf16*)(ws + WS_H);
    const dim3 tb(32, 8);
    k_wt<<<dim3(3072 / 32, D / 32), tb, 0, stream>>>(na_w_qkv, mix_norm, Wqkv0, D, 3072);
    k_wt<<<dim3(D / 32, D / 32), tb, 0, stream>>>(na_w_o, nullptr, Wo0, D, D);
    k_wt<<<dim3(FF / 32, D / 32), tb, 0, stream>>>(w_in, mlp_norm, Win0, D, FF);
    k_wt<<<dim3(D / 32, FF / 32), tb, 0, stream>>>(w_out, nullptr, Wout0, FF, D);
    k_wt<<<dim3(1536 / 32, D / 32), tb, 0, stream>>>(swa_w_qkv, mix_norm + D, Wqkv1, D, 1536);
    k_wt<<<dim3(D / 32, D / 32), tb, 0, stream>>>(swa_w_o, nullptr, Wo1, D, D);
    k_wt<<<dim3(FF / 32, D / 32), tb, 0, stream>>>(w_in + (size_t)D * FF, mlp_norm + D, Win1, D, FF);
    k_wt<<<dim3(D / 32, FF / 32), tb, 0, stream>>>(w_out + (size_t)D * FF, nullptr, Wout1, FF, D);
    k_tbl<<<(16 * 257 + 16 + 255) / 256, 256, 0, stream>>>(t5, swa_sinks, tbl);
    k_xprep<<<M / 4, 256, 0, stream>>>(x, XB, ssq);
    k_gemm<NEpiQKV><<<dim3(3072 / 64, M / 64), 256, 0, stream>>>(XB, Wqkv0, 3072, D, NEpiQKV{Qb, Kb, Vb, D, 0, ssq});
    k_na<<<M * NH, 128, 0, stream>>>(Qb, Kb, Vb, na_rpb, Qb);
    k_gemm<NEpiRes><<<dim3(D / 64, M / 64), 256, 0, stream>>>(Qb, Wo0, D, D, NEpiRes{x, out, XB});
    k_ssq<<<M / 4, 256, 0, stream>>>(out, ssq);
    k_gemm<NEpiUp><<<dim3(FF / 64, M / 64), 256, 0, stream>>>(XB, Win0, FF, D, NEpiUp{Hb, ssq});
    k_gemm<NEpiRes><<<dim3(D / 64, M / 64), 256, 0, stream>>>(Hb, Wout0, D, FF, NEpiRes{out, out, XB});
    k_ssq<<<M / 4, 256, 0, stream>>>(out, ssq);
    k_gemm<NEpiQKV><<<dim3(1536 / 64, M / 64), 256, 0, stream>>>(XB, Wqkv1, 1536, D, NEpiQKV{Qb, Kb, Vb, 256, 0, ssq});
    k_swa<<<M * NH, 320, 0, stream>>>(Qb, Kb, Vb, tbl, Qb);
    k_gemm<NEpiRes><<<dim3(D / 64, M / 64), 256, 0, stream>>>(Qb, Wo1, D, D, NEpiRes{out, out, XB});
    k_ssq<<<M / 4, 256, 0, stream>>>(out, ssq);
    k_gemm<NEpiUp><<<dim3(FF / 64, M / 64), 256, 0, stream>>>(XB, Win1, FF, D, NEpiUp{Hb, ssq});
    k_gemm<NEpiRes><<<dim3(D / 64, M / 64), 256, 0, stream>>>(Hb, Wout1, D, FF, NEpiRes{out, out, XB});
    k_ssq<<<M / 4, 256, 0, stream>>>(out, ssq);
    k_final<<<M / 4, 256, 0, stream>>>(out, ssq, final_norm);
}
```

```cpp
#include <hip/hip_runtime.h>
#include <cstdint>
#include <cstdio>

typedef unsigned short bf16;
constexpr int BATCH = 4, SEQ = 8192, D = 1024, NH = 16, HD = 64, KVH = 4, FF = 4096, M = BATCH * SEQ;
constexpr int GW = 64, ROWS = SEQ / GW, KR = 8, KC = 16, WINDOW = 128;
constexpr float EPS = 1e-6f, LOG2E = 1.4426950408889634f, C2 = 0.125f * LOG2E;
constexpr size_t MiB = 1u << 20;
constexpr size_t WS_CTL = 0, WS_SSQ = 1 * MiB, WS_TBL = 3 * MiB;
constexpr size_t WS_WQKV0 = 4 * MiB, WS_WO0 = 10 * MiB, WS_WIN0 = 12 * MiB, WS_WOUT0 = 20 * MiB, WS_WQKV1 = 28 * MiB, WS_WO1 = 31 * MiB, WS_WIN1 = 33 * MiB, WS_WOUT1 = 41 * MiB;
constexpr size_t WS_XB = 64 * MiB, WS_Q = 128 * MiB, WS_K = 192 * MiB, WS_V = 256 * MiB, WS_H = 128 * MiB, WS_END = 384 * MiB;

__device__ __forceinline__ unsigned f2bf(float f) { unsigned u = __builtin_bit_cast(unsigned, f); return (u + 0x7fffu + ((u >> 16) & 1u)) >> 16; }
__device__ __forceinline__ float bf2f(bf16 b) { return __builtin_bit_cast(float, (unsigned)b << 16); }
__device__ __forceinline__ float wave_sum(float v) {
#pragma unroll
    for (int o = 1; o < 64; o <<= 1) v += __shfl_xor(v, o);
    return v;
}
__device__ __forceinline__ float row_rstd(const float* ssq, int row) {
    const float4* p = (const float4*)(ssq + (size_t)row * 16);
    float4 a = p[0], b = p[1], c = p[2], d = p[3];
    float s = ((a.x + a.y) + (a.z + a.w)) + ((b.x + b.y) + (b.z + b.w)) + ((c.x + c.y) + (c.z + c.w)) + ((d.x + d.y) + (d.z + d.w));
    return 1.0f / sqrtf(s * (1.0f / D) + EPS);
}


namespace pg8 {
#define PG8_LAS __attribute__((address_space(3)))
typedef unsigned short bf16_t;
typedef short bf16x8 __attribute__((ext_vector_type(8)));
typedef float f32x4 __attribute__((ext_vector_type(4)));
typedef unsigned u32x4 __attribute__((ext_vector_type(4)));
constexpr int BM = 256, BK = 64, HALF = 128, HTB = HALF * BK * 2  , STAGE_BYTES = 8 * HTB, NXCD = 8, WGM = 8;

__host__ __device__ __forceinline__ int lds_byte(int r, int c) { const int st = (r >> 4) * 2 + (c >> 5), rr = r & 15, cc = c & 31, ob = rr * 64 + cc * 2; return st * 1024 + (ob ^ (((ob >> 9) & 1) << 5)); }
__host__ __device__ __forceinline__ void stage_rc(int b, int& R, int& C) { const int st = b / 1024, sb = b % 1024, swz = sb ^ (((sb >> 9) & 1) << 5); R = (st >> 1) * 16 + swz / 64; C = (st & 1) * 32 + (swz % 64) / 2; }
__host__ __device__ __forceinline__ int perm32(int rho) { const int n = rho >> 4, i = rho & 15; return 8 * (i >> 2) + 4 * n + (i & 3); }

struct Unit { int pm, pn; };
struct Gemm { const bf16_t* A; const bf16_t* Bt; int M, N, K; };

struct StaticOrder {
    int nM, nN, nwg, G, c;
    __host__ __device__ void init(int M, int N, int G_, int c_) { nM = M / BM; nN = N / BM; nwg = nM * nN; G = G_; c = c_; }
    __host__ __device__ bool next(int i, Unit& u) const {
        const long L = (long)i * G + c; if (L >= nwg) return false;
        int wgid = (int)L; { const int q = nwg / NXCD, r = nwg % NXCD, xcd = wgid % NXCD, off = wgid / NXCD; wgid = (xcd < r ? xcd * (q + 1) : r * (q + 1) + (xcd - r) * q) + off; }
        const int nig = WGM * nN, gid = wgid / nig, fm = gid * WGM, gsz = (nM - fm) < WGM ? (nM - fm) : WGM;
        u.pm = fm + ((wgid % nig) % gsz); u.pn = (wgid % nig) / gsz; return true;
    }
    __device__ __forceinline__ void a_ready(const Unit&) const {}
    __device__ __forceinline__ void done(const Unit&) const {}
};

__device__ __forceinline__ unsigned cvt_pk_bf16(float lo, float hi) { unsigned r; asm volatile("v_cvt_pk_bf16_f32 %0, %1, %2" : "=v"(r) : "v"(lo), "v"(hi)); return r; }
typedef float f32x2 __attribute__((ext_vector_type(2)));
__device__ __forceinline__ float rstd16(const float* ssq, int row) {
    const f32x4* p = (const f32x4*)(ssq + (size_t)row * 16);
    const f32x4 a = p[0], b = p[1], c = p[2], d = p[3];
    const float s = (((a[0] + a[1]) + (a[2] + a[3])) + ((b[0] + b[1]) + (b[2] + b[3]))) + (((c[0] + c[1]) + (c[2] + c[3])) + ((d[0] + d[1]) + (d[2] + d[3])));
    return __builtin_amdgcn_rsqf(s * (1.0f / 1024.0f) + 1e-6f);
}
struct EpiQKV {
    static constexpr bool PERM = true, AFTER_DRAIN = false;
    bf16_t *Q, *Kp, *V; int kvw; float qscale; const float* ssq;
    __device__ __forceinline__ void operator()(const f32x4 (&acc)[2][2][4][2], const Unit& u, int wr, int wc, int fr, int fq) const {
        int colt = u.pn * BM; bf16_t* base; int ld; float sc = 1.f;
        if (colt < 1024) { base = Q; ld = 1024; sc = qscale; } else if (colt < 1024 + kvw) { base = Kp; ld = kvw; colt -= 1024; } else { base = V; ld = kvw; colt -= 1024 + kvw; }
        const int col0 = colt + wc * 32 + 8 * fq, row0 = u.pm * BM + wr * 64 + fr;
#pragma unroll
        for (int ai = 0; ai < 2; ++ai)
#pragma unroll
            for (int m = 0; m < 4; ++m) { const int row = row0 + ai * HALF + m * 16; const float rs = rstd16(ssq, row) * sc; bf16_t* rowp = base + (size_t)row * ld + col0;
#pragma unroll
                for (int bj = 0; bj < 2; ++bj) { const f32x4 v0 = acc[ai][bj][m][0] * rs, v1 = acc[ai][bj][m][1] * rs;
                    u32x4 w; w.x = cvt_pk_bf16(v0[0], v0[1]); w.y = cvt_pk_bf16(v0[2], v0[3]); w.z = cvt_pk_bf16(v1[0], v1[1]); w.w = cvt_pk_bf16(v1[2], v1[3]);
                    *(u32x4*)(rowp + bj * HALF) = w; } }
    }
};
struct EpiUp {
    static constexpr bool PERM = true, AFTER_DRAIN = false;
    bf16_t* Hh; const float* ssq;
    __device__ __forceinline__ void operator()(const f32x4 (&acc)[2][2][4][2], const Unit& u, int wr, int wc, int fr, int fq) const {
        const int col0 = u.pn * BM + wc * 32 + 8 * fq, row0 = u.pm * BM + wr * 64 + fr;
#pragma unroll
        for (int ai = 0; ai < 2; ++ai)
#pragma unroll
            for (int m = 0; m < 4; ++m) { const int row = row0 + ai * HALF + m * 16; const float rs = rstd16(ssq, row); bf16_t* rowp = Hh + (size_t)row * 4096 + col0;
#pragma unroll
                for (int bj = 0; bj < 2; ++bj) { f32x4 v0 = acc[ai][bj][m][0] * rs, v1 = acc[ai][bj][m][1] * rs;
#pragma unroll
                    for (int e = 0; e < 4; ++e) { const float a = __builtin_fmaxf(v0[e], 0.f), b = __builtin_fmaxf(v1[e], 0.f); v0[e] = a * a; v1[e] = b * b; }
                    u32x4 w; w.x = cvt_pk_bf16(v0[0], v0[1]); w.y = cvt_pk_bf16(v0[2], v0[3]); w.z = cvt_pk_bf16(v1[0], v1[1]); w.w = cvt_pk_bf16(v1[2], v1[3]);
                    *(u32x4*)(rowp + bj * HALF) = w; } }
    }
};
struct EpiRes {
    static constexpr bool PERM = false, AFTER_DRAIN = false;
    const float* base; float* out; bf16_t* xb; float* ssq;
    __device__ __forceinline__ void operator()(const f32x4 (&acc)[2][2][4][2], const Unit& u, int wr, int wc, int fr, int fq) const {
        typedef unsigned u32x2v __attribute__((ext_vector_type(2)));
        const int col0 = u.pn * BM + wc * 32 + 4 * fq, row0 = u.pm * BM + wr * 64 + fr;
#pragma unroll
        for (int ai = 0; ai < 2; ++ai)
#pragma unroll
            for (int m = 0; m < 4; ++m) { const int row = row0 + ai * HALF + m * 16; const size_t off = (size_t)row * 1024 + col0; float s = 0.f;
#pragma unroll
                for (int bj = 0; bj < 2; ++bj)
#pragma unroll
                    for (int n = 0; n < 2; ++n) { const f32x4 bs = *(const f32x4*)(base + off + bj * HALF + n * 16); const f32x4 o = bs + acc[ai][bj][m][n];
                        *(f32x4*)(out + off + bj * HALF + n * 16) = o; s += (o[0] * o[0] + o[1] * o[1]) + (o[2] * o[2] + o[3] * o[3]);
                        u32x2v w; w.x = cvt_pk_bf16(o[0], o[1]); w.y = cvt_pk_bf16(o[2], o[3]); *(u32x2v*)(xb + off + bj * HALF + n * 16) = w; }
                s += __shfl_xor(s, 16); s += __shfl_xor(s, 32);
                if (fq == 0) ssq[(size_t)row * 16 + u.pn * 4 + wc] = s; }
    }
};
template <class Epi, class Sched, bool ALIGN_EPI = false, bool SP2 = false>
__device__ __forceinline__ void gemm_phase(PG8_LAS unsigned char* lds, const Gemm g, const Sched& S, const Epi& E) {
    const int tid = threadIdx.x, wid = __builtin_amdgcn_readfirstlane(tid >> 6), lane = tid & 63, wr = wid >> 2, wc = wid & 3, fr = lane & 15, fq = lane >> 4;
    const int K = g.K, nt = K / BK;
    unsigned voffA[2], voffB[2];
#pragma unroll
    for (int i = 0; i < 2; ++i) { int R, C; stage_rc(tid * 16 + i * 8192, R, C); const int Rb = Epi::PERM ? ((R & ~31) + perm32(R & 31)) : R;
        voffA[i] = (unsigned)(R * K + C) * 2u; voffB[i] = (unsigned)(Rb * K + C) * 2u; }
    const size_t kstep = (size_t)(BK * 2);
    const size_t hstep = (size_t)HALF * K * 2;
    const size_t tstep = 2 * hstep;
    const unsigned ldsw = (unsigned)wid * 1024u;
    const int aoff = lds_byte(wr * 64 + fr, fq * 8), boff = lds_byte(wc * 32 + fr, fq * 8);
#define PG8_SA(b, h) (((b) * 2 + (h)) * HTB)
#define PG8_SB(b, h) ((4 + (b) * 2 + (h)) * HTB)
#define PG8_STAGE(bufoff, gbase, voff) do { _Pragma("unroll") for (int _i = 0; _i < 2; ++_i) \
        __builtin_amdgcn_global_load_lds((const unsigned*)((const char*)(gbase) + (voff)[_i]), (PG8_LAS unsigned*)(lds + (bufoff) + ldsw + _i * 8192), 16, 0, 0); } while (0)
#define PG8_LDA(dst, b, h) do { _Pragma("unroll") for (int m = 0; m < 4; ++m) _Pragma("unroll") for (int k = 0; k < 2; ++k) dst[m][k] = *(const PG8_LAS bf16x8*)(lds + PG8_SA(b, h) + aoff + m * 2048 + k * 1024); } while (0)
#define PG8_LDB(dst, b, h) do { _Pragma("unroll") for (int n = 0; n < 2; ++n) _Pragma("unroll") for (int k = 0; k < 2; ++k) dst[n][k] = *(const PG8_LAS bf16x8*)(lds + PG8_SB(b, h) + boff + n * 2048 + k * 1024); } while (0)
#define PG8_MMA(ai, bj, At, Bt) do { __builtin_amdgcn_s_setprio(1); _Pragma("unroll") for (int m = 0; m < 4; ++m) _Pragma("unroll") for (int n = 0; n < 2; ++n) _Pragma("unroll") for (int k = 0; k < 2; ++k) \
        acc[ai][bj][m][n] = __builtin_amdgcn_mfma_f32_16x16x32_bf16(Bt[n][k], At[m][k], acc[ai][bj][m][n], 0, 0, 0); __builtin_amdgcn_s_setprio(0); } while (0)
#define PG8_WAIT_V(n) asm volatile("s_waitcnt vmcnt(" #n ")" ::: "memory")
#define PG8_WAIT_L(n) asm volatile("s_waitcnt lgkmcnt(" #n ")" ::: "memory")
#define PG8_BAR __builtin_amdgcn_s_barrier()
#define PG8_SCHED __builtin_amdgcn_sched_barrier(0)
    Unit cur, nxt; int ui = 0;
    if (!S.next(0, cur)) return;
    f32x4 acc[2][2][4][2];
#pragma unroll
    for (int a = 0; a < 2; ++a)
#pragma unroll
        for (int b = 0; b < 2; ++b)
#pragma unroll
            for (int m = 0; m < 4; ++m)
#pragma unroll
                for (int n = 0; n < 2; ++n) acc[a][b][m][n] = (f32x4){0.f, 0.f, 0.f, 0.f};
    bf16x8 At[4][2], B0[2][2], B1[2][2];
    const char* cA = (const char*)g.A + (size_t)cur.pm * tstep; const char* cB = (const char*)g.Bt + (size_t)cur.pn * tstep;
    S.a_ready(cur);
    if constexpr (SP2) {
        PG8_STAGE(PG8_SB(0, 0), cB, voffB); PG8_STAGE(PG8_SB(0, 1), cB + hstep, voffB); PG8_STAGE(PG8_SA(0, 0), cA, voffA); PG8_STAGE(PG8_SA(0, 1), cA + hstep, voffA);
        if (wr == 1) PG8_BAR;
        PG8_WAIT_V(2); PG8_BAR;
        PG8_STAGE(PG8_SB(1, 0), cB + kstep, voffB); PG8_STAGE(PG8_SA(1, 0), cA + kstep, voffA); PG8_STAGE(PG8_SB(1, 1), cB + hstep + kstep, voffB);
        PG8_WAIT_V(6); PG8_BAR;
    } else {
        PG8_STAGE(PG8_SB(0, 0), cB, voffB); PG8_STAGE(PG8_SA(0, 0), cA, voffA); PG8_STAGE(PG8_SB(0, 1), cB + hstep, voffB); PG8_STAGE(PG8_SA(0, 1), cA + hstep, voffA);
        if (wr == 1) PG8_BAR;
        PG8_WAIT_V(4); PG8_BAR;
        PG8_STAGE(PG8_SB(1, 0), cB + kstep, voffB); PG8_STAGE(PG8_SA(1, 0), cA + kstep, voffA); PG8_STAGE(PG8_SB(1, 1), cB + hstep + kstep, voffB);
        PG8_WAIT_V(6); PG8_BAR;
    }
    for (;;) {
        const bool has_next = S.next(ui + 1, nxt);
        const char* nA = has_next ? (const char*)g.A + (size_t)nxt.pm * tstep : cA; const char* nB = has_next ? (const char*)g.Bt + (size_t)nxt.pn * tstep : cB;
        for (int t = 0; t < nt; t += 2) {
            const bool last = (t == nt - 2);
            const char* a1 = cA + (size_t)(t + 1) * kstep;
            const char* a2 = last ? nA : cA + (size_t)(t + 2) * kstep; const char* b2 = last ? nB : cB + (size_t)(t + 2) * kstep;
            const char* a3 = a2 + kstep; const char* b3 = b2 + kstep;
            if (last && has_next) S.a_ready(nxt);
            if constexpr (SP2) {
            PG8_LDB(B0, 0, 0); PG8_LDB(B1, 0, 1); PG8_SCHED; PG8_LDA(At, 0, 0); PG8_STAGE(PG8_SA(1, 1), a1 + hstep, voffA);
            PG8_WAIT_V(8); PG8_WAIT_L(0); PG8_BAR; PG8_MMA(0, 0, At, B0); PG8_MMA(0, 1, At, B1); PG8_BAR; PG8_SCHED;
            PG8_LDA(At, 0, 1); PG8_STAGE(PG8_SB(0, 0), b2, voffB); PG8_STAGE(PG8_SB(0, 1), b2 + hstep, voffB); PG8_STAGE(PG8_SA(0, 0), a2, voffA);
            PG8_WAIT_V(8); PG8_WAIT_L(0); PG8_BAR; PG8_MMA(1, 0, At, B0); PG8_MMA(1, 1, At, B1); PG8_BAR; PG8_SCHED;
            PG8_LDB(B0, 1, 0); PG8_LDB(B1, 1, 1); PG8_SCHED; PG8_LDA(At, 1, 0); PG8_STAGE(PG8_SA(0, 1), a2 + hstep, voffA);
            PG8_WAIT_V(8); PG8_WAIT_L(0); PG8_BAR; PG8_MMA(0, 0, At, B0); PG8_MMA(0, 1, At, B1); PG8_BAR; PG8_SCHED;
            PG8_LDA(At, 1, 1); PG8_STAGE(PG8_SB(1, 0), b3, voffB); PG8_STAGE(PG8_SB(1, 1), b3 + hstep, voffB); PG8_STAGE(PG8_SA(1, 0), a3, voffA);
            PG8_WAIT_V(8); PG8_WAIT_L(0); PG8_BAR; PG8_MMA(1, 0, At, B0); PG8_MMA(1, 1, At, B1); PG8_BAR; PG8_SCHED;
            } else {
            PG8_LDB(B0, 0, 0); PG8_SCHED; PG8_LDA(At, 0, 0); PG8_STAGE(PG8_SA(1, 1), a1 + hstep, voffA);
            PG8_WAIT_L(8); PG8_BAR; PG8_WAIT_L(0); PG8_MMA(0, 0, At, B0); PG8_BAR; PG8_SCHED;
            PG8_LDB(B1, 0, 1); PG8_STAGE(PG8_SB(0, 0), b2, voffB);
            PG8_BAR; PG8_WAIT_L(0); PG8_MMA(0, 1, At, B1); PG8_BAR;
            PG8_LDA(At, 0, 1); PG8_STAGE(PG8_SA(0, 0), a2, voffA);
            PG8_BAR; PG8_WAIT_L(0); PG8_MMA(1, 0, At, B0); PG8_BAR; PG8_SCHED;
            PG8_STAGE(PG8_SB(0, 1), b2 + hstep, voffB);
            PG8_WAIT_V(6); PG8_BAR; PG8_MMA(1, 1, At, B1); PG8_BAR;
            PG8_LDB(B0, 1, 0); PG8_SCHED; PG8_LDA(At, 1, 0); PG8_STAGE(PG8_SA(0, 1), a2 + hstep, voffA);
            PG8_WAIT_L(8); PG8_BAR; PG8_WAIT_L(0); PG8_MMA(0, 0, At, B0); PG8_BAR; PG8_SCHED;
            PG8_LDB(B1, 1, 1); PG8_STAGE(PG8_SB(1, 0), b3, voffB);
            PG8_BAR; PG8_WAIT_L(0); PG8_MMA(0, 1, At, B1); PG8_BAR;
            PG8_LDA(At, 1, 1); PG8_STAGE(PG8_SA(1, 0), a3, voffA);
            PG8_BAR; PG8_WAIT_L(0); PG8_MMA(1, 0, At, B0); PG8_BAR; PG8_SCHED;
            PG8_STAGE(PG8_SB(1, 1), b3 + hstep, voffB);
            PG8_WAIT_V(6); PG8_BAR; PG8_MMA(1, 1, At, B1); PG8_BAR;
            }
        }
        if constexpr (ALIGN_EPI) { if (wr == 0) PG8_BAR; }
        if constexpr (!Epi::AFTER_DRAIN) { E(acc, cur, wr, wc, fr, fq); S.done(cur); }
        if (!has_next) break;
#pragma unroll
        for (int a = 0; a < 2; ++a)
#pragma unroll
            for (int b = 0; b < 2; ++b)
#pragma unroll
                for (int m = 0; m < 4; ++m)
#pragma unroll
                    for (int n = 0; n < 2; ++n) acc[a][b][m][n] = (f32x4){0.f, 0.f, 0.f, 0.f};
        cur = nxt; cA = nA; cB = nB; ++ui;
        if constexpr (ALIGN_EPI) { if (wr == 1) PG8_BAR; }
    }
    PG8_WAIT_V(0);
    if constexpr (!ALIGN_EPI) { if (wr == 0) PG8_BAR; }
    PG8_BAR;
    if constexpr (Epi::AFTER_DRAIN) { E.fused(acc, cur, wr, wc, fr, fq, lds, wid, lane); S.done(cur); }
#undef PG8_SA
#undef PG8_SB
#undef PG8_STAGE
#undef PG8_LDA
#undef PG8_LDB
#undef PG8_MMA
#undef PG8_WAIT_V
#undef PG8_WAIT_L
#undef PG8_BAR
#undef PG8_SCHED
}
}

#define GAS __attribute__((address_space(1)))
#define LAS __attribute__((address_space(3)))
typedef unsigned v4u __attribute__((ext_vector_type(4)));
typedef float f32x4 __attribute__((ext_vector_type(4)));
typedef short bf16x8 __attribute__((ext_vector_type(8)));
typedef GAS unsigned gu32;
typedef GAS unsigned long long gu64;
#define RLX_AGENT __ATOMIC_RELAXED, __HIP_MEMORY_SCOPE_AGENT
#define LDS_WAIT() asm volatile("s_waitcnt lgkmcnt(0)" ::: "memory")
#define VM_WAIT() asm volatile("s_waitcnt vmcnt(0)" ::: "memory")
__device__ __forceinline__ unsigned long long rt() { return __builtin_amdgcn_s_memrealtime(); }
__device__ __forceinline__ unsigned pk2(float lo, float hi) { return f2bf(lo) | (f2bf(hi) << 16); }

#define XB_TMO      128
#define XB_XCNT(j)  (256  + 64 * (j))
#define XB_XSUB(j)  (1280 + 64 * (j))
#define XB_XGEN(j)  (2304 + 64 * (j))
#define XB_TOP      3328
#define XB_TOPGEN   3392
#define XCD_BAR_WORDS 3456
#define XB_SPIN_CAP (1u << 18)

__device__ __forceinline__ unsigned xb_ld(unsigned* p)              { return __hip_atomic_load(p, __ATOMIC_RELAXED, __HIP_MEMORY_SCOPE_AGENT); }
__device__ __forceinline__ unsigned xb_add(unsigned* p, unsigned v) { return __hip_atomic_fetch_add(p, v, __ATOMIC_RELAXED, __HIP_MEMORY_SCOPE_AGENT); }
__device__ __forceinline__ unsigned xb_xcc_id() { return (unsigned)__builtin_amdgcn_s_getreg((3 << 11) | 20) & 0xFu; }
#define XB_SPIN(cond, bar) do { unsigned _sp = 0; while (cond) { __builtin_amdgcn_s_sleep(1); \
    if ((++_sp & 255u) == 0u) { if (xb_ld(&(bar)[XB_TMO])) break; if (_sp > XB_SPIN_CAP) { atomicAdd(&(bar)[XB_TMO], 1u); break; } } } } while (0)

struct XcdBarrier {
    unsigned* bar; unsigned x;
    volatile LAS unsigned* st;
};

__device__ __forceinline__ XcdBarrier xcd_barrier_post(unsigned* bar, volatile LAS unsigned* st) {
    XcdBarrier b; b.bar = bar; b.x = xb_xcc_id(); b.st = st;
    if (threadIdx.x == 0) (void)xb_add(&bar[XB_XCNT(b.x)], 1u);
    return b;
}
__device__ __forceinline__ void xcd_barrier_complete(unsigned* bar, unsigned x, unsigned& nloc, unsigned& nx) {
    const unsigned G = gridDim.x * gridDim.y * gridDim.z;
    unsigned sum, cnt, mine, sp = 0u;
    for (;;) {
        sum = 0u; cnt = 0u; mine = 0u;
#pragma unroll
        for (unsigned j = 0; j < 16; ++j) { const unsigned c = xb_ld(&bar[XB_XCNT(j)]); sum += c; cnt += (c > 0u) ? 1u : 0u; mine = (j == x) ? c : mine; }
        if (sum == G) break;
        __builtin_amdgcn_s_sleep(1);
        if ((++sp & 255u) == 0u) { if (xb_ld(&bar[XB_TMO])) break; if (sp > XB_SPIN_CAP) { atomicAdd(&bar[XB_TMO], 1u); break; } }
    }
    nloc = mine > 0u ? mine : 1u; nx = cnt > 0u ? cnt : 1u;
}

__device__ __forceinline__ void xcd_barrier(const XcdBarrier& b) {
    asm volatile("s_waitcnt vmcnt(0)" ::: "memory");
    __syncthreads();
    if (threadIdx.x == 0) {
        unsigned* bar = b.bar;
        __builtin_amdgcn_s_waitcnt(0);
        unsigned nloc = b.st[0], nx = b.st[1];
        if (nloc == 0u) { xcd_barrier_complete(bar, b.x, nloc, nx); b.st[0] = nloc; b.st[1] = nx; }
        const unsigned old = xb_add(&bar[XB_XSUB(b.x)], 1u);
        const unsigned gen = old / nloc;
        if (old + 1u == (gen + 1u) * nloc) {
            __builtin_amdgcn_fence(__ATOMIC_RELEASE, "agent");
            asm volatile("s_waitcnt vmcnt(0)" ::: "memory");
            const unsigned og = xb_add(&bar[XB_TOP], 1u);
            const unsigned tg = og / nx;
            if (og + 1u == (tg + 1u) * nx) xb_add(&bar[XB_TOPGEN], 1u);
            else XB_SPIN(xb_ld(&bar[XB_TOPGEN]) == tg, bar);
            __builtin_amdgcn_fence(__ATOMIC_ACQUIRE, "agent");
            xb_add(&bar[XB_XGEN(b.x)], 1u);
            asm volatile("s_waitcnt vmcnt(0)" ::: "memory");
        } else {
            XB_SPIN(xb_ld(&bar[XB_XGEN(b.x)]) == gen, bar);
            __builtin_amdgcn_fence(__ATOMIC_ACQUIRE, "agent");
            asm volatile("s_waitcnt vmcnt(0)" ::: "memory");
        }
    }
    __syncthreads();
}

namespace att {
typedef short bf16x8 __attribute__((ext_vector_type(8)));
typedef short s16x4 __attribute__((ext_vector_type(4)));
typedef float f32x4 __attribute__((ext_vector_type(4)));
typedef unsigned u32x2 __attribute__((ext_vector_type(2)));
typedef LAS const char* lptr;
constexpr int SLOT = 16384, NS = 7, PD = 5, TBL_OFF = NS * SLOT;
constexpr float NEG = -INFINITY;
__device__ __forceinline__ int fK(int t) { return (t >> 1) & 7; }
__device__ __forceinline__ int fV(int t) { return (((t >> 1) & 3) << 1) | ((t >> 3) & 1); }
__device__ __forceinline__ s16x4 vtr(lptr p) { typedef short v4i16_t __attribute__((ext_vector_type(4))); return __builtin_bit_cast(s16x4, __builtin_amdgcn_ds_read_tr16_b64_v4i16((LAS v4i16_t*)p)); }
__device__ __forceinline__ unsigned cvtpk(float lo, float hi) { unsigned r; asm volatile("v_cvt_pk_bf16_f32 %0, %1, %2" : "=v"(r) : "v"(lo), "v"(hi)); return r; }
__device__ __forceinline__ float xor16(float v) { return __builtin_bit_cast(float, __builtin_amdgcn_ds_swizzle(__builtin_bit_cast(int, v), 0x401F)); }
__device__ __forceinline__ float xor32(float v) { return __shfl_xor(v, 32); }

struct Item { bf16x8 q0, q1; f32x4 o0, o1, o2, o3; float m, l; int ka, va; };
__device__ __forceinline__ void item_init(Item& it, float m0, float l0) { it.o0 = it.o1 = it.o2 = it.o3 = (f32x4){0.f, 0.f, 0.f, 0.f}; it.m = m0; it.l = l0; }
__device__ __forceinline__ void item_addr(Item& it, int w0, int lane) {
    const int fr = lane & 15, fq = lane >> 4, rk = w0 + fr, rv = w0 + 4 * fq + (fr >> 2);
    it.ka = rk * 128 + ((fq ^ fK(rk)) << 4);
    it.va = 8192 + rv * 128 + (((((fr & 3) >> 1)) ^ fV(rv)) << 4) + 8 * (fr & 1);
}
__device__ __forceinline__ void half_step(Item& it, lptr slot, f32x4 b0, f32x4 b1) {
    lptr kp = slot + it.ka;
    const bf16x8 k00 = *(const LAS bf16x8*)(kp), k01 = *(const LAS bf16x8*)(kp + 2048);
    lptr kp1 = slot + (it.ka ^ 64);
    const bf16x8 k10 = *(const LAS bf16x8*)(kp1), k11 = *(const LAS bf16x8*)(kp1 + 2048);
    f32x4 s0 = __builtin_amdgcn_mfma_f32_16x16x32_bf16(k00, it.q0, b0, 0, 0, 0);
    f32x4 s1 = __builtin_amdgcn_mfma_f32_16x16x32_bf16(k01, it.q0, b1, 0, 0, 0);
    s0 = __builtin_amdgcn_mfma_f32_16x16x32_bf16(k10, it.q1, s0, 0, 0, 0);
    s1 = __builtin_amdgcn_mfma_f32_16x16x32_bf16(k11, it.q1, s1, 0, 0, 0);
    float mx = __builtin_fmaxf(__builtin_fmaxf(__builtin_fmaxf(s0[0], s0[1]), __builtin_fmaxf(s0[2], s0[3])), __builtin_fmaxf(__builtin_fmaxf(s1[0], s1[1]), __builtin_fmaxf(s1[2], s1[3])));
    mx = __builtin_fmaxf(mx, xor16(mx)); mx = __builtin_fmaxf(mx, xor32(mx));
    const float mn = __builtin_fmaxf(it.m, mx), al = __builtin_amdgcn_exp2f(it.m - mn);
    it.m = mn;
#pragma unroll
    for (int e = 0; e < 4; ++e) { s0[e] = __builtin_amdgcn_exp2f(s0[e] - mn); s1[e] = __builtin_amdgcn_exp2f(s1[e] - mn); }
    it.l = it.l * al + (((s0[0] + s0[1]) + (s0[2] + s0[3])) + ((s1[0] + s1[1]) + (s1[2] + s1[3])));
    it.o0 *= al; it.o1 *= al; it.o2 *= al; it.o3 *= al;
    typedef unsigned u32x4 __attribute__((ext_vector_type(4)));
    u32x4 pw; pw.x = cvtpk(s0[0], s0[1]); pw.y = cvtpk(s0[2], s0[3]); pw.z = cvtpk(s1[0], s1[1]); pw.w = cvtpk(s1[2], s1[3]);
    const bf16x8 pf = __builtin_bit_cast(bf16x8, pw);
#define ATT_PV(dt, O) do { lptr vp = slot + (it.va ^ ((dt) << 5)); const s16x4 lo = vtr(vp), hi = vtr(vp + 2048); \
        const bf16x8 vf = (bf16x8){lo[0], lo[1], lo[2], lo[3], hi[0], hi[1], hi[2], hi[3]}; O = __builtin_amdgcn_mfma_f32_16x16x32_bf16(vf, pf, O, 0, 0, 0); } while (0)
    ATT_PV(0, it.o0); ATT_PV(1, it.o1); ATT_PV(2, it.o2); ATT_PV(3, it.o3);
#undef ATT_PV
}
__device__ __forceinline__ void item_store(Item& it, bf16* orow, int lane) {
    float l = it.l; l += xor16(l); l += xor32(l);
    const float rl = 1.0f / l; const int fq = lane >> 4;
    u32x2 w;
    w.x = cvtpk(it.o0[0] * rl, it.o0[1] * rl); w.y = cvtpk(it.o0[2] * rl, it.o0[3] * rl); *(u32x2*)(orow + 0 + 4 * fq) = w;
    w.x = cvtpk(it.o1[0] * rl, it.o1[1] * rl); w.y = cvtpk(it.o1[2] * rl, it.o1[3] * rl); *(u32x2*)(orow + 16 + 4 * fq) = w;
    w.x = cvtpk(it.o2[0] * rl, it.o2[1] * rl); w.y = cvtpk(it.o2[2] * rl, it.o2[3] * rl); *(u32x2*)(orow + 32 + 4 * fq) = w;
    w.x = cvtpk(it.o3[0] * rl, it.o3[1] * rl); w.y = cvtpk(it.o3[2] * rl, it.o3[3] * rl); *(u32x2*)(orow + 48 + 4 * fq) = w;
}
__device__ __forceinline__ void dma_row(LAS unsigned char* L, int slot, int wid, const bf16* ksrc, const bf16* vsrc) {
    __builtin_amdgcn_global_load_lds((const unsigned*)ksrc, (LAS unsigned*)(L + slot * SLOT + wid * 1024), 16, 0, 0);
    __builtin_amdgcn_global_load_lds((const unsigned*)vsrc, (LAS unsigned*)(L + slot * SLOT + 8192 + wid * 1024), 16, 0, 0);
}
#define ATT_WAITV(n) asm volatile("s_waitcnt vmcnt(" #n ")" ::: "memory")
#define ATT_BAR() do { asm volatile("s_waitcnt lgkmcnt(0)" ::: "memory"); __builtin_amdgcn_s_barrier(); asm volatile("" ::: "memory"); } while (0)
__device__ __forceinline__ void wait_rows_in_flight(int n) {
    if (n >= 5) ATT_WAITV(10); else if (n == 4) ATT_WAITV(8); else if (n == 3) ATT_WAITV(6); else if (n == 2) ATT_WAITV(4); else if (n == 1) ATT_WAITV(2); else ATT_WAITV(0);
}

__device__ __forceinline__ void na_phase(LAS unsigned char* L, const bf16* Q, const bf16* K, const bf16* V, bf16* O, const float* rpb, int vcu, int G) {
    const int tid = threadIdx.x, lane = tid & 63, wid = __builtin_amdgcn_readfirstlane(tid >> 6), fr = lane & 15, fq = lane >> 4;
    LAS float* tb = (LAS float*)(L + TBL_OFF);
    const int tok = wid * 8 + (lane >> 3), cp = lane & 7;
    constexpr int NUNITS = BATCH * NH * (ROWS / 4);
    for (int u = vcu; u < NUNITS; u += G) {
        const int rg = u % (ROWS / 4), h = (u / (ROWS / 4)) % NH, b = u / (ROWS / 4 * NH), r0 = rg * 4;
        const int clo = r0 - 4 < 0 ? 0 : r0 - 4, chi_ = r0 + 3 - 4 > ROWS - KR ? ROWS - KR : r0 + 3 - 4, klo = clo > ROWS - KR ? ROWS - KR : clo, khi = (chi_ < 0 ? 0 : chi_) + KR - 1, nt = khi - klo + 1;
        const bf16* kbase = K + ((size_t)b * SEQ + (size_t)klo * GW) * D + h * HD; const bf16* vbase = V + ((size_t)b * SEQ + (size_t)klo * GW) * D + h * HD;
        const bf16* ksrc = kbase + (size_t)tok * D + ((cp ^ fK(tok)) << 3); const bf16* vsrc = vbase + (size_t)tok * D + ((cp ^ fV(tok)) << 3);
        ATT_BAR();
        for (int t = 0; t < PD && t < nt; ++t) dma_row(L, t % NS, wid, ksrc + (size_t)t * GW * D, vsrc + (size_t)t * GW * D);
        for (int i = tid; i < 15 * 64; i += 512) { const int dr = i >> 6, dc = (i & 63) - 16; tb[i] = (dc >= 0 && dc < 31) ? rpb[(h * 15 + dr) * 31 + dc] * LOG2E : 0.f; }
        const int r = r0 + (wid >> 1); int rs = r - KR / 2; rs = rs < 0 ? 0 : (rs > ROWS - KR ? ROWS - KR : rs);
        Item it[2]; int tbi[2]; f32x4 mk[2][2];
#pragma unroll
        for (int i = 0; i < 2; ++i) {
            const int ct = 2 * (wid & 1) + i, w0 = ct == 0 ? 0 : ct == 1 ? 8 : ct == 2 ? 24 : 32, c = ct * 16 + fr; int cs = c - KC / 2; cs = cs < 0 ? 0 : (cs > GW - KC ? GW - KC : cs);
            const bf16* qp = Q + ((size_t)b * SEQ + (size_t)r * GW + c) * D + h * HD + 8 * fq;
            it[i].q0 = *(const bf16x8*)qp; it[i].q1 = *(const bf16x8*)(qp + 32);
            item_init(it[i], -1e30f, 0.f); item_addr(it[i], w0, lane);
            tbi[i] = 16 + w0 + 4 * fq - c + 15;
            const int dl = w0 + 4 * fq - cs;
#pragma unroll
            for (int kt = 0; kt < 2; ++kt)
#pragma unroll
                for (int e = 0; e < 4; ++e) { const int x = dl + 16 * kt + e; mk[i][kt][e] = (x >= 0 && x <= 15) ? 0.f : NEG; }
        }
        for (int t = 0; t < nt; ++t) {
            if (t + PD < nt) dma_row(L, (t + PD) % NS, wid, ksrc + (size_t)(t + PD) * GW * D, vsrc + (size_t)(t + PD) * GW * D);
            wait_rows_in_flight(nt - 1 - t < PD ? nt - 1 - t : PD);
            ATT_BAR();
            const int kr = klo + t;
            if (kr >= rs && kr < rs + KR) {
                lptr slot = (lptr)(L + (t % NS) * SLOT); const int dr = kr - r + KR - 1;
#pragma unroll
                for (int i = 0; i < 2; ++i) { const LAS float* bp = tb + dr * 64 + tbi[i];
                    f32x4 b0, b1;
#pragma unroll
                    for (int e = 0; e < 4; ++e) { b0[e] = bp[e] + mk[i][0][e]; b1[e] = bp[16 + e] + mk[i][1][e]; }
                    half_step(it[i], slot, b0, b1); }
            }
        }
#pragma unroll
        for (int i = 0; i < 2; ++i) { const int c = (2 * (wid & 1) + i) * 16 + fr; item_store(it[i], O + ((size_t)b * SEQ + (size_t)r * GW + c) * D + h * HD, lane); }
        ATT_WAITV(0);
    }
}

__device__ __forceinline__ void swa_phase(LAS unsigned char* L, const bf16* Q, const bf16* K, const bf16* V, bf16* O, const float* tblg, int vcu, int G) {
    const int tid = threadIdx.x, lane = tid & 63, wid = __builtin_amdgcn_readfirstlane(tid >> 6), fr = lane & 15, fq = lane >> 4;
    LAS float* tb = (LAS float*)(L + TBL_OFF);
    const int tok = wid * 8 + (lane >> 3), cp = lane & 7;
    constexpr int NQB = SEQ / 64, NUNITS = BATCH * KVH * NQB, KVW = KVH * HD;
    for (int u = vcu; u < NUNITS; u += G) {
        const int qb = u % NQB, kv = (u / NQB) % KVH, b = u / (NQB * KVH);
        const int clo = qb - 2 < 0 ? 0 : qb - 2, chi_ = qb + 2 > NQB - 1 ? NQB - 1 : qb + 2, nt = chi_ - clo + 1;
        const bf16* kbase = K + ((size_t)b * SEQ + (size_t)clo * 64) * KVW + kv * HD; const bf16* vbase = V + ((size_t)b * SEQ + (size_t)clo * 64) * KVW + kv * HD;
        const bf16* ksrc = kbase + (size_t)tok * KVW + ((cp ^ fK(tok)) << 3); const bf16* vsrc = vbase + (size_t)tok * KVW + ((cp ^ fV(tok)) << 3);
        ATT_BAR();
        for (int t = 0; t < PD && t < nt; ++t) dma_row(L, t % NS, wid, ksrc + (size_t)t * 64 * KVW, vsrc + (size_t)t * 64 * KVW);
        for (int i = tid; i < 4 * 384; i += 512) { const int g = i / 384, rel = i % 384 - 192; tb[i] = (rel >= -WINDOW && rel <= WINDOW) ? tblg[(kv * 4 + g) * 257 + rel + WINDOW] : NEG; }
        const int g = wid >> 1, hq = kv * 4 + g; const float sink2 = tblg[16 * 257 + hq];
        Item it[2]; int tbi[2];
#pragma unroll
        for (int i = 0; i < 2; ++i) {
            const int qt = 2 * (wid & 1) + i;
            const bf16* qp = Q + ((size_t)b * SEQ + (size_t)qb * 64 + qt * 16 + fr) * D + hq * HD + 8 * fq;
            it[i].q0 = *(const bf16x8*)qp; it[i].q1 = *(const bf16x8*)(qp + 32);
            item_init(it[i], sink2, fq == 0 ? 1.f : 0.f); item_addr(it[i], 0, lane);
            tbi[i] = g * 384 + 192 + 4 * fq - 16 * qt - fr;
        }
        for (int t = 0; t < nt; ++t) {
            if (t + PD < nt) dma_row(L, (t + PD) % NS, wid, ksrc + (size_t)(t + PD) * 64 * KVW, vsrc + (size_t)(t + PD) * 64 * KVW);
            wait_rows_in_flight(nt - 1 - t < PD ? nt - 1 - t : PD);
            ATT_BAR();
            const int cb = clo + t; lptr slot = (lptr)(L + (t % NS) * SLOT);
#pragma unroll
            for (int hs = 0; hs < 2; ++hs)
#pragma unroll
                for (int i = 0; i < 2; ++i) { const int qt = 2 * (wid & 1) + i, k0 = 64 * cb + 32 * hs, tq0 = 64 * qb + 16 * qt;
                    if (k0 + 31 >= tq0 - WINDOW && k0 <= tq0 + 15 + WINDOW) {
                        const LAS float* bp = tb + tbi[i] + 64 * (cb - qb) + 32 * hs;
                        f32x4 b0, b1;
#pragma unroll
                        for (int e = 0; e < 4; ++e) { b0[e] = bp[e]; b1[e] = bp[16 + e]; }
                        half_step(it[i], slot + hs * 4096, b0, b1); } }
        }
#pragma unroll
        for (int i = 0; i < 2; ++i) { const int qt = 2 * (wid & 1) + i; item_store(it[i], O + ((size_t)b * SEQ + (size_t)qb * 64 + qt * 16 + fr) * D + hq * HD, lane); }
        ATT_WAITV(0);
    }
}
#undef ATT_WAITV
#undef ATT_BAR
}

#ifndef PG8_SP2
#define PG8_SP2 true
#endif
#ifndef PG8_ALIGN
#define PG8_ALIGN true
#endif
#ifndef MK_N_LAUNCHES
#define MK_N_LAUNCHES 1
#endif
constexpr int NWAVES = 8;
constexpr int RING_OFF = 0, RING_BYTES = 131072, LDSCTL_OFF = RING_BYTES, MISC_OFF = LDSCTL_OFF + 320, LDS_BYTES = 147456;
constexpr int CW_BAR = 4096;
constexpr int NPHASE = 12;

__device__ __forceinline__ void p0_transpose_item(const float* W, const float* g, int K, int N, bf16* WT, LAS float* scr, int item, int lane) {
    const int nblk = N / 32, kb = item / nblk, nb = item % nblk, k0 = 64 * kb, n0 = 32 * nb;
#pragma unroll 8
    for (int i = 0; i < 32; ++i) { const int kk = 2 * i + (lane >> 5); scr[kk * 33 + (lane & 31)] = W[(size_t)(k0 + kk) * N + n0 + (lane & 31)] * (g ? g[k0 + kk] : 1.0f); }
    LDS_WAIT(); asm volatile("" ::: "memory");
    const int c = lane & 7;
#pragma unroll
    for (int j = 0; j < 4; ++j) { const int n = (lane >> 3) + 8 * j; const LAS float* s = scr + (8 * c) * 33 + n;
        v4u o; o.x = pk2(s[0 * 33], s[1 * 33]); o.y = pk2(s[2 * 33], s[3 * 33]); o.z = pk2(s[4 * 33], s[5 * 33]); o.w = pk2(s[6 * 33], s[7 * 33]);
        *(GAS v4u*)(WT + (size_t)(n0 + n) * K + k0 + 8 * c) = o; }
    LDS_WAIT(); asm volatile("" ::: "memory");
}

struct Args { const float* in[13]; float* out; unsigned char* ws; int ph_lo, ph_hi; };
__global__ void __launch_bounds__(NWAVES * 64, 2) mk_fwd(Args args) {
    extern __shared__ __attribute__((aligned(16))) unsigned char lds[];
    LAS unsigned char* L = (LAS unsigned char*)lds;
    volatile LAS unsigned* MISC = (volatile LAS unsigned*)(L + MISC_OFF);
    const int tid = threadIdx.x, lane = tid & 63, wave = __builtin_amdgcn_readfirstlane(tid >> 6);
    unsigned char* ws = args.ws;
    gu32* ctl = (gu32*)(ws + WS_CTL);
    float* ssq = (float*)(ws + WS_SSQ); float* tblg = (float*)(ws + WS_TBL);
    bf16 *Wqkv0 = (bf16*)(ws + WS_WQKV0), *Wo0 = (bf16*)(ws + WS_WO0), *Win0 = (bf16*)(ws + WS_WIN0), *Wout0 = (bf16*)(ws + WS_WOUT0);
    bf16 *Wqkv1 = (bf16*)(ws + WS_WQKV1), *Wo1 = (bf16*)(ws + WS_WO1), *Win1 = (bf16*)(ws + WS_WIN1), *Wout1 = (bf16*)(ws + WS_WOUT1);
    bf16 *XB = (bf16*)(ws + WS_XB), *Qb = (bf16*)(ws + WS_Q), *Kb = (bf16*)(ws + WS_K), *Vb = (bf16*)(ws + WS_V), *Hb = (bf16*)(ws + WS_H);
    const float* x = args.in[0]; float* out = args.out;
    const int G = gridDim.x; int vcu; { const int bx = blockIdx.x; vcu = (G % 8 == 0) ? (bx % 8) * (G / 8) + bx / 8 : bx; }
    for (int u = tid; u < (LDS_BYTES - LDSCTL_OFF) / 4; u += NWAVES * 64) ((LAS unsigned*)(L + LDSCTL_OFF))[u] = 0u;
    __syncthreads();
    XcdBarrier bar; bar.bar = (unsigned*)(ctl + CW_BAR); bar.x = 0; bar.st = nullptr;
    if (MK_N_LAUNCHES == 1) bar = xcd_barrier_post((unsigned*)(ctl + CW_BAR), MISC + 8);
    const int lo = args.ph_lo, hi = args.ph_hi;
#define IN(k) (lo <= (k) && (k) < hi)
#define SEAM(k) do { if (IN(k) && IN((k) + 1)) xcd_barrier(bar); } while (0)

    if (IN(0)) {
        LAS float* scr = (LAS float*)(L + RING_OFF + wave * 16384);
        const int gw = vcu * NWAVES + wave, NGW = G * NWAVES;
        const float *mix_norm = args.in[1], *mlp_norm = args.in[2], *w_in = args.in[11], *w_out = args.in[12];
        constexpr int I_QKV0 = (D / 64) * (3072 / 32), I_O = (D / 64) * (D / 32), I_IN = (D / 64) * (FF / 32), I_OUT = (FF / 64) * (D / 32), I_QKV1 = (D / 64) * (1536 / 32);
        constexpr int NITEMS = I_QKV0 + I_QKV1 + 2 * (I_O + I_IN + I_OUT);
        for (int it = gw; it < NITEMS; it += NGW) {
            int r = it;
            if (r < I_QKV0) { p0_transpose_item(args.in[4], mix_norm, D, 3072, Wqkv0, scr, r, lane); continue; } r -= I_QKV0;
            if (r < I_O) { p0_transpose_item(args.in[6], nullptr, D, D, Wo0, scr, r, lane); continue; } r -= I_O;
            if (r < I_IN) { p0_transpose_item(w_in, mlp_norm, D, FF, Win0, scr, r, lane); continue; } r -= I_IN;
            if (r < I_OUT) { p0_transpose_item(w_out, nullptr, FF, D, Wout0, scr, r, lane); continue; } r -= I_OUT;
            if (r < I_QKV1) { p0_transpose_item(args.in[7], mix_norm + D, D, 1536, Wqkv1, scr, r, lane); continue; } r -= I_QKV1;
            if (r < I_O) { p0_transpose_item(args.in[9], nullptr, D, D, Wo1, scr, r, lane); continue; } r -= I_O;
            if (r < I_IN) { p0_transpose_item(w_in + (size_t)D * FF, mlp_norm + D, D, FF, Win1, scr, r, lane); continue; } r -= I_IN;
            p0_transpose_item(w_out + (size_t)D * FF, nullptr, FF, D, Wout1, scr, r, lane);
        }
        for (int i = vcu * (NWAVES * 64) + tid; i < 16 * 257 + 16; i += G * NWAVES * 64) {
            if (i < 16 * 257) { const int h = i / 257, rel = i % 257 - 128; const int n = rel < 0 ? -rel : rel; int bk;
                if (n < 8) bk = n; else { const int k = (31 - __clz(n * n)) - 6; bk = 8 + (k < 7 ? k : 7); }
                if (rel > 0) bk += 16;
                tblg[i] = args.in[10][bk * 16 + h] * LOG2E; }
            else tblg[i] = args.in[8][i - 16 * 257] * LOG2E;
        }
        for (int m = gw; m < M; m += NGW) {
            const GAS f32x4* xr = (const GAS f32x4*)(x + (size_t)m * D) + lane; GAS unsigned long long* o8 = (GAS unsigned long long*)(XB + (size_t)m * D) + lane;
            float s = 0.f;
#pragma unroll
            for (int j = 0; j < 4; ++j) { const f32x4 v = xr[64 * j]; s += (v.x * v.x + v.y * v.y) + (v.z * v.z + v.w * v.w);
                o8[64 * j] = (unsigned long long)pk2(v.x, v.y) | ((unsigned long long)pk2(v.z, v.w) << 32); }
            s = wave_sum(s);
            if (lane < 16) ssq[(size_t)m * 16 + lane] = lane == 0 ? s : 0.f;
        }
    }
    SEAM(0);
    if (IN(1)) { pg8::Gemm g{XB, Wqkv0, M, 3072, D}; pg8::StaticOrder S; S.init(M, 3072, G, (int)blockIdx.x);
        pg8::EpiQKV E{Qb, Kb, Vb, D, C2, ssq};
        pg8::gemm_phase<pg8::EpiQKV, pg8::StaticOrder, PG8_ALIGN, PG8_SP2>(L + RING_OFF, g, S, E); }
    SEAM(1);
    if (IN(2)) att::na_phase(L + RING_OFF, Qb, Kb, Vb, Qb, args.in[5], vcu, G);
    SEAM(2);
    if (IN(3)) { pg8::Gemm g{Qb, Wo0, M, D, D}; pg8::StaticOrder S; S.init(M, D, G, (int)blockIdx.x);
        pg8::EpiRes E{x, out, XB, ssq};
        pg8::gemm_phase<pg8::EpiRes, pg8::StaticOrder, PG8_ALIGN, PG8_SP2>(L + RING_OFF, g, S, E); }
    SEAM(3);
    if (IN(4)) { pg8::Gemm g{XB, Win0, M, FF, D}; pg8::StaticOrder S; S.init(M, FF, G, (int)blockIdx.x);
        pg8::EpiUp E{Hb, ssq};
        pg8::gemm_phase<pg8::EpiUp, pg8::StaticOrder, PG8_ALIGN, PG8_SP2>(L + RING_OFF, g, S, E); }
    SEAM(4);
    if (IN(5)) { pg8::Gemm g{Hb, Wout0, M, D, FF}; pg8::StaticOrder S; S.init(M, D, G, (int)blockIdx.x);
        pg8::EpiRes E{out, out, XB, ssq};
        pg8::gemm_phase<pg8::EpiRes, pg8::StaticOrder, PG8_ALIGN, PG8_SP2>(L + RING_OFF, g, S, E); }
    SEAM(5);
    if (IN(6)) { pg8::Gemm g{XB, Wqkv1, M, 1536, D}; pg8::StaticOrder S; S.init(M, 1536, G, (int)blockIdx.x);
        pg8::EpiQKV E{Qb, Kb, Vb, 256, C2, ssq};
        pg8::gemm_phase<pg8::EpiQKV, pg8::StaticOrder, PG8_ALIGN, PG8_SP2>(L + RING_OFF, g, S, E); }
    SEAM(6);
    if (IN(7)) att::swa_phase(L + RING_OFF, Qb, Kb, Vb, Qb, tblg, vcu, G);
    SEAM(7);
    if (IN(8)) { pg8::Gemm g{Qb, Wo1, M, D, D}; pg8::StaticOrder S; S.init(M, D, G, (int)blockIdx.x);
        pg8::EpiRes E{out, out, XB, ssq};
        pg8::gemm_phase<pg8::EpiRes, pg8::StaticOrder, PG8_ALIGN, PG8_SP2>(L + RING_OFF, g, S, E); }
    SEAM(8);
    if (IN(9)) { pg8::Gemm g{XB, Win1, M, FF, D}; pg8::StaticOrder S; S.init(M, FF, G, (int)blockIdx.x);
        pg8::EpiUp E{Hb, ssq};
        pg8::gemm_phase<pg8::EpiUp, pg8::StaticOrder, PG8_ALIGN, PG8_SP2>(L + RING_OFF, g, S, E); }
    SEAM(9);
    if (IN(10)) { pg8::Gemm g{Hb, Wout1, M, D, FF}; pg8::StaticOrder S; S.init(M, D, G, (int)blockIdx.x);
        pg8::EpiRes E{out, out, XB, ssq};
        pg8::gemm_phase<pg8::EpiRes, pg8::StaticOrder, PG8_ALIGN, PG8_SP2>(L + RING_OFF, g, S, E); }
    SEAM(10);
    if (IN(11)) {
        const int gw = vcu * NWAVES + wave, NGW = G * NWAVES; const GAS f32x4* gr = (const GAS f32x4*)args.in[3] + lane;
        const f32x4 g0 = gr[0], g1 = gr[64], g2 = gr[128], g3 = gr[192];
        for (int m = gw; m < M; m += NGW) {
            const float r = pg8::rstd16(ssq, m); GAS f32x4* xr = (GAS f32x4*)(out + (size_t)m * D) + lane;
            const f32x4 v0 = xr[0], v1 = xr[64], v2 = xr[128], v3 = xr[192];
            xr[0] = v0 * r * g0; xr[64] = v1 * r * g1; xr[128] = v2 * r * g2; xr[192] = v3 * r * g3;
        }
    }
#undef IN
#undef SEAM
}

extern "C" void kernel_launch(void* const* d_in, const int* in_sizes, int n_in, void* d_out, int out_size, void* d_ws, size_t ws_size, hipStream_t stream) {
    static int grid = 0;
    if (grid == 0) {
        if (n_in != 13 || in_sizes[0] != M * D || out_size != M * D || ws_size < WS_END) { fprintf(stderr, "kernel_launch: unexpected shapes (n_in %d in0 %d out %d ws %zu)\n", n_in, n_in > 0 ? in_sizes[0] : -1, out_size, ws_size); grid = -1; return; }
        int dev = 0, cus = 0, per_cu = 0;
        if (hipGetDevice(&dev) != hipSuccess || hipDeviceGetAttribute(&cus, hipDeviceAttributeMultiprocessorCount, dev) != hipSuccess) { grid = -1; return; }
        if (hipFuncSetAttribute((const void*)mk_fwd, hipFuncAttributeMaxDynamicSharedMemorySize, LDS_BYTES) != hipSuccess) { fprintf(stderr, "kernel_launch: hipFuncSetAttribute failed\n"); grid = -1; return; }
        if (hipOccupancyMaxActiveBlocksPerMultiprocessor(&per_cu, (const void*)mk_fwd, NWAVES * 64, LDS_BYTES) != hipSuccess || per_cu < 1) { fprintf(stderr, "kernel_launch: occupancy query says %d blocks per CU\n", per_cu); grid = -1; (void)hipGetLastError(); return; }
        (void)hipGetLastError();
        grid = cus;
    }
    if (grid < 0) return;
    (void)hipMemsetAsync((unsigned char*)d_ws + WS_CTL, 0, 1 * MiB, stream);
    Args a{}; for (int i = 0; i < 13; ++i) a.in[i] = (const float*)d_in[i]; a.out = (float*)d_out; a.ws = (unsigned char*)d_ws;
#if MK_N_LAUNCHES == 1
    a.ph_lo = 0; a.ph_hi = NPHASE; hipLaunchKernelGGL(mk_fwd, dim3(grid), dim3(NWAVES * 64), LDS_BYTES, stream, a);
#else
    for (int p = 0; p < NPHASE; ++p) { a.ph_lo = p; a.ph_hi = p + 1; hipLaunchKernelGGL(mk_fwd, dim3(grid), dim3(NWAVES * 64), LDS_BYTES, stream, a); }
#endif
}
```

```cpp
#include <hip/hip_runtime.h>
#include <cstdint>
#include <cstdio>

typedef unsigned short bf16;
constexpr int BATCH = 4, SEQ = 8192, D = 1024, NH = 16, HD = 64, KVH = 4, FF = 4096, M = BATCH * SEQ;
constexpr int GW = 64, ROWS = SEQ / GW, KR = 8, KC = 16, WINDOW = 128;
constexpr float EPS = 1e-6f, LOG2E = 1.4426950408889634f, C2 = 0.125f * LOG2E;
constexpr size_t MiB = 1u << 20;
constexpr size_t WS_CTL = 0, WS_SSQ = 1 * MiB, WS_TBL = 3 * MiB;
constexpr size_t WS_WQKV0 = 4 * MiB, WS_WO0 = 10 * MiB, WS_WIN0 = 12 * MiB, WS_WOUT0 = 20 * MiB, WS_WQKV1 = 28 * MiB, WS_WO1 = 31 * MiB, WS_WIN1 = 33 * MiB, WS_WOUT1 = 41 * MiB;
constexpr size_t WS_XB = 64 * MiB, WS_Q = 128 * MiB, WS_K = 192 * MiB, WS_V = 256 * MiB, WS_H = 128 * MiB, WS_END = 384 * MiB;

__device__ __forceinline__ unsigned f2bf(float f) { unsigned u = __builtin_bit_cast(unsigned, f); return (u + 0x7fffu + ((u >> 16) & 1u)) >> 16; }
__device__ __forceinline__ float bf2f(bf16 b) { return __builtin_bit_cast(float, (unsigned)b << 16); }
__device__ __forceinline__ float wave_sum(float v) {
#pragma unroll
    for (int o = 1; o < 64; o <<= 1) v += __shfl_xor(v, o);
    return v;
}
__device__ __forceinline__ float row_rstd(const float* ssq, int row) {
    const float4* p = (const float4*)(ssq + (size_t)row * 16);
    float4 a = p[0], b = p[1], c = p[2], d = p[3];
    float s = ((a.x + a.y) + (a.z + a.w)) + ((b.x + b.y) + (b.z + b.w)) + ((c.x + c.y) + (c.z + c.w)) + ((d.x + d.y) + (d.z + d.w));
    return 1.0f / sqrtf(s * (1.0f / D) + EPS);
}


namespace pg8 {
#define PG8_LAS __attribute__((address_space(3)))
typedef unsigned short bf16_t;
typedef short bf16x8 __attribute__((ext_vector_type(8)));
typedef float f32x4 __attribute__((ext_vector_type(4)));
typedef unsigned u32x4 __attribute__((ext_vector_type(4)));
constexpr int BM = 256, BK = 64, HALF = 128, HTB = HALF * BK * 2  , STAGE_BYTES = 8 * HTB, NXCD = 8, WGM = 8;

__host__ __device__ __forceinline__ int lds_byte(int r, int c) { const int st = (r >> 4) * 2 + (c >> 5), rr = r & 15, cc = c & 31, ob = rr * 64 + cc * 2; return st * 1024 + (ob ^ (((ob >> 9) & 1) << 5)); }
__host__ __device__ __forceinline__ void stage_rc(int b, int& R, int& C) { const int st = b / 1024, sb = b % 1024, swz = sb ^ (((sb >> 9) & 1) << 5); R = (st >> 1) * 16 + swz / 64; C = (st & 1) * 32 + (swz % 64) / 2; }
__host__ __device__ __forceinline__ int perm32(int rho) { const int n = rho >> 4, i = rho & 15; return 8 * (i >> 2) + 4 * n + (i & 3); }

struct Unit { int pm, pn; };
struct Gemm { const bf16_t* A; const bf16_t* Bt; int M, N, K; };

struct StaticOrder {
    int nM, nN, nwg, G, c;
    __host__ __device__ void init(int M, int N, int G_, int c_) { nM = M / BM; nN = N / BM; nwg = nM * nN; G = G_; c = c_; }
    __host__ __device__ bool next(int i, Unit& u) const {
        const long L = (long)i * G + c; if (L >= nwg) return false;
        int wgid = (int)L; { const int q = nwg / NXCD, r = nwg % NXCD, xcd = wgid % NXCD, off = wgid / NXCD; wgid = (xcd < r ? xcd * (q + 1) : r * (q + 1) + (xcd - r) * q) + off; }
        const int nig = WGM * nN, gid = wgid / nig, fm = gid * WGM, gsz = (nM - fm) < WGM ? (nM - fm) : WGM;
        u.pm = fm + ((wgid % nig) % gsz); u.pn = (wgid % nig) / gsz; return true;
    }
    __device__ __forceinline__ void a_ready(const Unit&) const {}
    __device__ __forceinline__ void done(const Unit&) const {}
};

__device__ __forceinline__ unsigned cvt_pk_bf16(float lo, float hi) { unsigned r; asm volatile("v_cvt_pk_bf16_f32 %0, %1, %2" : "=v"(r) : "v"(lo), "v"(hi)); return r; }
typedef float f32x2 __attribute__((ext_vector_type(2)));
__device__ __forceinline__ float rstd16(const float* ssq, int row) {
    const f32x4* p = (const f32x4*)(ssq + (size_t)row * 16);
    const f32x4 a = p[0], b = p[1], c = p[2], d = p[3];
    const float s = (((a[0] + a[1]) + (a[2] + a[3])) + ((b[0] + b[1]) + (b[2] + b[3]))) + (((c[0] + c[1]) + (c[2] + c[3])) + ((d[0] + d[1]) + (d[2] + d[3])));
    return __builtin_amdgcn_rsqf(s * (1.0f / 1024.0f) + 1e-6f);
}
struct EpiQKV {
    static constexpr bool PERM = true, AFTER_DRAIN = false;
    bf16_t *Q, *Kp, *V; int kvw; float qscale; const float* ssq;
    __device__ __forceinline__ void operator()(const f32x4 (&acc)[2][2][4][2], const Unit& u, int wr, int wc, int fr, int fq) const {
        int colt = u.pn * BM; bf16_t* base; int ld; float sc = 1.f;
        if (colt < 1024) { base = Q; ld = 1024; sc = qscale; } else if (colt < 1024 + kvw) { base = Kp; ld = kvw; colt -= 1024; } else { base = V; ld = kvw; colt -= 1024 + kvw; }
        const int col0 = colt + wc * 32 + 8 * fq, row0 = u.pm * BM + wr * 64 + fr;
#pragma unroll
        for (int ai = 0; ai < 2; ++ai)
#pragma unroll
            for (int m = 0; m < 4; ++m) { const int row = row0 + ai * HALF + m * 16; const float rs = rstd16(ssq, row) * sc; bf16_t* rowp = base + (size_t)row * ld + col0;
#pragma unroll
                for (int bj = 0; bj < 2; ++bj) { const f32x4 v0 = acc[ai][bj][m][0] * rs, v1 = acc[ai][bj][m][1] * rs;
                    u32x4 w; w.x = cvt_pk_bf16(v0[0], v0[1]); w.y = cvt_pk_bf16(v0[2], v0[3]); w.z = cvt_pk_bf16(v1[0], v1[1]); w.w = cvt_pk_bf16(v1[2], v1[3]);
                    *(u32x4*)(rowp + bj * HALF) = w; } }
    }
};
struct EpiUp {
    static constexpr bool PERM = true, AFTER_DRAIN = false;
    bf16_t* Hh; const float* ssq;
    __device__ __forceinline__ void operator()(const f32x4 (&acc)[2][2][4][2], const Unit& u, int wr, int wc, int fr, int fq) const {
        const int col0 = u.pn * BM + wc * 32 + 8 * fq, row0 = u.pm * BM + wr * 64 + fr;
#pragma unroll
        for (int ai = 0; ai < 2; ++ai)
#pragma unroll
            for (int m = 0; m < 4; ++m) { const int row = row0 + ai * HALF + m * 16; const float rs = rstd16(ssq, row); bf16_t* rowp = Hh + (size_t)row * 4096 + col0;
#pragma unroll
                for (int bj = 0; bj < 2; ++bj) { f32x4 v0 = acc[ai][bj][m][0] * rs, v1 = acc[ai][bj][m][1] * rs;
#pragma unroll
                    for (int e = 0; e < 4; ++e) { const float a = __builtin_fmaxf(v0[e], 0.f), b = __builtin_fmaxf(v1[e], 0.f); v0[e] = a * a; v1[e] = b * b; }
                    u32x4 w; w.x = cvt_pk_bf16(v0[0], v0[1]); w.y = cvt_pk_bf16(v0[2], v0[3]); w.z = cvt_pk_bf16(v1[0], v1[1]); w.w = cvt_pk_bf16(v1[2], v1[3]);
                    *(u32x4*)(rowp + bj * HALF) = w; } }
    }
};
struct EpiRes {
    static constexpr bool PERM = false, AFTER_DRAIN = false;
    const float* base; float* out; bf16_t* xb; float* ssq;
    __device__ __forceinline__ void operator()(const f32x4 (&acc)[2][2][4][2], const Unit& u, int wr, int wc, int fr, int fq) const {
        typedef unsigned u32x2v __attribute__((ext_vector_type(2)));
        const int col0 = u.pn * BM + wc * 32 + 4 * fq, row0 = u.pm * BM + wr * 64 + fr;
#pragma unroll
        for (int ai = 0; ai < 2; ++ai)
#pragma unroll
            for (int m = 0; m < 4; ++m) { const int row = row0 + ai * HALF + m * 16; const size_t off = (size_t)row * 1024 + col0; float s = 0.f;
#pragma unroll
                for (int bj = 0; bj < 2; ++bj)
#pragma unroll
                    for (int n = 0; n < 2; ++n) { const f32x4 bs = *(const f32x4*)(base + off + bj * HALF + n * 16); const f32x4 o = bs + acc[ai][bj][m][n];
                        *(f32x4*)(out + off + bj * HALF + n * 16) = o; s += (o[0] * o[0] + o[1] * o[1]) + (o[2] * o[2] + o[3] * o[3]);
                        u32x2v w; w.x = cvt_pk_bf16(o[0], o[1]); w.y = cvt_pk_bf16(o[2], o[3]); *(u32x2v*)(xb + off + bj * HALF + n * 16) = w; }
                s += __shfl_xor(s, 16); s += __shfl_xor(s, 32);
                if (fq == 0) ssq[(size_t)row * 16 + u.pn * 4 + wc] = s; }
    }
};
template <bool BASE_F32, bool OUT_F32> struct EpiRes2 {
    static constexpr bool PERM = true, AFTER_DRAIN = false;
    const float* basef; float* outf; bf16_t* xb; float* ssq;
    __device__ __forceinline__ void operator()(const f32x4 (&acc)[2][2][4][2], const Unit& u, int wr, int wc, int fr, int fq) const {
        const int col0 = u.pn * BM + wc * 32 + 8 * fq, row0 = u.pm * BM + wr * 64 + fr;
#pragma unroll
        for (int ai = 0; ai < 2; ++ai)
#pragma unroll
            for (int m = 0; m < 4; ++m) { const int row = row0 + ai * HALF + m * 16; const size_t off = (size_t)row * 1024 + col0; float s = 0.f;
#pragma unroll
                for (int bj = 0; bj < 2; ++bj) { f32x4 b0, b1;
                    if (BASE_F32) { b0 = *(const f32x4*)(basef + off + bj * HALF); b1 = *(const f32x4*)(basef + off + bj * HALF + 4); }
                    else { const u32x4 w = *(const u32x4*)(xb + off + bj * HALF);
                        b0 = (f32x4){__builtin_bit_cast(float, w.x << 16), __builtin_bit_cast(float, w.x & 0xffff0000u), __builtin_bit_cast(float, w.y << 16), __builtin_bit_cast(float, w.y & 0xffff0000u)};
                        b1 = (f32x4){__builtin_bit_cast(float, w.z << 16), __builtin_bit_cast(float, w.z & 0xffff0000u), __builtin_bit_cast(float, w.w << 16), __builtin_bit_cast(float, w.w & 0xffff0000u)}; }
                    const f32x4 o0 = b0 + acc[ai][bj][m][0], o1 = b1 + acc[ai][bj][m][1];
                    s += ((o0[0] * o0[0] + o0[1] * o0[1]) + (o0[2] * o0[2] + o0[3] * o0[3])) + ((o1[0] * o1[0] + o1[1] * o1[1]) + (o1[2] * o1[2] + o1[3] * o1[3]));
                    if (OUT_F32) { *(f32x4*)(outf + off + bj * HALF) = o0; *(f32x4*)(outf + off + bj * HALF + 4) = o1; }
                    else { u32x4 w; w.x = cvt_pk_bf16(o0[0], o0[1]); w.y = cvt_pk_bf16(o0[2], o0[3]); w.z = cvt_pk_bf16(o1[0], o1[1]); w.w = cvt_pk_bf16(o1[2], o1[3]); *(u32x4*)(xb + off + bj * HALF) = w; } }
                s += __shfl_xor(s, 16); s += __shfl_xor(s, 32);
                if (fq == 0) ssq[(size_t)row * 16 + u.pn * 4 + wc] = s; }
    }
};
template <class Epi, class Sched, bool ALIGN_EPI = false, bool SP2 = false>
__device__ __forceinline__ void gemm_phase(PG8_LAS unsigned char* lds, const Gemm g, const Sched& S, const Epi& E) {
    const int tid = threadIdx.x, wid = __builtin_amdgcn_readfirstlane(tid >> 6), lane = tid & 63, wr = wid >> 2, wc = wid & 3, fr = lane & 15, fq = lane >> 4;
    const int K = g.K, nt = K / BK;
    unsigned voffA[2], voffB[2];
#pragma unroll
    for (int i = 0; i < 2; ++i) { int R, C; stage_rc(tid * 16 + i * 8192, R, C); const int Rb = Epi::PERM ? ((R & ~31) + perm32(R & 31)) : R;
        voffA[i] = (unsigned)(R * K + C) * 2u; voffB[i] = (unsigned)(Rb * K + C) * 2u; }
    const size_t kstep = (size_t)(BK * 2);
    const size_t hstep = (size_t)HALF * K * 2;
    const size_t tstep = 2 * hstep;
    const unsigned ldsw = (unsigned)wid * 1024u;
    const int aoff = lds_byte(wr * 64 + fr, fq * 8), boff = lds_byte(wc * 32 + fr, fq * 8);
#define PG8_SA(b, h) (((b) * 2 + (h)) * HTB)
#define PG8_SB(b, h) ((4 + (b) * 2 + (h)) * HTB)
#define PG8_STAGE(bufoff, gbase, voff) do { _Pragma("unroll") for (int _i = 0; _i < 2; ++_i) \
        __builtin_amdgcn_global_load_lds((const unsigned*)((const char*)(gbase) + (voff)[_i]), (PG8_LAS unsigned*)(lds + (bufoff) + ldsw + _i * 8192), 16, 0, 0); } while (0)
#define PG8_LDA(dst, b, h) do { _Pragma("unroll") for (int m = 0; m < 4; ++m) _Pragma("unroll") for (int k = 0; k < 2; ++k) dst[m][k] = *(const PG8_LAS bf16x8*)(lds + PG8_SA(b, h) + aoff + m * 2048 + k * 1024); } while (0)
#define PG8_LDB(dst, b, h) do { _Pragma("unroll") for (int n = 0; n < 2; ++n) _Pragma("unroll") for (int k = 0; k < 2; ++k) dst[n][k] = *(const PG8_LAS bf16x8*)(lds + PG8_SB(b, h) + boff + n * 2048 + k * 1024); } while (0)
#define PG8_MMA(ai, bj, At, Bt) do { __builtin_amdgcn_s_setprio(1); _Pragma("unroll") for (int m = 0; m < 4; ++m) _Pragma("unroll") for (int n = 0; n < 2; ++n) _Pragma("unroll") for (int k = 0; k < 2; ++k) \
        acc[ai][bj][m][n] = __builtin_amdgcn_mfma_f32_16x16x32_bf16(Bt[n][k], At[m][k], acc[ai][bj][m][n], 0, 0, 0); __builtin_amdgcn_s_setprio(0); } while (0)
#define PG8_WAIT_V(n) asm volatile("s_waitcnt vmcnt(" #n ")" ::: "memory")
#define PG8_WAIT_L(n) asm volatile("s_waitcnt lgkmcnt(" #n ")" ::: "memory")
#define PG8_BAR __builtin_amdgcn_s_barrier()
#define PG8_SCHED __builtin_amdgcn_sched_barrier(0)
    Unit cur, nxt; int ui = 0;
    if (!S.next(0, cur)) return;
    f32x4 acc[2][2][4][2];
#pragma unroll
    for (int a = 0; a < 2; ++a)
#pragma unroll
        for (int b = 0; b < 2; ++b)
#pragma unroll
            for (int m = 0; m < 4; ++m)
#pragma unroll
                for (int n = 0; n < 2; ++n) acc[a][b][m][n] = (f32x4){0.f, 0.f, 0.f, 0.f};
    bf16x8 At[4][2], B0[2][2], B1[2][2];
    const char* cA = (const char*)g.A + (size_t)cur.pm * tstep; const char* cB = (const char*)g.Bt + (size_t)cur.pn * tstep;
    S.a_ready(cur);
    if constexpr (SP2) {
        PG8_STAGE(PG8_SB(0, 0), cB, voffB); PG8_STAGE(PG8_SB(0, 1), cB + hstep, voffB); PG8_STAGE(PG8_SA(0, 0), cA, voffA); PG8_STAGE(PG8_SA(0, 1), cA + hstep, voffA);
        if (wr == 1) PG8_BAR;
        PG8_WAIT_V(2); PG8_BAR;
        PG8_STAGE(PG8_SB(1, 0), cB + kstep, voffB); PG8_STAGE(PG8_SA(1, 0), cA + kstep, voffA); PG8_STAGE(PG8_SB(1, 1), cB + hstep + kstep, voffB);
        PG8_WAIT_V(6); PG8_BAR;
    } else {
        PG8_STAGE(PG8_SB(0, 0), cB, voffB); PG8_STAGE(PG8_SA(0, 0), cA, voffA); PG8_STAGE(PG8_SB(0, 1), cB + hstep, voffB); PG8_STAGE(PG8_SA(0, 1), cA + hstep, voffA);
        if (wr == 1) PG8_BAR;
        PG8_WAIT_V(4); PG8_BAR;
        PG8_STAGE(PG8_SB(1, 0), cB + kstep, voffB); PG8_STAGE(PG8_SA(1, 0), cA + kstep, voffA); PG8_STAGE(PG8_SB(1, 1), cB + hstep + kstep, voffB);
        PG8_WAIT_V(6); PG8_BAR;
    }
    for (;;) {
        const bool has_next = S.next(ui + 1, nxt);
        const char* nA = has_next ? (const char*)g.A + (size_t)nxt.pm * tstep : cA; const char* nB = has_next ? (const char*)g.Bt + (size_t)nxt.pn * tstep : cB;
        for (int t = 0; t < nt; t += 2) {
            const bool last = (t == nt - 2);
            const char* a1 = cA + (size_t)(t + 1) * kstep;
            const char* a2 = last ? nA : cA + (size_t)(t + 2) * kstep; const char* b2 = last ? nB : cB + (size_t)(t + 2) * kstep;
            const char* a3 = a2 + kstep; const char* b3 = b2 + kstep;
            if (last && has_next) S.a_ready(nxt);
            if constexpr (SP2) {
            PG8_LDB(B0, 0, 0); PG8_LDB(B1, 0, 1); PG8_SCHED; PG8_LDA(At, 0, 0); PG8_STAGE(PG8_SA(1, 1), a1 + hstep, voffA);
            PG8_WAIT_V(8); PG8_WAIT_L(0); PG8_BAR; PG8_MMA(0, 0, At, B0); PG8_MMA(0, 1, At, B1); PG8_BAR; PG8_SCHED;
            PG8_LDA(At, 0, 1); PG8_STAGE(PG8_SB(0, 0), b2, voffB); PG8_STAGE(PG8_SB(0, 1), b2 + hstep, voffB); PG8_STAGE(PG8_SA(0, 0), a2, voffA);
            PG8_WAIT_V(8); PG8_WAIT_L(0); PG8_BAR; PG8_MMA(1, 0, At, B0); PG8_MMA(1, 1, At, B1); PG8_BAR; PG8_SCHED;
            PG8_LDB(B0, 1, 0); PG8_LDB(B1, 1, 1); PG8_SCHED; PG8_LDA(At, 1, 0); PG8_STAGE(PG8_SA(0, 1), a2 + hstep, voffA);
            PG8_WAIT_V(8); PG8_WAIT_L(0); PG8_BAR; PG8_MMA(0, 0, At, B0); PG8_MMA(0, 1, At, B1); PG8_BAR; PG8_SCHED;
            PG8_LDA(At, 1, 1); PG8_STAGE(PG8_SB(1, 0), b3, voffB); PG8_STAGE(PG8_SB(1, 1), b3 + hstep, voffB); PG8_STAGE(PG8_SA(1, 0), a3, voffA);
            PG8_WAIT_V(8); PG8_WAIT_L(0); PG8_BAR; PG8_MMA(1, 0, At, B0); PG8_MMA(1, 1, At, B1); PG8_BAR; PG8_SCHED;
            } else {
            PG8_LDB(B0, 0, 0); PG8_SCHED; PG8_LDA(At, 0, 0); PG8_STAGE(PG8_SA(1, 1), a1 + hstep, voffA);
            PG8_WAIT_L(8); PG8_BAR; PG8_WAIT_L(0); PG8_MMA(0, 0, At, B0); PG8_BAR; PG8_SCHED;
            PG8_LDB(B1, 0, 1); PG8_STAGE(PG8_SB(0, 0), b2, voffB);
            PG8_BAR; PG8_WAIT_L(0); PG8_MMA(0, 1, At, B1); PG8_BAR;
            PG8_LDA(At, 0, 1); PG8_STAGE(PG8_SA(0, 0), a2, voffA);
            PG8_BAR; PG8_WAIT_L(0); PG8_MMA(1, 0, At, B0); PG8_BAR; PG8_SCHED;
            PG8_STAGE(PG8_SB(0, 1), b2 + hstep, voffB);
            PG8_WAIT_V(6); PG8_BAR; PG8_MMA(1, 1, At, B1); PG8_BAR;
            PG8_LDB(B0, 1, 0); PG8_SCHED; PG8_LDA(At, 1, 0); PG8_STAGE(PG8_SA(0, 1), a2 + hstep, voffA);
            PG8_WAIT_L(8); PG8_BAR; PG8_WAIT_L(0); PG8_MMA(0, 0, At, B0); PG8_BAR; PG8_SCHED;
            PG8_LDB(B1, 1, 1); PG8_STAGE(PG8_SB(1, 0), b3, voffB);
            PG8_BAR; PG8_WAIT_L(0); PG8_MMA(0, 1, At, B1); PG8_BAR;
            PG8_LDA(At, 1, 1); PG8_STAGE(PG8_SA(1, 0), a3, voffA);
            PG8_BAR; PG8_WAIT_L(0); PG8_MMA(1, 0, At, B0); PG8_BAR; PG8_SCHED;
            PG8_STAGE(PG8_SB(1, 1), b3 + hstep, voffB);
            PG8_WAIT_V(6); PG8_BAR; PG8_MMA(1, 1, At, B1); PG8_BAR;
            }
        }
        if constexpr (ALIGN_EPI) { if (wr == 0) PG8_BAR; }
        if constexpr (!Epi::AFTER_DRAIN) { E(acc, cur, wr, wc, fr, fq); S.done(cur); }
        if (!has_next) break;
#pragma unroll
        for (int a = 0; a < 2; ++a)
#pragma unroll
            for (int b = 0; b < 2; ++b)
#pragma unroll
                for (int m = 0; m < 4; ++m)
#pragma unroll
                    for (int n = 0; n < 2; ++n) acc[a][b][m][n] = (f32x4){0.f, 0.f, 0.f, 0.f};
        cur = nxt; cA = nA; cB = nB; ++ui;
        if constexpr (ALIGN_EPI) { if (wr == 1) PG8_BAR; }
    }
    PG8_WAIT_V(0);
    if constexpr (!ALIGN_EPI) { if (wr == 0) PG8_BAR; }
    PG8_BAR;
    if constexpr (Epi::AFTER_DRAIN) { E.fused(acc, cur, wr, wc, fr, fq, lds, wid, lane); S.done(cur); }
#undef PG8_SA
#undef PG8_SB
#undef PG8_STAGE
#undef PG8_LDA
#undef PG8_LDB
#undef PG8_MMA
#undef PG8_WAIT_V
#undef PG8_WAIT_L
#undef PG8_BAR
#undef PG8_SCHED
}
}

#define GAS __attribute__((address_space(1)))
#define LAS __attribute__((address_space(3)))
typedef unsigned v4u __attribute__((ext_vector_type(4)));
typedef float f32x4 __attribute__((ext_vector_type(4)));
typedef short bf16x8 __attribute__((ext_vector_type(8)));
typedef GAS unsigned gu32;
typedef GAS unsigned long long gu64;
#define RLX_AGENT __ATOMIC_RELAXED, __HIP_MEMORY_SCOPE_AGENT
#define LDS_WAIT() asm volatile("s_waitcnt lgkmcnt(0)" ::: "memory")
#define VM_WAIT() asm volatile("s_waitcnt vmcnt(0)" ::: "memory")
__device__ __forceinline__ unsigned long long rt() { return __builtin_amdgcn_s_memrealtime(); }
__device__ __forceinline__ unsigned pk2(float lo, float hi) { return f2bf(lo) | (f2bf(hi) << 16); }

#define XB_TMO      128
#define XB_XCNT(j)  (256  + 64 * (j))
#define XB_XSUB(j)  (1280 + 64 * (j))
#define XB_XGEN(j)  (2304 + 64 * (j))
#define XB_TOP      3328
#define XB_TOPGEN   3392
#define XCD_BAR_WORDS 3456
#define XB_SPIN_CAP (1u << 18)

__device__ __forceinline__ unsigned xb_ld(unsigned* p)              { return __hip_atomic_load(p, __ATOMIC_RELAXED, __HIP_MEMORY_SCOPE_AGENT); }
__device__ __forceinline__ unsigned xb_add(unsigned* p, unsigned v) { return __hip_atomic_fetch_add(p, v, __ATOMIC_RELAXED, __HIP_MEMORY_SCOPE_AGENT); }
__device__ __forceinline__ unsigned xb_xcc_id() { return (unsigned)__builtin_amdgcn_s_getreg((3 << 11) | 20) & 0xFu; }
#define XB_SPIN(cond, bar) do { unsigned _sp = 0; while (cond) { __builtin_amdgcn_s_sleep(1); \
    if ((++_sp & 255u) == 0u) { if (xb_ld(&(bar)[XB_TMO])) break; if (_sp > XB_SPIN_CAP) { atomicAdd(&(bar)[XB_TMO], 1u); break; } } } } while (0)

struct XcdBarrier {
    unsigned* bar; unsigned x;
    volatile LAS unsigned* st;
};

__device__ __forceinline__ XcdBarrier xcd_barrier_post(unsigned* bar, volatile LAS unsigned* st) {
    XcdBarrier b; b.bar = bar; b.x = xb_xcc_id(); b.st = st;
    if (threadIdx.x == 0) (void)xb_add(&bar[XB_XCNT(b.x)], 1u);
    return b;
}
__device__ __forceinline__ void xcd_barrier_complete(unsigned* bar, unsigned x, unsigned& nloc, unsigned& nx) {
    const unsigned G = gridDim.x * gridDim.y * gridDim.z;
    unsigned sum, cnt, mine, sp = 0u;
    for (;;) {
        sum = 0u; cnt = 0u; mine = 0u;
#pragma unroll
        for (unsigned j = 0; j < 16; ++j) { const unsigned c = xb_ld(&bar[XB_XCNT(j)]); sum += c; cnt += (c > 0u) ? 1u : 0u; mine = (j == x) ? c : mine; }
        if (sum == G) break;
        __builtin_amdgcn_s_sleep(1);
        if ((++sp & 255u) == 0u) { if (xb_ld(&bar[XB_TMO])) break; if (sp > XB_SPIN_CAP) { atomicAdd(&bar[XB_TMO], 1u); break; } }
    }
    nloc = mine > 0u ? mine : 1u; nx = cnt > 0u ? cnt : 1u;
}

__device__ __forceinline__ void xcd_barrier(const XcdBarrier& b) {
    asm volatile("s_waitcnt vmcnt(0)" ::: "memory");
    __syncthreads();
    if (threadIdx.x == 0) {
        unsigned* bar = b.bar;
        __builtin_amdgcn_s_waitcnt(0);
        unsigned nloc = b.st[0], nx = b.st[1];
        if (nloc == 0u) { xcd_barrier_complete(bar, b.x, nloc, nx); b.st[0] = nloc; b.st[1] = nx; }
        const unsigned old = xb_add(&bar[XB_XSUB(b.x)], 1u);
        const unsigned gen = old / nloc;
        if (old + 1u == (gen + 1u) * nloc) {
            __builtin_amdgcn_fence(__ATOMIC_RELEASE, "agent");
            asm volatile("s_waitcnt vmcnt(0)" ::: "memory");
            const unsigned og = xb_add(&bar[XB_TOP], 1u);
            const unsigned tg = og / nx;
            if (og + 1u == (tg + 1u) * nx) xb_add(&bar[XB_TOPGEN], 1u);
            else XB_SPIN(xb_ld(&bar[XB_TOPGEN]) == tg, bar);
            __builtin_amdgcn_fence(__ATOMIC_ACQUIRE, "agent");
            xb_add(&bar[XB_XGEN(b.x)], 1u);
            asm volatile("s_waitcnt vmcnt(0)" ::: "memory");
        } else {
            XB_SPIN(xb_ld(&bar[XB_XGEN(b.x)]) == gen, bar);
            __builtin_amdgcn_fence(__ATOMIC_ACQUIRE, "agent");
            asm volatile("s_waitcnt vmcnt(0)" ::: "memory");
        }
    }
    __syncthreads();
}

namespace att {
typedef short bf16x8 __attribute__((ext_vector_type(8)));
typedef short s16x4 __attribute__((ext_vector_type(4)));
typedef float f32x4 __attribute__((ext_vector_type(4)));
typedef unsigned u32x2 __attribute__((ext_vector_type(2)));
typedef LAS const char* lptr;
constexpr int SLOT = 16384, NS = 7, PD = 5, TBL_OFF = NS * SLOT;
constexpr float NEG = -INFINITY;
__device__ __forceinline__ int fK(int t) { return (t >> 1) & 7; }
__device__ __forceinline__ int fV(int t) { return (((t >> 1) & 3) << 1) | ((t >> 3) & 1); }
__device__ __forceinline__ s16x4 vtr(lptr p) { typedef short v4i16_t __attribute__((ext_vector_type(4))); return __builtin_bit_cast(s16x4, __builtin_amdgcn_ds_read_tr16_b64_v4i16((LAS v4i16_t*)p)); }
__device__ __forceinline__ unsigned cvtpk(float lo, float hi) { unsigned r; asm volatile("v_cvt_pk_bf16_f32 %0, %1, %2" : "=v"(r) : "v"(lo), "v"(hi)); return r; }
__device__ __forceinline__ float xor16(float v) { return __builtin_bit_cast(float, __builtin_amdgcn_ds_swizzle(__builtin_bit_cast(int, v), 0x401F)); }
__device__ __forceinline__ float xor32(float v) { return __shfl_xor(v, 32); }

struct Item { bf16x8 q0, q1; f32x4 o0, o1, o2, o3; float m, l; int ka, va; };
__device__ __forceinline__ void item_init(Item& it, float m0, float l0) { it.o0 = it.o1 = it.o2 = it.o3 = (f32x4){0.f, 0.f, 0.f, 0.f}; it.m = m0; it.l = l0; }
__device__ __forceinline__ void item_addr(Item& it, int w0, int lane) {
    const int fr = lane & 15, fq = lane >> 4, rk = w0 + fr, rv = w0 + 4 * fq + (fr >> 2);
    it.ka = rk * 128 + ((fq ^ fK(rk)) << 4);
    it.va = 8192 + rv * 128 + (((((fr & 3) >> 1)) ^ fV(rv)) << 4) + 8 * (fr & 1);
}
__device__ __forceinline__ void half_step(Item& it, lptr slot, f32x4 b0, f32x4 b1) {
    lptr kp = slot + it.ka;
    const bf16x8 k00 = *(const LAS bf16x8*)(kp), k01 = *(const LAS bf16x8*)(kp + 2048);
    lptr kp1 = slot + (it.ka ^ 64);
    const bf16x8 k10 = *(const LAS bf16x8*)(kp1), k11 = *(const LAS bf16x8*)(kp1 + 2048);
    f32x4 s0 = __builtin_amdgcn_mfma_f32_16x16x32_bf16(k00, it.q0, b0, 0, 0, 0);
    f32x4 s1 = __builtin_amdgcn_mfma_f32_16x16x32_bf16(k01, it.q0, b1, 0, 0, 0);
    s0 = __builtin_amdgcn_mfma_f32_16x16x32_bf16(k10, it.q1, s0, 0, 0, 0);
    s1 = __builtin_amdgcn_mfma_f32_16x16x32_bf16(k11, it.q1, s1, 0, 0, 0);
    float mx = __builtin_fmaxf(__builtin_fmaxf(__builtin_fmaxf(s0[0], s0[1]), __builtin_fmaxf(s0[2], s0[3])), __builtin_fmaxf(__builtin_fmaxf(s1[0], s1[1]), __builtin_fmaxf(s1[2], s1[3])));
    mx = __builtin_fmaxf(mx, xor16(mx)); mx = __builtin_fmaxf(mx, xor32(mx));
    const float mn = __builtin_fmaxf(it.m, mx), al = __builtin_amdgcn_exp2f(it.m - mn);
    it.m = mn;
#pragma unroll
    for (int e = 0; e < 4; ++e) { s0[e] = __builtin_amdgcn_exp2f(s0[e] - mn); s1[e] = __builtin_amdgcn_exp2f(s1[e] - mn); }
    it.l = it.l * al + (((s0[0] + s0[1]) + (s0[2] + s0[3])) + ((s1[0] + s1[1]) + (s1[2] + s1[3])));
    it.o0 *= al; it.o1 *= al; it.o2 *= al; it.o3 *= al;
    typedef unsigned u32x4 __attribute__((ext_vector_type(4)));
    u32x4 pw; pw.x = cvtpk(s0[0], s0[1]); pw.y = cvtpk(s0[2], s0[3]); pw.z = cvtpk(s1[0], s1[1]); pw.w = cvtpk(s1[2], s1[3]);
    const bf16x8 pf = __builtin_bit_cast(bf16x8, pw);
#define ATT_PV(dt, O) do { lptr vp = slot + (it.va ^ ((dt) << 5)); const s16x4 lo = vtr(vp), hi = vtr(vp + 2048); \
        const bf16x8 vf = (bf16x8){lo[0], lo[1], lo[2], lo[3], hi[0], hi[1], hi[2], hi[3]}; O = __builtin_amdgcn_mfma_f32_16x16x32_bf16(vf, pf, O, 0, 0, 0); } while (0)
    ATT_PV(0, it.o0); ATT_PV(1, it.o1); ATT_PV(2, it.o2); ATT_PV(3, it.o3);
#undef ATT_PV
}
__device__ __forceinline__ void item_store(Item& it, bf16* orow, int lane) {
    float l = it.l; l += xor16(l); l += xor32(l);
    const float rl = 1.0f / l; const int fq = lane >> 4;
    u32x2 w;
    w.x = cvtpk(it.o0[0] * rl, it.o0[1] * rl); w.y = cvtpk(it.o0[2] * rl, it.o0[3] * rl); *(u32x2*)(orow + 0 + 4 * fq) = w;
    w.x = cvtpk(it.o1[0] * rl, it.o1[1] * rl); w.y = cvtpk(it.o1[2] * rl, it.o1[3] * rl); *(u32x2*)(orow + 16 + 4 * fq) = w;
    w.x = cvtpk(it.o2[0] * rl, it.o2[1] * rl); w.y = cvtpk(it.o2[2] * rl, it.o2[3] * rl); *(u32x2*)(orow + 32 + 4 * fq) = w;
    w.x = cvtpk(it.o3[0] * rl, it.o3[1] * rl); w.y = cvtpk(it.o3[2] * rl, it.o3[3] * rl); *(u32x2*)(orow + 48 + 4 * fq) = w;
}
__device__ __forceinline__ void glds16(const void* gsrc, unsigned lds_dst) { unsigned keep;
    asm volatile("s_mov_b32 %0, m0\n\ts_mov_b32 m0, %2\n\ts_nop 0\n\tglobal_load_lds_dwordx4 %1, off\n\ts_mov_b32 m0, %0" : "=&s"(keep) : "v"(gsrc), "s"(lds_dst) : "memory"); }
__device__ __forceinline__ void dma_row(LAS unsigned char* L, int slot, int wid, const bf16* ksrc, const bf16* vsrc) {
    const unsigned d = (unsigned)__builtin_amdgcn_readfirstlane((int)(unsigned)(uintptr_t)(L + slot * SLOT + wid * 1024));
    glds16(ksrc, d); glds16(vsrc, d + 8192u);
}
#define ATT_WAITV(n) asm volatile("s_waitcnt vmcnt(" #n ")" ::: "memory")
#define ATT_BAR() do { asm volatile("s_waitcnt lgkmcnt(0)" ::: "memory"); __builtin_amdgcn_s_barrier(); asm volatile("" ::: "memory"); } while (0)
__device__ __forceinline__ void wait_rows_in_flight(int n) {
    if (n >= 5) ATT_WAITV(10); else if (n == 4) ATT_WAITV(8); else if (n == 3) ATT_WAITV(6); else if (n == 2) ATT_WAITV(4); else if (n == 1) ATT_WAITV(2); else ATT_WAITV(0);
}

template <int MODE> __device__ __forceinline__ void na_phase(LAS unsigned char* L, const bf16* Q, const bf16* K, const bf16* V, bf16* O, const float* rpb, int vcu, int G) {
    const int tid = threadIdx.x, lane = tid & 63, wid = __builtin_amdgcn_readfirstlane(tid >> 6), fr = lane & 15, fq = lane >> 4;
    LAS float* tb = (LAS float*)(L + TBL_OFF);
    const int tok = wid * 8 + (lane >> 3), cp = lane & 7;
    constexpr int NUNITS = BATCH * NH * (ROWS / 4);
    for (int u = vcu; u < NUNITS; u += G) {
        const int rg = u % (ROWS / 4), h = (u / (ROWS / 4)) % NH, b = u / (ROWS / 4 * NH), r0 = rg * 4;
        const int clo = r0 - 4 < 0 ? 0 : r0 - 4, chi_ = r0 + 3 - 4 > ROWS - KR ? ROWS - KR : r0 + 3 - 4, klo = clo > ROWS - KR ? ROWS - KR : clo, khi = (chi_ < 0 ? 0 : chi_) + KR - 1, nt = khi - klo + 1;
        const bf16* kbase = K + ((size_t)b * SEQ + (size_t)klo * GW) * D + h * HD; const bf16* vbase = V + ((size_t)b * SEQ + (size_t)klo * GW) * D + h * HD;
        const bf16* ksrc = kbase + (size_t)tok * D + ((cp ^ fK(tok)) << 3); const bf16* vsrc = vbase + (size_t)tok * D + ((cp ^ fV(tok)) << 3);
        ATT_BAR();
        if (MODE != 2) for (int t = 0; t < PD && t < nt; ++t) dma_row(L, t % NS, wid, ksrc + (size_t)t * GW * D, vsrc + (size_t)t * GW * D);
        for (int i = tid; i < 15 * 64; i += 512) { const int dr = i >> 6, dc = (i & 63) - 16; tb[i] = (dc >= 0 && dc < 31) ? rpb[(h * 15 + dr) * 31 + dc] * LOG2E : 0.f; }
        const int r = r0 + (wid >> 1); int rs = r - KR / 2; rs = rs < 0 ? 0 : (rs > ROWS - KR ? ROWS - KR : rs);
        Item it[2]; int tbi[2]; f32x4 mk[2][2];
#pragma unroll
        for (int i = 0; i < 2; ++i) {
            const int ct = 2 * (wid & 1) + i, w0 = ct == 0 ? 0 : ct == 1 ? 8 : ct == 2 ? 24 : 32, c = ct * 16 + fr; int cs = c - KC / 2; cs = cs < 0 ? 0 : (cs > GW - KC ? GW - KC : cs);
            const bf16* qp = Q + ((size_t)b * SEQ + (size_t)r * GW + c) * D + h * HD + 8 * fq;
            it[i].q0 = *(const bf16x8*)qp; it[i].q1 = *(const bf16x8*)(qp + 32);
            item_init(it[i], -1e30f, 0.f); item_addr(it[i], w0, lane);
            tbi[i] = 16 + w0 + 4 * fq - c + 15;
            const int dl = w0 + 4 * fq - cs;
#pragma unroll
            for (int kt = 0; kt < 2; ++kt)
#pragma unroll
                for (int e = 0; e < 4; ++e) { const int x = dl + 16 * kt + e; mk[i][kt][e] = (x >= 0 && x <= 15) ? 0.f : NEG; }
        }
        __builtin_amdgcn_s_waitcnt(0x0F70);
        for (int t = 0; t < nt; ++t) {
            if (MODE != 2 && t + PD < nt) dma_row(L, (t + PD) % NS, wid, ksrc + (size_t)(t + PD) * GW * D, vsrc + (size_t)(t + PD) * GW * D);
            if (MODE != 2) wait_rows_in_flight(nt - 1 - t < PD ? nt - 1 - t : PD);
            ATT_BAR();
            const int kr = klo + t;
            if (MODE != 1 && kr >= rs && kr < rs + KR) {
                lptr slot = (lptr)(L + (t % NS) * SLOT); const int dr = kr - r + KR - 1;
#pragma unroll
                for (int i = 0; i < 2; ++i) { const LAS float* bp = tb + dr * 64 + tbi[i];
                    f32x4 b0, b1;
#pragma unroll
                    for (int e = 0; e < 4; ++e) { b0[e] = bp[e] + mk[i][0][e]; b1[e] = bp[16 + e] + mk[i][1][e]; }
                    half_step(it[i], slot, b0, b1); }
            }
        }
        if (MODE != 1)
#pragma unroll
        for (int i = 0; i < 2; ++i) { const int c = (2 * (wid & 1) + i) * 16 + fr; item_store(it[i], O + ((size_t)b * SEQ + (size_t)r * GW + c) * D + h * HD, lane); }
        ATT_WAITV(0);
    }
}

__device__ __forceinline__ void swa_phase(LAS unsigned char* L, const bf16* Q, const bf16* K, const bf16* V, bf16* O, const float* tblg, int vcu, int G) {
    const int tid = threadIdx.x, lane = tid & 63, wid = __builtin_amdgcn_readfirstlane(tid >> 6), fr = lane & 15, fq = lane >> 4;
    LAS float* tb = (LAS float*)(L + TBL_OFF);
    const int tok = wid * 8 + (lane >> 3), cp = lane & 7;
    constexpr int NQB = SEQ / 64, NUNITS = BATCH * KVH * NQB, KVW = KVH * HD;
    for (int u = vcu; u < NUNITS; u += G) {
        const int qb = u % NQB, kv = (u / NQB) % KVH, b = u / (NQB * KVH);
        const int clo = qb - 2 < 0 ? 0 : qb - 2, chi_ = qb + 2 > NQB - 1 ? NQB - 1 : qb + 2, nt = chi_ - clo + 1;
        const bf16* kbase = K + ((size_t)b * SEQ + (size_t)clo * 64) * KVW + kv * HD; const bf16* vbase = V + ((size_t)b * SEQ + (size_t)clo * 64) * KVW + kv * HD;
        const bf16* ksrc = kbase + (size_t)tok * KVW + ((cp ^ fK(tok)) << 3); const bf16* vsrc = vbase + (size_t)tok * KVW + ((cp ^ fV(tok)) << 3);
        ATT_BAR();
        for (int t = 0; t < PD && t < nt; ++t) dma_row(L, t % NS, wid, ksrc + (size_t)t * 64 * KVW, vsrc + (size_t)t * 64 * KVW);
        for (int i = tid; i < 4 * 384; i += 512) { const int g = i / 384, rel = i % 384 - 192; tb[i] = (rel >= -WINDOW && rel <= WINDOW) ? tblg[(kv * 4 + g) * 257 + rel + WINDOW] : NEG; }
        const int g = wid >> 1, hq = kv * 4 + g; const float sink2 = tblg[16 * 257 + hq];
        Item it[2]; int tbi[2];
#pragma unroll
        for (int i = 0; i < 2; ++i) {
            const int qt = 2 * (wid & 1) + i;
            const bf16* qp = Q + ((size_t)b * SEQ + (size_t)qb * 64 + qt * 16 + fr) * D + hq * HD + 8 * fq;
            it[i].q0 = *(const bf16x8*)qp; it[i].q1 = *(const bf16x8*)(qp + 32);
            item_init(it[i], sink2, fq == 0 ? 1.f : 0.f); item_addr(it[i], 0, lane);
            tbi[i] = g * 384 + 192 + 4 * fq - 16 * qt - fr;
        }
        __builtin_amdgcn_s_waitcnt(0x0F70);
        for (int t = 0; t < nt; ++t) {
            if (t + PD < nt) dma_row(L, (t + PD) % NS, wid, ksrc + (size_t)(t + PD) * 64 * KVW, vsrc + (size_t)(t + PD) * 64 * KVW);
            wait_rows_in_flight(nt - 1 - t < PD ? nt - 1 - t : PD);
            ATT_BAR();
            const int cb = clo + t; lptr slot = (lptr)(L + (t % NS) * SLOT);
#pragma unroll
            for (int hs = 0; hs < 2; ++hs)
#pragma unroll
                for (int i = 0; i < 2; ++i) { const int qt = 2 * (wid & 1) + i, k0 = 64 * cb + 32 * hs, tq0 = 64 * qb + 16 * qt;
                    if (k0 + 31 >= tq0 - WINDOW && k0 <= tq0 + 15 + WINDOW) {
                        const LAS float* bp = tb + tbi[i] + 64 * (cb - qb) + 32 * hs;
                        f32x4 b0, b1;
#pragma unroll
                        for (int e = 0; e < 4; ++e) { b0[e] = bp[e]; b1[e] = bp[16 + e]; }
                        half_step(it[i], slot + hs * 4096, b0, b1); } }
        }
#pragma unroll
        for (int i = 0; i < 2; ++i) { const int qt = 2 * (wid & 1) + i; item_store(it[i], O + ((size_t)b * SEQ + (size_t)qb * 64 + qt * 16 + fr) * D + hq * HD, lane); }
        ATT_WAITV(0);
    }
}
#undef ATT_WAITV
#undef ATT_BAR
}

#ifndef PG8_SP2
#define PG8_SP2 true
#endif
#ifndef PG8_ALIGN
#define PG8_ALIGN true
#endif
#ifndef MK_N_LAUNCHES
#define MK_N_LAUNCHES 1
#endif
constexpr int NWAVES = 8;
constexpr int RING_OFF = 0, RING_BYTES = 131072, LDSCTL_OFF = RING_BYTES, MISC_OFF = LDSCTL_OFF + 320, LDS_BYTES = 147456;
constexpr int CW_BAR = 4096;
constexpr int NPHASE = 12;

__device__ __forceinline__ void p0_transpose_item(const float* W, const float* g, int K, int N, bf16* WT, LAS float* scr, int item, int lane) {
    const int nblk = N / 32, kb = item / nblk, nb = item % nblk, k0 = 64 * kb, n0 = 32 * nb;
#pragma unroll 8
    for (int i = 0; i < 32; ++i) { const int kk = 2 * i + (lane >> 5); scr[kk * 33 + (lane & 31)] = W[(size_t)(k0 + kk) * N + n0 + (lane & 31)] * (g ? g[k0 + kk] : 1.0f); }
    LDS_WAIT(); asm volatile("" ::: "memory");
    const int c = lane & 7;
#pragma unroll
    for (int j = 0; j < 4; ++j) { const int n = (lane >> 3) + 8 * j; const LAS float* s = scr + (8 * c) * 33 + n;
        v4u o; o.x = pk2(s[0 * 33], s[1 * 33]); o.y = pk2(s[2 * 33], s[3 * 33]); o.z = pk2(s[4 * 33], s[5 * 33]); o.w = pk2(s[6 * 33], s[7 * 33]);
        *(GAS v4u*)(WT + (size_t)(n0 + n) * K + k0 + 8 * c) = o; }
    LDS_WAIT(); asm volatile("" ::: "memory");
}

struct Args { const float* in[13]; float* out; unsigned char* ws; int ph_lo, ph_hi; };
__global__ void __launch_bounds__(NWAVES * 64, 2) mk_fwd(Args args) {
    extern __shared__ __attribute__((aligned(16))) unsigned char lds[];
    LAS unsigned char* L = (LAS unsigned char*)lds;
    volatile LAS unsigned* MISC = (volatile LAS unsigned*)(L + MISC_OFF);
    const int tid = threadIdx.x, lane = tid & 63, wave = __builtin_amdgcn_readfirstlane(tid >> 6);
    unsigned char* ws = args.ws;
    gu32* ctl = (gu32*)(ws + WS_CTL);
    float* ssq = (float*)(ws + WS_SSQ); float* tblg = (float*)(ws + WS_TBL);
    bf16 *Wqkv0 = (bf16*)(ws + WS_WQKV0), *Wo0 = (bf16*)(ws + WS_WO0), *Win0 = (bf16*)(ws + WS_WIN0), *Wout0 = (bf16*)(ws + WS_WOUT0);
    bf16 *Wqkv1 = (bf16*)(ws + WS_WQKV1), *Wo1 = (bf16*)(ws + WS_WO1), *Win1 = (bf16*)(ws + WS_WIN1), *Wout1 = (bf16*)(ws + WS_WOUT1);
    bf16 *XB = (bf16*)(ws + WS_XB), *Qb = (bf16*)(ws + WS_Q), *Kb = (bf16*)(ws + WS_K), *Vb = (bf16*)(ws + WS_V), *Hb = (bf16*)(ws + WS_H);
    const float* x = args.in[0]; float* out = args.out;
    const int G = gridDim.x; int vcu; { const int bx = blockIdx.x; vcu = (G % 8 == 0) ? (bx % 8) * (G / 8) + bx / 8 : bx; }
    for (int u = tid; u < (LDS_BYTES - LDSCTL_OFF) / 4; u += NWAVES * 64) ((LAS unsigned*)(L + LDSCTL_OFF))[u] = 0u;
    __syncthreads();
    XcdBarrier bar; bar.bar = (unsigned*)(ctl + CW_BAR); bar.x = 0; bar.st = nullptr;
    if (MK_N_LAUNCHES == 1) bar = xcd_barrier_post((unsigned*)(ctl + CW_BAR), MISC + 8);
    const int lo = args.ph_lo, hi = args.ph_hi;
#define IN(k) (lo <= (k) && (k) < hi)
#ifdef PROBE_A
#define STAMP(k) do { if (blockIdx.x == 0 && tid == 0) MISC[16 + (k)] = (unsigned)__builtin_amdgcn_s_memrealtime(); } while (0)
#else
#define STAMP(k) do {} while (0)
#endif
#define SEAM(k) do { if (IN(k) && IN((k) + 1)) xcd_barrier(bar); STAMP((k) + 1); } while (0)
    STAMP(0);

    if (IN(0)) {
        LAS float* scr = (LAS float*)(L + RING_OFF + wave * 16384);
        const int gw = vcu * NWAVES + wave, NGW = G * NWAVES;
        const float *mix_norm = args.in[1], *mlp_norm = args.in[2], *w_in = args.in[11], *w_out = args.in[12];
        constexpr int I_QKV0 = (D / 64) * (3072 / 32), I_O = (D / 64) * (D / 32), I_IN = (D / 64) * (FF / 32), I_OUT = (FF / 64) * (D / 32), I_QKV1 = (D / 64) * (1536 / 32);
        constexpr int NITEMS = I_QKV0 + I_QKV1 + 2 * (I_O + I_IN + I_OUT);
        for (int it = gw; it < NITEMS; it += NGW) {
            int r = it;
            if (r < I_QKV0) { p0_transpose_item(args.in[4], mix_norm, D, 3072, Wqkv0, scr, r, lane); continue; } r -= I_QKV0;
            if (r < I_O) { p0_transpose_item(args.in[6], nullptr, D, D, Wo0, scr, r, lane); continue; } r -= I_O;
            if (r < I_IN) { p0_transpose_item(w_in, mlp_norm, D, FF, Win0, scr, r, lane); continue; } r -= I_IN;
            if (r < I_OUT) { p0_transpose_item(w_out, nullptr, FF, D, Wout0, scr, r, lane); continue; } r -= I_OUT;
            if (r < I_QKV1) { p0_transpose_item(args.in[7], mix_norm + D, D, 1536, Wqkv1, scr, r, lane); continue; } r -= I_QKV1;
            if (r < I_O) { p0_transpose_item(args.in[9], nullptr, D, D, Wo1, scr, r, lane); continue; } r -= I_O;
            if (r < I_IN) { p0_transpose_item(w_in + (size_t)D * FF, mlp_norm + D, D, FF, Win1, scr, r, lane); continue; } r -= I_IN;
            p0_transpose_item(w_out + (size_t)D * FF, nullptr, FF, D, Wout1, scr, r, lane);
        }
        for (int i = vcu * (NWAVES * 64) + tid; i < 16 * 257 + 16; i += G * NWAVES * 64) {
            if (i < 16 * 257) { const int h = i / 257, rel = i % 257 - 128; const int n = rel < 0 ? -rel : rel; int bk;
                if (n < 8) bk = n; else { const int k = (31 - __clz(n * n)) - 6; bk = 8 + (k < 7 ? k : 7); }
                if (rel > 0) bk += 16;
                tblg[i] = args.in[10][bk * 16 + h] * LOG2E; }
            else tblg[i] = args.in[8][i - 16 * 257] * LOG2E;
        }
        for (int m = gw; m < M; m += NGW) {
            const GAS f32x4* xr = (const GAS f32x4*)(x + (size_t)m * D) + lane; GAS unsigned long long* o8 = (GAS unsigned long long*)(XB + (size_t)m * D) + lane;
            float s = 0.f;
#pragma unroll
            for (int j = 0; j < 4; ++j) { const f32x4 v = xr[64 * j]; s += (v.x * v.x + v.y * v.y) + (v.z * v.z + v.w * v.w);
                o8[64 * j] = (unsigned long long)pk2(v.x, v.y) | ((unsigned long long)pk2(v.z, v.w) << 32); }
            s = wave_sum(s);
            if (lane < 16) ssq[(size_t)m * 16 + lane] = lane == 0 ? s : 0.f;
        }
    }
    SEAM(0);
    if (IN(1)) { pg8::Gemm g{XB, Wqkv0, M, 3072, D}; pg8::StaticOrder S; S.init(M, 3072, G, (int)blockIdx.x);
        pg8::EpiQKV E{Qb, Kb, Vb, D, C2, ssq};
        pg8::gemm_phase<pg8::EpiQKV, pg8::StaticOrder, PG8_ALIGN, PG8_SP2>(L + RING_OFF, g, S, E); }
    SEAM(1);
#ifdef PROBE_NA
    if (IN(2)) { att::na_phase<1>(L + RING_OFF, Qb, Kb, Vb, (bf16*)(ws + 448 * MiB), args.in[5], vcu, G); xcd_barrier(bar); STAMP(13);
                 att::na_phase<2>(L + RING_OFF, Qb, Kb, Vb, (bf16*)(ws + 448 * MiB), args.in[5], vcu, G); xcd_barrier(bar); STAMP(14); }
#endif
    if (IN(2)) att::na_phase<0>(L + RING_OFF, Qb, Kb, Vb, Qb, args.in[5], vcu, G);
    SEAM(2);
    if (IN(3)) { pg8::Gemm g{Qb, Wo0, M, D, D}; pg8::StaticOrder S; S.init(M, D, G, (int)blockIdx.x);
        pg8::EpiRes2<true, false> E{x, nullptr, XB, ssq};
        pg8::gemm_phase<pg8::EpiRes2<true, false>, pg8::StaticOrder, PG8_ALIGN, PG8_SP2>(L + RING_OFF, g, S, E); }
    SEAM(3);
    if (IN(4)) { pg8::Gemm g{XB, Win0, M, FF, D}; pg8::StaticOrder S; S.init(M, FF, G, (int)blockIdx.x);
        pg8::EpiUp E{Hb, ssq};
        pg8::gemm_phase<pg8::EpiUp, pg8::StaticOrder, PG8_ALIGN, PG8_SP2>(L + RING_OFF, g, S, E); }
    SEAM(4);
    if (IN(5)) { pg8::Gemm g{Hb, Wout0, M, D, FF}; pg8::StaticOrder S; S.init(M, D, G, (int)blockIdx.x);
        pg8::EpiRes2<false, false> E{nullptr, nullptr, XB, ssq};
        pg8::gemm_phase<pg8::EpiRes2<false, false>, pg8::StaticOrder, PG8_ALIGN, PG8_SP2>(L + RING_OFF, g, S, E); }
    SEAM(5);
    if (IN(6)) { pg8::Gemm g{XB, Wqkv1, M, 1536, D}; pg8::StaticOrder S; S.init(M, 1536, G, (int)blockIdx.x);
        pg8::EpiQKV E{Qb, Kb, Vb, 256, C2, ssq};
        pg8::gemm_phase<pg8::EpiQKV, pg8::StaticOrder, PG8_ALIGN, PG8_SP2>(L + RING_OFF, g, S, E); }
    SEAM(6);
    if (IN(7)) att::swa_phase(L + RING_OFF, Qb, Kb, Vb, Qb, tblg, vcu, G);
    SEAM(7);
    if (IN(8)) { pg8::Gemm g{Qb, Wo1, M, D, D}; pg8::StaticOrder S; S.init(M, D, G, (int)blockIdx.x);
        pg8::EpiRes2<false, false> E{nullptr, nullptr, XB, ssq};
        pg8::gemm_phase<pg8::EpiRes2<false, false>, pg8::StaticOrder, PG8_ALIGN, PG8_SP2>(L + RING_OFF, g, S, E); }
    SEAM(8);
    if (IN(9)) { pg8::Gemm g{XB, Win1, M, FF, D}; pg8::StaticOrder S; S.init(M, FF, G, (int)blockIdx.x);
        pg8::EpiUp E{Hb, ssq};
        pg8::gemm_phase<pg8::EpiUp, pg8::StaticOrder, PG8_ALIGN, PG8_SP2>(L + RING_OFF, g, S, E); }
    SEAM(9);
    if (IN(10)) { pg8::Gemm g{Hb, Wout1, M, D, FF}; pg8::StaticOrder S; S.init(M, D, G, (int)blockIdx.x);
        pg8::EpiRes2<false, true> E{nullptr, out, XB, ssq};
        pg8::gemm_phase<pg8::EpiRes2<false, true>, pg8::StaticOrder, PG8_ALIGN, PG8_SP2>(L + RING_OFF, g, S, E); }
    SEAM(10);
    if (IN(11)) {
        const int gw = vcu * NWAVES + wave, NGW = G * NWAVES; const GAS f32x4* gr = (const GAS f32x4*)args.in[3] + lane;
        const f32x4 g0 = gr[0], g1 = gr[64], g2 = gr[128], g3 = gr[192];
        for (int m = gw; m < M; m += NGW) {
            const float r = pg8::rstd16(ssq, m); GAS f32x4* xr = (GAS f32x4*)(out + (size_t)m * D) + lane;
            const f32x4 v0 = xr[0], v1 = xr[64], v2 = xr[128], v3 = xr[192];
            xr[0] = v0 * r * g0; xr[64] = v1 * r * g1; xr[128] = v2 * r * g2; xr[192] = v3 * r * g3;
        }
    }
#ifdef PROBE_A
    xcd_barrier(bar); STAMP(12);
    if (blockIdx.x == 0) { __syncthreads();
        #ifdef PROBE_NA
        const float ta = (float)(MISC[16 + 13] - MISC[16 + 2]) * 0.01f, tb2 = (float)(MISC[16 + 14] - MISC[16 + 13]) * 0.01f;
#else
        const float ta = (float)(MISC[16 + PROBE_A + 1] - MISC[16 + PROBE_A]) * 0.01f, tb2 = (float)(MISC[16 + PROBE_B + 1] - MISC[16 + PROBE_B]) * 0.01f;
#endif
        if (tid == 0) out[0] += ta * 0.01f;
        out[D + tid] += tb2 * 0.01f; out[D + 512 + tid] += tb2 * 0.01f; }
#endif
#undef IN
#undef SEAM
}

extern "C" void kernel_launch(void* const* d_in, const int* in_sizes, int n_in, void* d_out, int out_size, void* d_ws, size_t ws_size, hipStream_t stream) {
    static int grid = 0;
    if (grid == 0) {
        if (n_in != 13 || in_sizes[0] != M * D || out_size != M * D || ws_size < WS_END) { fprintf(stderr, "kernel_launch: unexpected shapes (n_in %d in0 %d out %d ws %zu)\n", n_in, n_in > 0 ? in_sizes[0] : -1, out_size, ws_size); grid = -1; return; }
        int dev = 0, cus = 0, per_cu = 0;
        if (hipGetDevice(&dev) != hipSuccess || hipDeviceGetAttribute(&cus, hipDeviceAttributeMultiprocessorCount, dev) != hipSuccess) { grid = -1; return; }
        if (hipFuncSetAttribute((const void*)mk_fwd, hipFuncAttributeMaxDynamicSharedMemorySize, LDS_BYTES) != hipSuccess) { fprintf(stderr, "kernel_launch: hipFuncSetAttribute failed\n"); grid = -1; return; }
        if (hipOccupancyMaxActiveBlocksPerMultiprocessor(&per_cu, (const void*)mk_fwd, NWAVES * 64, LDS_BYTES) != hipSuccess || per_cu < 1) { fprintf(stderr, "kernel_launch: occupancy query says %d blocks per CU\n", per_cu); grid = -1; (void)hipGetLastError(); return; }
        (void)hipGetLastError();
        grid = cus;
    }
    if (grid < 0) return;
    (void)hipMemsetAsync((unsigned char*)d_ws + WS_CTL, 0, 1 * MiB, stream);
    Args a{}; for (int i = 0; i < 13; ++i) a.in[i] = (const float*)d_in[i]; a.out = (float*)d_out; a.ws = (unsigned char*)d_ws;
#if MK_N_LAUNCHES == 1
    a.ph_lo = 0; a.ph_hi = NPHASE; hipLaunchKernelGGL(mk_fwd, dim3(grid), dim3(NWAVES * 64), LDS_BYTES, stream, a);
#else
    for (int p = 0; p < NPHASE; ++p) { a.ph_lo = p; a.ph_hi = p + 1; hipLaunchKernelGGL(mk_fwd, dim3(grid), dim3(NWAVES * 64), LDS_BYTES, stream, a); }
#endif
}
```

```cpp
#include <hip/hip_runtime.h>
#include <cstdint>
#include <cstdio>

typedef unsigned short bf16;
constexpr int BATCH = 4, SEQ = 8192, D = 1024, NH = 16, HD = 64, KVH = 4, FF = 4096, M = BATCH * SEQ;
constexpr int GW = 64, ROWS = SEQ / GW, KR = 8, KC = 16, WINDOW = 128;
constexpr float EPS = 1e-6f, LOG2E = 1.4426950408889634f, C2 = 0.125f * LOG2E;
constexpr size_t MiB = 1u << 20;
constexpr size_t WS_CTL = 0, WS_SSQ = 1 * MiB, WS_TBL = 3 * MiB;
constexpr size_t WS_WQKV0 = 4 * MiB, WS_WO0 = 10 * MiB, WS_WIN0 = 12 * MiB, WS_WOUT0 = 20 * MiB, WS_WQKV1 = 28 * MiB, WS_WO1 = 31 * MiB, WS_WIN1 = 33 * MiB, WS_WOUT1 = 41 * MiB;
constexpr size_t WS_XB = 64 * MiB, WS_Q = 128 * MiB, WS_K = 192 * MiB, WS_V = 256 * MiB, WS_H = 128 * MiB, WS_END = 384 * MiB;

__device__ __forceinline__ unsigned f2bf(float f) { unsigned u = __builtin_bit_cast(unsigned, f); return (u + 0x7fffu + ((u >> 16) & 1u)) >> 16; }
__device__ __forceinline__ float bf2f(bf16 b) { return __builtin_bit_cast(float, (unsigned)b << 16); }
__device__ __forceinline__ float wave_sum(float v) {
#pragma unroll
    for (int o = 1; o < 64; o <<= 1) v += __shfl_xor(v, o);
    return v;
}
__device__ __forceinline__ float row_rstd(const float* ssq, int row) {
    const float4* p = (const float4*)(ssq + (size_t)row * 16);
    float4 a = p[0], b = p[1], c = p[2], d = p[3];
    float s = ((a.x + a.y) + (a.z + a.w)) + ((b.x + b.y) + (b.z + b.w)) + ((c.x + c.y) + (c.z + c.w)) + ((d.x + d.y) + (d.z + d.w));
    return 1.0f / sqrtf(s * (1.0f / D) + EPS);
}


namespace pg8 {
#define PG8_LAS __attribute__((address_space(3)))
typedef unsigned short bf16_t;
typedef short bf16x8 __attribute__((ext_vector_type(8)));
typedef float f32x4 __attribute__((ext_vector_type(4)));
typedef unsigned u32x4 __attribute__((ext_vector_type(4)));
constexpr int BM = 256, BK = 64, HALF = 128, HTB = HALF * BK * 2  , STAGE_BYTES = 8 * HTB, NXCD = 8, WGM = 8;

__host__ __device__ __forceinline__ int lds_byte(int r, int c) { const int st = (r >> 4) * 2 + (c >> 5), rr = r & 15, cc = c & 31, ob = rr * 64 + cc * 2; return st * 1024 + (ob ^ (((ob >> 9) & 1) << 5)); }
__host__ __device__ __forceinline__ void stage_rc(int b, int& R, int& C) { const int st = b / 1024, sb = b % 1024, swz = sb ^ (((sb >> 9) & 1) << 5); R = (st >> 1) * 16 + swz / 64; C = (st & 1) * 32 + (swz % 64) / 2; }
__host__ __device__ __forceinline__ int perm32(int rho) { const int n = rho >> 4, i = rho & 15; return 8 * (i >> 2) + 4 * n + (i & 3); }

struct Unit { int pm, pn; };
struct Gemm { const bf16_t* A; const bf16_t* Bt; int M, N, K; };

struct StaticOrder {
    int nM, nN, nwg, G, c;
    __host__ __device__ void init(int M, int N, int G_, int c_) { nM = M / BM; nN = N / BM; nwg = nM * nN; G = G_; c = c_; }
    __host__ __device__ bool next(int i, Unit& u) const {
        const long L = (long)i * G + c; if (L >= nwg) return false;
        int wgid = (int)L; { const int q = nwg / NXCD, r = nwg % NXCD, xcd = wgid % NXCD, off = wgid / NXCD; wgid = (xcd < r ? xcd * (q + 1) : r * (q + 1) + (xcd - r) * q) + off; }
        const int nig = WGM * nN, gid = wgid / nig, fm = gid * WGM, gsz = (nM - fm) < WGM ? (nM - fm) : WGM;
        u.pm = fm + ((wgid % nig) % gsz); u.pn = (wgid % nig) / gsz; return true;
    }
    __device__ __forceinline__ void a_ready(const Unit&) const {}
    __device__ __forceinline__ void done(const Unit&) const {}
};

__device__ __forceinline__ unsigned cvt_pk_bf16(float lo, float hi) { unsigned r; asm volatile("v_cvt_pk_bf16_f32 %0, %1, %2" : "=v"(r) : "v"(lo), "v"(hi)); return r; }
typedef float f32x2 __attribute__((ext_vector_type(2)));
__device__ __forceinline__ float rstd16(const float* ssq, int row) {
    const f32x4* p = (const f32x4*)(ssq + (size_t)row * 16);
    const f32x4 a = p[0], b = p[1], c = p[2], d = p[3];
    const float s = (((a[0] + a[1]) + (a[2] + a[3])) + ((b[0] + b[1]) + (b[2] + b[3]))) + (((c[0] + c[1]) + (c[2] + c[3])) + ((d[0] + d[1]) + (d[2] + d[3])));
    return __builtin_amdgcn_rsqf(s * (1.0f / 1024.0f) + 1e-6f);
}
struct EpiQKV {
    static constexpr bool PERM = true, AFTER_DRAIN = false;
    bf16_t *Q, *Kp, *V; int kvw; float qscale; const float* ssq;
    __device__ __forceinline__ void operator()(const f32x4 (&acc)[2][2][4][2], const Unit& u, int wr, int wc, int fr, int fq) const {
        int colt = u.pn * BM; bf16_t* base; float sc = 1.f; bool hm = true;
        if (colt < 1024) { base = Q; sc = qscale; hm = false; } else if (colt < 1024 + kvw) { base = Kp; colt -= 1024; } else { base = V; colt -= 1024 + kvw; }
        const int col0 = colt + wc * 32 + 8 * fq, row0 = u.pm * BM + wr * 64 + fr, nhk = kvw >> 6;
#pragma unroll
        for (int ai = 0; ai < 2; ++ai)
#pragma unroll
            for (int m = 0; m < 4; ++m) { const int row = row0 + ai * HALF + m * 16; const float rs = rstd16(ssq, row) * sc; const int bb = row >> 13, tk = row & 8191;
#pragma unroll
                for (int bj = 0; bj < 2; ++bj) { const f32x4 v0 = acc[ai][bj][m][0] * rs, v1 = acc[ai][bj][m][1] * rs; const int cc = col0 + bj * HALF;
                    u32x4 w; w.x = cvt_pk_bf16(v0[0], v0[1]); w.y = cvt_pk_bf16(v0[2], v0[3]); w.z = cvt_pk_bf16(v1[0], v1[1]); w.w = cvt_pk_bf16(v1[2], v1[3]);
                    bf16_t* p = hm ? base + ((size_t)(bb * nhk + (cc >> 6)) * 8192 + tk) * 64 + (cc & 63) : base + (size_t)row * 1024 + cc;
                    *(u32x4*)p = w; } }
    }
};
struct EpiUp {
    static constexpr bool PERM = true, AFTER_DRAIN = false;
    bf16_t* Hh; const float* ssq;
    __device__ __forceinline__ void operator()(const f32x4 (&acc)[2][2][4][2], const Unit& u, int wr, int wc, int fr, int fq) const {
        const int col0 = u.pn * BM + wc * 32 + 8 * fq, row0 = u.pm * BM + wr * 64 + fr;
#pragma unroll
        for (int ai = 0; ai < 2; ++ai)
#pragma unroll
            for (int m = 0; m < 4; ++m) { const int row = row0 + ai * HALF + m * 16; const float rs = rstd16(ssq, row); bf16_t* rowp = Hh + (size_t)row * 4096 + col0;
#pragma unroll
                for (int bj = 0; bj < 2; ++bj) { f32x4 v0 = acc[ai][bj][m][0] * rs, v1 = acc[ai][bj][m][1] * rs;
#pragma unroll
                    for (int e = 0; e < 4; ++e) { const float a = __builtin_fmaxf(v0[e], 0.f), b = __builtin_fmaxf(v1[e], 0.f); v0[e] = a * a; v1[e] = b * b; }
                    u32x4 w; w.x = cvt_pk_bf16(v0[0], v0[1]); w.y = cvt_pk_bf16(v0[2], v0[3]); w.z = cvt_pk_bf16(v1[0], v1[1]); w.w = cvt_pk_bf16(v1[2], v1[3]);
                    *(u32x4*)(rowp + bj * HALF) = w; } }
    }
};
struct EpiRes {
    static constexpr bool PERM = false, AFTER_DRAIN = false;
    const float* base; float* out; bf16_t* xb; float* ssq;
    __device__ __forceinline__ void operator()(const f32x4 (&acc)[2][2][4][2], const Unit& u, int wr, int wc, int fr, int fq) const {
        typedef unsigned u32x2v __attribute__((ext_vector_type(2)));
        const int col0 = u.pn * BM + wc * 32 + 4 * fq, row0 = u.pm * BM + wr * 64 + fr;
#pragma unroll
        for (int ai = 0; ai < 2; ++ai)
#pragma unroll
            for (int m = 0; m < 4; ++m) { const int row = row0 + ai * HALF + m * 16; const size_t off = (size_t)row * 1024 + col0; float s = 0.f;
#pragma unroll
                for (int bj = 0; bj < 2; ++bj)
#pragma unroll
                    for (int n = 0; n < 2; ++n) { const f32x4 bs = *(const f32x4*)(base + off + bj * HALF + n * 16); const f32x4 o = bs + acc[ai][bj][m][n];
                        *(f32x4*)(out + off + bj * HALF + n * 16) = o; s += (o[0] * o[0] + o[1] * o[1]) + (o[2] * o[2] + o[3] * o[3]);
                        u32x2v w; w.x = cvt_pk_bf16(o[0], o[1]); w.y = cvt_pk_bf16(o[2], o[3]); *(u32x2v*)(xb + off + bj * HALF + n * 16) = w; }
                s += __shfl_xor(s, 16); s += __shfl_xor(s, 32);
                if (fq == 0) ssq[(size_t)row * 16 + u.pn * 4 + wc] = s; }
    }
};
template <bool BASE_F32, bool OUT_F32> struct EpiRes2 {
    static constexpr bool PERM = true, AFTER_DRAIN = false;
    const float* basef; float* outf; bf16_t* xb; float* ssq;
    __device__ __forceinline__ void operator()(const f32x4 (&acc)[2][2][4][2], const Unit& u, int wr, int wc, int fr, int fq) const {
        const int col0 = u.pn * BM + wc * 32 + 8 * fq, row0 = u.pm * BM + wr * 64 + fr;
#pragma unroll
        for (int ai = 0; ai < 2; ++ai)
#pragma unroll
            for (int m = 0; m < 4; ++m) { const int row = row0 + ai * HALF + m * 16; const size_t off = (size_t)row * 1024 + col0; float s = 0.f;
#pragma unroll
                for (int bj = 0; bj < 2; ++bj) { f32x4 b0, b1;
                    if (BASE_F32) { b0 = *(const f32x4*)(basef + off + bj * HALF); b1 = *(const f32x4*)(basef + off + bj * HALF + 4); }
                    else { const u32x4 w = *(const u32x4*)(xb + off + bj * HALF);
                        b0 = (f32x4){__builtin_bit_cast(float, w.x << 16), __builtin_bit_cast(float, w.x & 0xffff0000u), __builtin_bit_cast(float, w.y << 16), __builtin_bit_cast(float, w.y & 0xffff0000u)};
                        b1 = (f32x4){__builtin_bit_cast(float, w.z << 16), __builtin_bit_cast(float, w.z & 0xffff0000u), __builtin_bit_cast(float, w.w << 16), __builtin_bit_cast(float, w.w & 0xffff0000u)}; }
                    const f32x4 o0 = b0 + acc[ai][bj][m][0], o1 = b1 + acc[ai][bj][m][1];
                    s += ((o0[0] * o0[0] + o0[1] * o0[1]) + (o0[2] * o0[2] + o0[3] * o0[3])) + ((o1[0] * o1[0] + o1[1] * o1[1]) + (o1[2] * o1[2] + o1[3] * o1[3]));
                    if (OUT_F32) { *(f32x4*)(outf + off + bj * HALF) = o0; *(f32x4*)(outf + off + bj * HALF + 4) = o1; }
                    else { u32x4 w; w.x = cvt_pk_bf16(o0[0], o0[1]); w.y = cvt_pk_bf16(o0[2], o0[3]); w.z = cvt_pk_bf16(o1[0], o1[1]); w.w = cvt_pk_bf16(o1[2], o1[3]); *(u32x4*)(xb + off + bj * HALF) = w; } }
                s += __shfl_xor(s, 16); s += __shfl_xor(s, 32);
                if (fq == 0) ssq[(size_t)row * 16 + u.pn * 4 + wc] = s; }
    }
};
template <class Epi, class Sched, bool ALIGN_EPI = false, bool SP2 = false>
__device__ __forceinline__ void gemm_phase(PG8_LAS unsigned char* lds, const Gemm g, const Sched& S, const Epi& E) {
    const int tid = threadIdx.x, wid = __builtin_amdgcn_readfirstlane(tid >> 6), lane = tid & 63, wr = wid >> 2, wc = wid & 3, fr = lane & 15, fq = lane >> 4;
    const int K = g.K, nt = K / BK;
    unsigned voffA[2], voffB[2];
#pragma unroll
    for (int i = 0; i < 2; ++i) { int R, C; stage_rc(tid * 16 + i * 8192, R, C); const int Rb = Epi::PERM ? ((R & ~31) + perm32(R & 31)) : R;
        voffA[i] = (unsigned)(R * K + C) * 2u; voffB[i] = (unsigned)(Rb * K + C) * 2u; }
    const size_t kstep = (size_t)(BK * 2);
    const size_t hstep = (size_t)HALF * K * 2;
    const size_t tstep = 2 * hstep;
    const unsigned ldsw = (unsigned)wid * 1024u;
    const int aoff = lds_byte(wr * 64 + fr, fq * 8), boff = lds_byte(wc * 32 + fr, fq * 8);
#define PG8_SA(b, h) (((b) * 2 + (h)) * HTB)
#define PG8_SB(b, h) ((4 + (b) * 2 + (h)) * HTB)
#define PG8_STAGE(bufoff, gbase, voff) do { _Pragma("unroll") for (int _i = 0; _i < 2; ++_i) \
        __builtin_amdgcn_global_load_lds((const unsigned*)((const char*)(gbase) + (voff)[_i]), (PG8_LAS unsigned*)(lds + (bufoff) + ldsw + _i * 8192), 16, 0, 0); } while (0)
#define PG8_LDA(dst, b, h) do { _Pragma("unroll") for (int m = 0; m < 4; ++m) _Pragma("unroll") for (int k = 0; k < 2; ++k) dst[m][k] = *(const PG8_LAS bf16x8*)(lds + PG8_SA(b, h) + aoff + m * 2048 + k * 1024); } while (0)
#define PG8_LDB(dst, b, h) do { _Pragma("unroll") for (int n = 0; n < 2; ++n) _Pragma("unroll") for (int k = 0; k < 2; ++k) dst[n][k] = *(const PG8_LAS bf16x8*)(lds + PG8_SB(b, h) + boff + n * 2048 + k * 1024); } while (0)
#define PG8_MMA(ai, bj, At, Bt) do { __builtin_amdgcn_s_setprio(1); _Pragma("unroll") for (int m = 0; m < 4; ++m) _Pragma("unroll") for (int n = 0; n < 2; ++n) _Pragma("unroll") for (int k = 0; k < 2; ++k) \
        acc[ai][bj][m][n] = __builtin_amdgcn_mfma_f32_16x16x32_bf16(Bt[n][k], At[m][k], acc[ai][bj][m][n], 0, 0, 0); __builtin_amdgcn_s_setprio(0); } while (0)
#define PG8_WAIT_V(n) asm volatile("s_waitcnt vmcnt(" #n ")" ::: "memory")
#define PG8_WAIT_L(n) asm volatile("s_waitcnt lgkmcnt(" #n ")" ::: "memory")
#define PG8_BAR __builtin_amdgcn_s_barrier()
#define PG8_SCHED __builtin_amdgcn_sched_barrier(0)
    Unit cur, nxt; int ui = 0;
    if (!S.next(0, cur)) return;
    f32x4 acc[2][2][4][2];
#pragma unroll
    for (int a = 0; a < 2; ++a)
#pragma unroll
        for (int b = 0; b < 2; ++b)
#pragma unroll
            for (int m = 0; m < 4; ++m)
#pragma unroll
                for (int n = 0; n < 2; ++n) acc[a][b][m][n] = (f32x4){0.f, 0.f, 0.f, 0.f};
    bf16x8 At[4][2], B0[2][2], B1[2][2];
    const char* cA = (const char*)g.A + (size_t)cur.pm * tstep; const char* cB = (const char*)g.Bt + (size_t)cur.pn * tstep;
    S.a_ready(cur);
    if constexpr (SP2) {
        PG8_STAGE(PG8_SB(0, 0), cB, voffB); PG8_STAGE(PG8_SB(0, 1), cB + hstep, voffB); PG8_STAGE(PG8_SA(0, 0), cA, voffA); PG8_STAGE(PG8_SA(0, 1), cA + hstep, voffA);
        if (wr == 1) PG8_BAR;
        PG8_WAIT_V(2); PG8_BAR;
        PG8_STAGE(PG8_SB(1, 0), cB + kstep, voffB); PG8_STAGE(PG8_SA(1, 0), cA + kstep, voffA); PG8_STAGE(PG8_SB(1, 1), cB + hstep + kstep, voffB);
        PG8_WAIT_V(6); PG8_BAR;
    } else {
        PG8_STAGE(PG8_SB(0, 0), cB, voffB); PG8_STAGE(PG8_SA(0, 0), cA, voffA); PG8_STAGE(PG8_SB(0, 1), cB + hstep, voffB); PG8_STAGE(PG8_SA(0, 1), cA + hstep, voffA);
        if (wr == 1) PG8_BAR;
        PG8_WAIT_V(4); PG8_BAR;
        PG8_STAGE(PG8_SB(1, 0), cB + kstep, voffB); PG8_STAGE(PG8_SA(1, 0), cA + kstep, voffA); PG8_STAGE(PG8_SB(1, 1), cB + hstep + kstep, voffB);
        PG8_WAIT_V(6); PG8_BAR;
    }
    for (;;) {
        const bool has_next = S.next(ui + 1, nxt);
        const char* nA = has_next ? (const char*)g.A + (size_t)nxt.pm * tstep : cA; const char* nB = has_next ? (const char*)g.Bt + (size_t)nxt.pn * tstep : cB;
        for (int t = 0; t < nt; t += 2) {
            const bool last = (t == nt - 2);
            const char* a1 = cA + (size_t)(t + 1) * kstep;
            const char* a2 = last ? nA : cA + (size_t)(t + 2) * kstep; const char* b2 = last ? nB : cB + (size_t)(t + 2) * kstep;
            const char* a3 = a2 + kstep; const char* b3 = b2 + kstep;
            if (last && has_next) S.a_ready(nxt);
            if constexpr (SP2) {
            PG8_LDB(B0, 0, 0); PG8_LDB(B1, 0, 1); PG8_SCHED; PG8_LDA(At, 0, 0); PG8_STAGE(PG8_SA(1, 1), a1 + hstep, voffA);
            PG8_WAIT_V(8); PG8_WAIT_L(0); PG8_BAR; PG8_MMA(0, 0, At, B0); PG8_MMA(0, 1, At, B1); PG8_BAR; PG8_SCHED;
            PG8_LDA(At, 0, 1); PG8_STAGE(PG8_SB(0, 0), b2, voffB); PG8_STAGE(PG8_SB(0, 1), b2 + hstep, voffB); PG8_STAGE(PG8_SA(0, 0), a2, voffA);
            PG8_WAIT_V(8); PG8_WAIT_L(0); PG8_BAR; PG8_MMA(1, 0, At, B0); PG8_MMA(1, 1, At, B1); PG8_BAR; PG8_SCHED;
            PG8_LDB(B0, 1, 0); PG8_LDB(B1, 1, 1); PG8_SCHED; PG8_LDA(At, 1, 0); PG8_STAGE(PG8_SA(0, 1), a2 + hstep, voffA);
            PG8_WAIT_V(8); PG8_WAIT_L(0); PG8_BAR; PG8_MMA(0, 0, At, B0); PG8_MMA(0, 1, At, B1); PG8_BAR; PG8_SCHED;
            PG8_LDA(At, 1, 1); PG8_STAGE(PG8_SB(1, 0), b3, voffB); PG8_STAGE(PG8_SB(1, 1), b3 + hstep, voffB); PG8_STAGE(PG8_SA(1, 0), a3, voffA);
            PG8_WAIT_V(8); PG8_WAIT_L(0); PG8_BAR; PG8_MMA(1, 0, At, B0); PG8_MMA(1, 1, At, B1); PG8_BAR; PG8_SCHED;
            } else {
            PG8_LDB(B0, 0, 0); PG8_SCHED; PG8_LDA(At, 0, 0); PG8_STAGE(PG8_SA(1, 1), a1 + hstep, voffA);
            PG8_WAIT_L(8); PG8_BAR; PG8_WAIT_L(0); PG8_MMA(0, 0, At, B0); PG8_BAR; PG8_SCHED;
            PG8_LDB(B1, 0, 1); PG8_STAGE(PG8_SB(0, 0), b2, voffB);
            PG8_BAR; PG8_WAIT_L(0); PG8_MMA(0, 1, At, B1); PG8_BAR;
            PG8_LDA(At, 0, 1); PG8_STAGE(PG8_SA(0, 0), a2, voffA);
            PG8_BAR; PG8_WAIT_L(0); PG8_MMA(1, 0, At, B0); PG8_BAR; PG8_SCHED;
            PG8_STAGE(PG8_SB(0, 1), b2 + hstep, voffB);
            PG8_WAIT_V(6); PG8_BAR; PG8_MMA(1, 1, At, B1); PG8_BAR;
            PG8_LDB(B0, 1, 0); PG8_SCHED; PG8_LDA(At, 1, 0); PG8_STAGE(PG8_SA(0, 1), a2 + hstep, voffA);
            PG8_WAIT_L(8); PG8_BAR; PG8_WAIT_L(0); PG8_MMA(0, 0, At, B0); PG8_BAR; PG8_SCHED;
            PG8_LDB(B1, 1, 1); PG8_STAGE(PG8_SB(1, 0), b3, voffB);
            PG8_BAR; PG8_WAIT_L(0); PG8_MMA(0, 1, At, B1); PG8_BAR;
            PG8_LDA(At, 1, 1); PG8_STAGE(PG8_SA(1, 0), a3, voffA);
            PG8_BAR; PG8_WAIT_L(0); PG8_MMA(1, 0, At, B0); PG8_BAR; PG8_SCHED;
            PG8_STAGE(PG8_SB(1, 1), b3 + hstep, voffB);
            PG8_WAIT_V(6); PG8_BAR; PG8_MMA(1, 1, At, B1); PG8_BAR;
            }
        }
        if constexpr (ALIGN_EPI) { if (wr == 0) PG8_BAR; }
        if constexpr (!Epi::AFTER_DRAIN) { E(acc, cur, wr, wc, fr, fq); S.done(cur); }
        if (!has_next) break;
#pragma unroll
        for (int a = 0; a < 2; ++a)
#pragma unroll
            for (int b = 0; b < 2; ++b)
#pragma unroll
                for (int m = 0; m < 4; ++m)
#pragma unroll
                    for (int n = 0; n < 2; ++n) acc[a][b][m][n] = (f32x4){0.f, 0.f, 0.f, 0.f};
        cur = nxt; cA = nA; cB = nB; ++ui;
        if constexpr (ALIGN_EPI) { if (wr == 1) PG8_BAR; }
    }
    PG8_WAIT_V(0);
    if constexpr (!ALIGN_EPI) { if (wr == 0) PG8_BAR; }
    PG8_BAR;
    if constexpr (Epi::AFTER_DRAIN) { E.fused(acc, cur, wr, wc, fr, fq, lds, wid, lane); S.done(cur); }
#undef PG8_SA
#undef PG8_SB
#undef PG8_STAGE
#undef PG8_LDA
#undef PG8_LDB
#undef PG8_MMA
#undef PG8_WAIT_V
#undef PG8_WAIT_L
#undef PG8_BAR
#undef PG8_SCHED
}
}

#define GAS __attribute__((address_space(1)))
#define LAS __attribute__((address_space(3)))
typedef unsigned v4u __attribute__((ext_vector_type(4)));
typedef float f32x4 __attribute__((ext_vector_type(4)));
typedef short bf16x8 __attribute__((ext_vector_type(8)));
typedef GAS unsigned gu32;
typedef GAS unsigned long long gu64;
#define RLX_AGENT __ATOMIC_RELAXED, __HIP_MEMORY_SCOPE_AGENT
#define LDS_WAIT() asm volatile("s_waitcnt lgkmcnt(0)" ::: "memory")
#define VM_WAIT() asm volatile("s_waitcnt vmcnt(0)" ::: "memory")
__device__ __forceinline__ unsigned long long rt() { return __builtin_amdgcn_s_memrealtime(); }
__device__ __forceinline__ unsigned pk2(float lo, float hi) { return f2bf(lo) | (f2bf(hi) << 16); }

#define XB_TMO      128
#define XB_XCNT(j)  (256  + 64 * (j))
#define XB_XSUB(j)  (1280 + 64 * (j))
#define XB_XGEN(j)  (2304 + 64 * (j))
#define XB_TOP      3328
#define XB_TOPGEN   3392
#define XCD_BAR_WORDS 3456
#define XB_SPIN_CAP (1u << 18)

__device__ __forceinline__ unsigned xb_ld(unsigned* p)              { return __hip_atomic_load(p, __ATOMIC_RELAXED, __HIP_MEMORY_SCOPE_AGENT); }
__device__ __forceinline__ unsigned xb_add(unsigned* p, unsigned v) { return __hip_atomic_fetch_add(p, v, __ATOMIC_RELAXED, __HIP_MEMORY_SCOPE_AGENT); }
__device__ __forceinline__ unsigned xb_xcc_id() { return (unsigned)__builtin_amdgcn_s_getreg((3 << 11) | 20) & 0xFu; }
#define XB_SPIN(cond, bar) do { unsigned _sp = 0; while (cond) { __builtin_amdgcn_s_sleep(1); \
    if ((++_sp & 255u) == 0u) { if (xb_ld(&(bar)[XB_TMO])) break; if (_sp > XB_SPIN_CAP) { atomicAdd(&(bar)[XB_TMO], 1u); break; } } } } while (0)

struct XcdBarrier {
    unsigned* bar; unsigned x;
    volatile LAS unsigned* st;
};

__device__ __forceinline__ XcdBarrier xcd_barrier_post(unsigned* bar, volatile LAS unsigned* st) {
    XcdBarrier b; b.bar = bar; b.x = xb_xcc_id(); b.st = st;
    if (threadIdx.x == 0) (void)xb_add(&bar[XB_XCNT(b.x)], 1u);
    return b;
}
__device__ __forceinline__ void xcd_barrier_complete(unsigned* bar, unsigned x, unsigned& nloc, unsigned& nx) {
    const unsigned G = gridDim.x * gridDim.y * gridDim.z;
    unsigned sum, cnt, mine, sp = 0u;
    for (;;) {
        sum = 0u; cnt = 0u; mine = 0u;
#pragma unroll
        for (unsigned j = 0; j < 16; ++j) { const unsigned c = xb_ld(&bar[XB_XCNT(j)]); sum += c; cnt += (c > 0u) ? 1u : 0u; mine = (j == x) ? c : mine; }
        if (sum == G) break;
        __builtin_amdgcn_s_sleep(1);
        if ((++sp & 255u) == 0u) { if (xb_ld(&bar[XB_TMO])) break; if (sp > XB_SPIN_CAP) { atomicAdd(&bar[XB_TMO], 1u); break; } }
    }
    nloc = mine > 0u ? mine : 1u; nx = cnt > 0u ? cnt : 1u;
}

__device__ __forceinline__ void xcd_barrier(const XcdBarrier& b) {
    asm volatile("s_waitcnt vmcnt(0)" ::: "memory");
    __syncthreads();
    if (threadIdx.x == 0) {
        unsigned* bar = b.bar;
        __builtin_amdgcn_s_waitcnt(0);
        unsigned nloc = b.st[0], nx = b.st[1];
        if (nloc == 0u) { xcd_barrier_complete(bar, b.x, nloc, nx); b.st[0] = nloc; b.st[1] = nx; }
        const unsigned old = xb_add(&bar[XB_XSUB(b.x)], 1u);
        const unsigned gen = old / nloc;
        if (old + 1u == (gen + 1u) * nloc) {
            __builtin_amdgcn_fence(__ATOMIC_RELEASE, "agent");
            asm volatile("s_waitcnt vmcnt(0)" ::: "memory");
            const unsigned og = xb_add(&bar[XB_TOP], 1u);
            const unsigned tg = og / nx;
            if (og + 1u == (tg + 1u) * nx) xb_add(&bar[XB_TOPGEN], 1u);
            else XB_SPIN(xb_ld(&bar[XB_TOPGEN]) == tg, bar);
            __builtin_amdgcn_fence(__ATOMIC_ACQUIRE, "agent");
            xb_add(&bar[XB_XGEN(b.x)], 1u);
            asm volatile("s_waitcnt vmcnt(0)" ::: "memory");
        } else {
            XB_SPIN(xb_ld(&bar[XB_XGEN(b.x)]) == gen, bar);
            __builtin_amdgcn_fence(__ATOMIC_ACQUIRE, "agent");
            asm volatile("s_waitcnt vmcnt(0)" ::: "memory");
        }
    }
    __syncthreads();
}

namespace att {
typedef short bf16x8 __attribute__((ext_vector_type(8)));
typedef short s16x4 __attribute__((ext_vector_type(4)));
typedef float f32x4 __attribute__((ext_vector_type(4)));
typedef unsigned u32x2 __attribute__((ext_vector_type(2)));
typedef LAS const char* lptr;
constexpr float NEG = -INFINITY;
__device__ __forceinline__ int fK(int t) { return (t >> 1) & 7; }
__device__ __forceinline__ int fV(int t) { return (((t >> 1) & 3) << 1) | ((t >> 3) & 1); }
__device__ __forceinline__ s16x4 vtr(lptr p) { typedef short v4i16_t __attribute__((ext_vector_type(4))); return __builtin_bit_cast(s16x4, __builtin_amdgcn_ds_read_tr16_b64_v4i16((LAS v4i16_t*)p)); }
__device__ __forceinline__ unsigned cvtpk(float lo, float hi) { unsigned r; asm volatile("v_cvt_pk_bf16_f32 %0, %1, %2" : "=v"(r) : "v"(lo), "v"(hi)); return r; }
__device__ __forceinline__ float xor16(float v) { return __builtin_bit_cast(float, __builtin_amdgcn_ds_swizzle(__builtin_bit_cast(int, v), 0x401F)); }
__device__ __forceinline__ float max4(float v) { v = __builtin_fmaxf(v, xor16(v)); return __builtin_fmaxf(v, __shfl_xor(v, 32)); }
__device__ __forceinline__ float sum4(float v) { v += xor16(v); return v + __shfl_xor(v, 32); }

struct Item { bf16x8 q0, q1; f32x4 o0, o1, o2, o3; float m, l; int ka, va; };
__device__ __forceinline__ void item_init(Item& it, float m0, float l0) { it.o0 = it.o1 = it.o2 = it.o3 = (f32x4){0.f, 0.f, 0.f, 0.f}; it.m = m0; it.l = l0; }
__device__ __forceinline__ void item_addr(Item& it, int w0, int lane) {
    const int fr = lane & 15, fq = lane >> 4, rk = w0 + fr, rv = w0 + 4 * fq + (fr >> 2);
    it.ka = rk * 128 + ((fq ^ fK(rk)) << 4);
    it.va = 8192 + rv * 128 + (((((fr & 3) >> 1)) ^ fV(rv)) << 4) + 8 * (fr & 1);
}
__device__ __forceinline__ void half_step(Item& it, lptr slot, f32x4 b0, f32x4 b1) {
    lptr kp = slot + it.ka;
    const bf16x8 k00 = *(const LAS bf16x8*)(kp), k01 = *(const LAS bf16x8*)(kp + 2048);
    lptr kp1 = slot + (it.ka ^ 64);
    const bf16x8 k10 = *(const LAS bf16x8*)(kp1), k11 = *(const LAS bf16x8*)(kp1 + 2048);
    f32x4 s0 = __builtin_amdgcn_mfma_f32_16x16x32_bf16(k00, it.q0, b0, 0, 0, 0);
    f32x4 s1 = __builtin_amdgcn_mfma_f32_16x16x32_bf16(k01, it.q0, b1, 0, 0, 0);
    s0 = __builtin_amdgcn_mfma_f32_16x16x32_bf16(k10, it.q1, s0, 0, 0, 0);
    s1 = __builtin_amdgcn_mfma_f32_16x16x32_bf16(k11, it.q1, s1, 0, 0, 0);
    float mx = __builtin_fmaxf(__builtin_fmaxf(__builtin_fmaxf(s0[0], s0[1]), __builtin_fmaxf(s0[2], s0[3])), __builtin_fmaxf(__builtin_fmaxf(s1[0], s1[1]), __builtin_fmaxf(s1[2], s1[3])));
    mx = max4(mx);
    const float mn = __builtin_fmaxf(it.m, mx), al = __builtin_amdgcn_exp2f(it.m - mn);
    it.m = mn;
#pragma unroll
    for (int e = 0; e < 4; ++e) { s0[e] = __builtin_amdgcn_exp2f(s0[e] - mn); s1[e] = __builtin_amdgcn_exp2f(s1[e] - mn); }
    it.l = it.l * al + (((s0[0] + s0[1]) + (s0[2] + s0[3])) + ((s1[0] + s1[1]) + (s1[2] + s1[3])));
    it.o0 *= al; it.o1 *= al; it.o2 *= al; it.o3 *= al;
    typedef unsigned u32x4 __attribute__((ext_vector_type(4)));
    u32x4 pw; pw.x = cvtpk(s0[0], s0[1]); pw.y = cvtpk(s0[2], s0[3]); pw.z = cvtpk(s1[0], s1[1]); pw.w = cvtpk(s1[2], s1[3]);
    const bf16x8 pf = __builtin_bit_cast(bf16x8, pw);
#define ATT_PV(dt, O) do { lptr vp = slot + (it.va ^ ((dt) << 5)); const s16x4 lo = vtr(vp), hi = vtr(vp + 2048); \
        const bf16x8 vf = (bf16x8){lo[0], lo[1], lo[2], lo[3], hi[0], hi[1], hi[2], hi[3]}; O = __builtin_amdgcn_mfma_f32_16x16x32_bf16(vf, pf, O, 0, 0, 0); } while (0)
    ATT_PV(0, it.o0); ATT_PV(1, it.o1); ATT_PV(2, it.o2); ATT_PV(3, it.o3);
#undef ATT_PV
}
__device__ __forceinline__ void item_store(Item& it, bf16* orow, int lane) {
    const float rl = 1.0f / sum4(it.l); const int fq = lane >> 4;
    u32x2 w;
    w.x = cvtpk(it.o0[0] * rl, it.o0[1] * rl); w.y = cvtpk(it.o0[2] * rl, it.o0[3] * rl); *(u32x2*)(orow + 0 + 4 * fq) = w;
    w.x = cvtpk(it.o1[0] * rl, it.o1[1] * rl); w.y = cvtpk(it.o1[2] * rl, it.o1[3] * rl); *(u32x2*)(orow + 16 + 4 * fq) = w;
    w.x = cvtpk(it.o2[0] * rl, it.o2[1] * rl); w.y = cvtpk(it.o2[2] * rl, it.o2[3] * rl); *(u32x2*)(orow + 32 + 4 * fq) = w;
    w.x = cvtpk(it.o3[0] * rl, it.o3[1] * rl); w.y = cvtpk(it.o3[2] * rl, it.o3[3] * rl); *(u32x2*)(orow + 48 + 4 * fq) = w;
}
__device__ __forceinline__ void glds16(const void* gsrc, unsigned lds_dst) { unsigned keep;
    asm volatile("s_mov_b32 %0, m0\n\ts_mov_b32 m0, %2\n\ts_nop 0\n\tglobal_load_lds_dwordx4 %1, off\n\ts_mov_b32 m0, %0" : "=&s"(keep) : "v"(gsrc), "s"(lds_dst) : "memory"); }
__device__ __forceinline__ unsigned lds_u32(LAS unsigned char* p) { return (unsigned)__builtin_amdgcn_readfirstlane((int)(unsigned)(uintptr_t)p); }
#define ATT_WAITV(n) asm volatile("s_waitcnt vmcnt(" #n ")" ::: "memory")
#define ATT_BAR() do { asm volatile("s_waitcnt lgkmcnt(0)" ::: "memory"); __builtin_amdgcn_s_barrier(); asm volatile("" ::: "memory"); } while (0)
__device__ __forceinline__ void wait_vm(int n) {
    if (n >= 31) ATT_WAITV(31); else if (n >= 28) ATT_WAITV(28); else if (n >= 25) ATT_WAITV(25); else if (n >= 22) ATT_WAITV(22); else if (n >= 19) ATT_WAITV(19); else if (n >= 16) ATT_WAITV(16);
    else if (n >= 10) ATT_WAITV(10); else if (n >= 9) ATT_WAITV(9); else if (n >= 8) ATT_WAITV(8); else if (n >= 6) ATT_WAITV(6); else if (n >= 4) ATT_WAITV(4); else if (n >= 3) ATT_WAITV(3); else if (n >= 2) ATT_WAITV(2); else ATT_WAITV(0);
}

constexpr int NA_SLOT = 24576, NA_NS = 5, NA_PD = 3, NA_TBL = NA_NS * NA_SLOT;
struct NaCtx { LAS unsigned char* L; const bf16 *Q, *Kh, *Vh; bf16* O; const float* rpb; int tid, lane, wid, fr, fq, tok, cp; };
__device__ __forceinline__ void na_item_cols(int ct, int fr, int fq, int lane, Item& it, int& tbi, f32x4 (&mk)[2]) {
    const int w0 = ct == 0 ? 0 : ct == 1 ? 8 : ct == 2 ? 24 : 32, c = ct * 16 + fr; int cs = c - KC / 2; cs = cs < 0 ? 0 : (cs > GW - KC ? GW - KC : cs);
    item_addr(it, w0, lane); tbi = 16 + w0 + 4 * fq - c + 15;
    const int dl = w0 + 4 * fq - cs;
#pragma unroll
    for (int kt = 0; kt < 2; ++kt)
#pragma unroll
        for (int e = 0; e < 4; ++e) { const int x = dl + 16 * kt + e; mk[kt][e] = (x >= 0 && x <= 15) ? 0.f : NEG; }
}
__device__ __forceinline__ void na_table(const NaCtx& c, int h) {
    LAS float* tb = (LAS float*)(c.L + NA_TBL);
    for (int i = c.tid; i < 15 * 64; i += 512) { const int dr = i >> 6, ix = i & 63, dc = ix - 16; const float v = (dc >= 0 && dc < 31) ? c.rpb[(h * 15 + dr) * 31 + dc] * LOG2E : 0.f;
        tb[i] = v; tb[15 * 64 + i] = (ix >= 23 && ix <= 38) ? v : NEG; }
}
__device__ __forceinline__ void na_edge(const NaCtx& c, int b, int h, int r0, int klo) {
    LAS unsigned char* L = c.L; LAS float* tb = (LAS float*)(L + NA_TBL); const int wid = c.wid; int lane = c.lane; asm volatile("" : "+v"(lane));
    const int fr = lane & 15, fq = lane >> 4;
    const size_t plane = ((size_t)(b * NH + h) * SEQ) * HD;
    const bf16* ksrc = c.Kh + plane + (size_t)klo * GW * HD + c.tok * HD + ((c.cp ^ fK(c.tok)) << 3); const bf16* vsrc = c.Vh + plane + (size_t)klo * GW * HD + c.tok * HD + ((c.cp ^ fV(c.tok)) << 3);
    ATT_BAR();
    for (int t = 0; t < NA_PD; ++t) { const unsigned d = lds_u32(L + t * NA_SLOT + wid * 1024); glds16(ksrc + (size_t)t * GW * HD, d); glds16(vsrc + (size_t)t * GW * HD, d + 8192u); }
    na_table(c, h);
    const int r = r0 + (wid >> 1);
    Item it[2]; int tbi[2]; f32x4 mk[2][2];
#pragma unroll
    for (int i = 0; i < 2; ++i) { const int ct = 2 * (wid & 1) + i;
        const bf16* qp = c.Q + ((size_t)b * SEQ + (size_t)r * GW + ct * 16 + fr) * D + h * HD + 8 * fq;
        it[i].q0 = *(const bf16x8*)qp; it[i].q1 = *(const bf16x8*)(qp + 32);
        item_init(it[i], -1e30f, 0.f); na_item_cols(ct, fr, fq, lane, it[i], tbi[i], mk[i]); }
    __builtin_amdgcn_s_waitcnt(0x0F70);
    for (int t = 0; t < KR; ++t) {
        if (t + NA_PD < KR) { const unsigned d = lds_u32(L + ((t + NA_PD) % NA_NS) * NA_SLOT + wid * 1024); glds16(ksrc + (size_t)(t + NA_PD) * GW * HD, d); glds16(vsrc + (size_t)(t + NA_PD) * GW * HD, d + 8192u); }
        wait_vm(2 * (KR - 1 - t < NA_PD ? KR - 1 - t : NA_PD));
        ATT_BAR();
        lptr slot = (lptr)(L + (t % NA_NS) * NA_SLOT); const int dr = klo + t - r + KR - 1;
#pragma unroll
        for (int i = 0; i < 2; ++i) { const LAS float* bp = tb + dr * 64 + tbi[i]; f32x4 b0, b1;
#pragma unroll
            for (int e = 0; e < 4; ++e) { b0[e] = bp[e] + mk[i][0][e]; b1[e] = bp[16 + e] + mk[i][1][e]; }
            half_step(it[i], slot, b0, b1); }
    }
#pragma unroll
    for (int i = 0; i < 2; ++i) { const int cc = (2 * (wid & 1) + i) * 16 + fr; item_store(it[i], c.O + ((size_t)b * SEQ + (size_t)r * GW + cc) * D + h * HD, lane); }
    __builtin_amdgcn_s_waitcnt(0x0F70);
}
__device__ __forceinline__ void na_strip(const NaCtx& c, int b, int h, int ra, int rb) {
    LAS unsigned char* L = c.L; LAS float* tb = (LAS float*)(L + NA_TBL); const int wid = c.wid; int lane = c.lane; asm volatile("" : "+v"(lane));
    const int fr = lane & 15, fq = lane >> 4;
    const int klo = ra - 4, nt = rb - ra + 7;
    const size_t plane = ((size_t)(b * NH + h) * SEQ) * HD;
    const bf16* ksrc = c.Kh + plane + (size_t)klo * GW * HD + c.tok * HD + ((c.cp ^ fK(c.tok)) << 3); const bf16* vsrc = c.Vh + plane + (size_t)klo * GW * HD + c.tok * HD + ((c.cp ^ fV(c.tok)) << 3);
    const bf16* qsrc = c.Q + ((size_t)b * SEQ + c.tok) * D + h * HD + ((c.cp ^ fK(c.tok)) << 3);
#define NA_DMA(step) do { const int s_ = (step); const unsigned d = lds_u32(L + (s_ % NA_NS) * NA_SLOT + wid * 1024); int rq = ra + s_; rq = rq < rb ? rq : rb - 1; \
        glds16(ksrc + (size_t)s_ * GW * HD, d); glds16(vsrc + (size_t)s_ * GW * HD, d + 8192u); glds16(qsrc + (size_t)rq * GW * D, d + 16384u); } while (0)
    ATT_BAR();
    for (int t = 0; t < NA_PD; ++t) NA_DMA(t);
    na_table(c, h);
    Item it[4]; int tbi[4]; f32x4 mk[2][2];
#pragma unroll
    for (int i = 0; i < 4; ++i) { f32x4 dummy[2]; na_item_cols(i, fr, fq, lane, it[i], tbi[i], (i == 0 || i == 3) ? mk[i == 3] : dummy); item_init(it[i], -1e30f, 0.f); it[i].q0 = it[i].q1 = (bf16x8){0, 0, 0, 0, 0, 0, 0, 0}; }
    __builtin_amdgcn_s_waitcnt(0x0F70);
    for (int t = 0; t < nt; ++t) {
        if (t + NA_PD < nt) NA_DMA(t + NA_PD);
        const int j = t - wid, ph = j & 7, r = ra + t - ph;
        wait_vm(3 * (nt - 1 - t < NA_PD ? nt - 1 - t : NA_PD));
        ATT_BAR();
        if (j >= 0 && r < rb) {
            lptr slot = (lptr)(L + (t % NA_NS) * NA_SLOT);
            if (ph == 0) {
#pragma unroll
                for (int i = 0; i < 4; ++i) { const int rk = i * 16 + fr; lptr qp = slot + 16384 + rk * 128; const int sw = fq ^ fK(rk);
                    it[i].q0 = *(const LAS bf16x8*)(qp + (sw << 4)); it[i].q1 = *(const LAS bf16x8*)(qp + ((sw ^ 4) << 4)); item_init(it[i], -1e30f, 0.f); }
            }
            const LAS float* tbr = tb + (ph + 3) * 64;
#pragma unroll
            for (int i = 0; i < 4; ++i) { const LAS float* bp = tbr + tbi[i] + ((i == 1 || i == 2) ? 15 * 64 : 0); f32x4 b0, b1;
#pragma unroll
                for (int e = 0; e < 4; ++e) { b0[e] = bp[e]; b1[e] = bp[16 + e]; if (i == 0 || i == 3) { b0[e] += mk[i == 3][0][e]; b1[e] += mk[i == 3][1][e]; } }
                half_step(it[i], slot, b0, b1);
                if (i == 1) __builtin_amdgcn_sched_barrier(0); }
            if (ph == 7) {
#pragma unroll
                for (int i = 0; i < 4; ++i) item_store(it[i], c.O + ((size_t)b * SEQ + (size_t)r * GW + i * 16 + fr) * D + h * HD, lane);
            }
        }
    }
#undef NA_DMA
    __builtin_amdgcn_s_waitcnt(0x0F70);
}
__device__ __forceinline__ void na_phase(LAS unsigned char* L, const bf16* Q, const bf16* Kh, const bf16* Vh, bf16* O, const float* rpb, int vcu, int G) {
    NaCtx c; c.L = L; c.Q = Q; c.Kh = Kh; c.Vh = Vh; c.O = O; c.rpb = rpb; c.tid = threadIdx.x; c.lane = c.tid & 63; c.wid = __builtin_amdgcn_readfirstlane(c.tid >> 6); c.fr = c.lane & 15; c.fq = c.lane >> 4;
    c.tok = c.wid * 8 + (c.lane >> 3); c.cp = c.lane & 7;
    for (int task = vcu; task < BATCH * NH * 4; task += G) {
        const int qd = task & 3, h = (task >> 2) % NH, b = task / (4 * NH);
        if (qd == 0) na_edge(c, b, h, 0, 0);
        na_strip(c, b, h, qd == 0 ? 4 : 32 * qd, qd == 3 ? ROWS - 4 : 32 * qd + 32);
        if (qd == 3) na_edge(c, b, h, ROWS - 4, ROWS - KR);
    }
}

constexpr int SW_SLOT = 16384, SW_NS = 7, SW_TBL = SW_NS * SW_SLOT;
__device__ __forceinline__ void swa_phase(LAS unsigned char* L, const bf16* Q, const bf16* Kh, const bf16* Vh, bf16* O, const float* tblg, int vcu, int G) {
    const int tid = threadIdx.x, lane = tid & 63, wid = __builtin_amdgcn_readfirstlane(tid >> 6), fr = lane & 15, fq = lane >> 4;
    LAS float* tb = (LAS float*)(L + SW_TBL);
    const int tok = wid * 8 + (lane >> 3), cp = lane & 7;
    constexpr int NQB = SEQ / 64, QPT = 8, NTASK = BATCH * KVH * (NQB / QPT);
    for (int task = vcu; task < NTASK; task += G) {
        const int q0 = (task % (NQB / QPT)) * QPT, kv = (task / (NQB / QPT)) % KVH, b = task / (NQB / QPT * KVH);
        const size_t plane = ((size_t)(b * KVH + kv) * SEQ) * HD;
        const bf16* ksrc = Kh + plane + tok * HD + ((cp ^ fK(tok)) << 3); const bf16* vsrc = Vh + plane + tok * HD + ((cp ^ fV(tok)) << 3);
        const int cmax = q0 + QPT + 1 > NQB - 1 ? NQB - 1 : q0 + QPT + 1;
#define SW_DMA(ch) do { const int c_ = (ch); if (c_ >= 0 && c_ <= cmax) { const unsigned d = lds_u32(L + (c_ % SW_NS) * SW_SLOT + wid * 1024); glds16(ksrc + (size_t)c_ * 64 * HD, d); glds16(vsrc + (size_t)c_ * 64 * HD, d + 8192u); } } while (0)
        ATT_BAR();
        for (int ch = q0 - 2; ch <= q0 + 3; ++ch) SW_DMA(ch);
        for (int i = tid; i < 4 * 384; i += 512) { const int g = i / 384, rel = i % 384 - 192; tb[i] = (rel >= -WINDOW && rel <= WINDOW) ? tblg[(kv * 4 + g) * 257 + rel + WINDOW] : NEG; }
        const int g = wid >> 1, hq = kv * 4 + g; const float sink2 = tblg[16 * 257 + hq];
        Item it[2]; int tbi[2]; bf16x8 qn[2][2];
        const bf16* qbase = Q + ((size_t)b * SEQ + fr) * D + hq * HD + 8 * fq;
#pragma unroll
        for (int i = 0; i < 2; ++i) { const int qt = 2 * (wid & 1) + i; const bf16* qp = qbase + (size_t)(64 * q0 + 16 * qt) * D;
            qn[i][0] = *(const bf16x8*)qp; qn[i][1] = *(const bf16x8*)(qp + 32);
            item_addr(it[i], 0, lane); tbi[i] = g * 384 + 192 + 4 * fq - 16 * qt - fr; }
        __builtin_amdgcn_s_waitcnt(0x0F70);
        for (int qb = q0; qb < q0 + QPT; ++qb) {
            ATT_BAR();
            if (qb > q0) SW_DMA(qb + 3);
#pragma unroll
            for (int i = 0; i < 2; ++i) { it[i].q0 = qn[i][0]; it[i].q1 = qn[i][1]; item_init(it[i], sink2, fq == 0 ? 1.f : 0.f); }
            if (qb + 1 < q0 + QPT) {
#pragma unroll
                for (int i = 0; i < 2; ++i) { const int qt = 2 * (wid & 1) + i; const bf16* qp = qbase + (size_t)(64 * (qb + 1) + 16 * qt) * D; qn[i][0] = *(const bf16x8*)qp; qn[i][1] = *(const bf16x8*)(qp + 32); }
            }
            const int clo = qb - 2 < 0 ? 0 : qb - 2, chi_ = qb + 2 > NQB - 1 ? NQB - 1 : qb + 2;
#ifdef PROBE_SW
            unsigned long long pt0 = 0, pc0 = 0; if (qb == q0 + 3) { pt0 = __builtin_amdgcn_s_memrealtime(); pc0 = __builtin_amdgcn_s_memtime(); }
#endif
            for (int cb = clo; cb <= chi_; ++cb) {
                lptr slot = (lptr)(L + (cb % SW_NS) * SW_SLOT);
#pragma unroll
                for (int hs = 0; hs < 2; ++hs)
#pragma unroll
                    for (int i = 0; i < 2; ++i) { const int qt = 2 * (wid & 1) + i, k0 = 64 * cb + 32 * hs, tq0 = 64 * qb + 16 * qt;
                        if (k0 + 31 >= tq0 - WINDOW && k0 <= tq0 + 15 + WINDOW) {
                            const LAS float* bp = tb + tbi[i] + 64 * (cb - qb) + 32 * hs; f32x4 b0, b1;
#pragma unroll
                            for (int e = 0; e < 4; ++e) { b0[e] = bp[e]; b1[e] = bp[16 + e]; }
                            half_step(it[i], slot + hs * 4096, b0, b1); } }
            }
#ifdef PROBE_SW
            if (qb == q0 + 3) { asm volatile("" :: "v"(it[0].o0), "v"(it[1].o0)); const unsigned long long pt1 = __builtin_amdgcn_s_memrealtime(), pc1 = __builtin_amdgcn_s_memtime();
                if (blockIdx.x == 0 && tid == 0 && task == vcu) { volatile LAS unsigned* MI = (volatile LAS unsigned*)(L + 131072 + 320); MI[40] = (unsigned)(pt1 - pt0); MI[41] = (unsigned)(pc1 - pc0); } }
#endif
#pragma unroll
            for (int i = 0; i < 2; ++i) { const int qt = 2 * (wid & 1) + i; item_store(it[i], O + ((size_t)b * SEQ + (size_t)qb * 64 + qt * 16 + fr) * D + hq * HD, lane); }
            __builtin_amdgcn_s_waitcnt(0x0F70);
        }
#undef SW_DMA
    }
}
#undef ATT_WAITV
#undef ATT_BAR
}

#ifndef PG8_SP2
#define PG8_SP2 true
#endif
#ifndef PG8_ALIGN
#define PG8_ALIGN true
#endif
#ifndef MK_N_LAUNCHES
#define MK_N_LAUNCHES 1
#endif
constexpr int NWAVES = 8;
constexpr int RING_OFF = 0, RING_BYTES = 131072, LDSCTL_OFF = RING_BYTES, MISC_OFF = LDSCTL_OFF + 320, LDS_BYTES = 147456;
constexpr int CW_BAR = 4096;
constexpr int NPHASE = 12;

__device__ __forceinline__ void p0_transpose_item(const float* W, const float* g, int K, int N, bf16* WT, LAS float* scr, int item, int lane) {
    const int nblk = N / 32, kb = item / nblk, nb = item % nblk, k0 = 64 * kb, n0 = 32 * nb;
#pragma unroll 8
    for (int i = 0; i < 32; ++i) { const int kk = 2 * i + (lane >> 5); scr[kk * 33 + (lane & 31)] = W[(size_t)(k0 + kk) * N + n0 + (lane & 31)] * (g ? g[k0 + kk] : 1.0f); }
    LDS_WAIT(); asm volatile("" ::: "memory");
    const int c = lane & 7;
#pragma unroll
    for (int j = 0; j < 4; ++j) { const int n = (lane >> 3) + 8 * j; const LAS float* s = scr + (8 * c) * 33 + n;
        v4u o; o.x = pk2(s[0 * 33], s[1 * 33]); o.y = pk2(s[2 * 33], s[3 * 33]); o.z = pk2(s[4 * 33], s[5 * 33]); o.w = pk2(s[6 * 33], s[7 * 33]);
        *(GAS v4u*)(WT + (size_t)(n0 + n) * K + k0 + 8 * c) = o; }
    LDS_WAIT(); asm volatile("" ::: "memory");
}

struct Args { const float* in[13]; float* out; unsigned char* ws; int ph_lo, ph_hi; };
__global__ void __launch_bounds__(NWAVES * 64, 2) mk_fwd(Args args) {
    extern __shared__ __attribute__((aligned(16))) unsigned char lds[];
    LAS unsigned char* L = (LAS unsigned char*)lds;
    volatile LAS unsigned* MISC = (volatile LAS unsigned*)(L + MISC_OFF);
    const int tid = threadIdx.x, lane = tid & 63, wave = __builtin_amdgcn_readfirstlane(tid >> 6);
    unsigned char* ws = args.ws;
    gu32* ctl = (gu32*)(ws + WS_CTL);
    float* ssq = (float*)(ws + WS_SSQ); float* tblg = (float*)(ws + WS_TBL);
    bf16 *Wqkv0 = (bf16*)(ws + WS_WQKV0), *Wo0 = (bf16*)(ws + WS_WO0), *Win0 = (bf16*)(ws + WS_WIN0), *Wout0 = (bf16*)(ws + WS_WOUT0);
    bf16 *Wqkv1 = (bf16*)(ws + WS_WQKV1), *Wo1 = (bf16*)(ws + WS_WO1), *Win1 = (bf16*)(ws + WS_WIN1), *Wout1 = (bf16*)(ws + WS_WOUT1);
    bf16 *XB = (bf16*)(ws + WS_XB), *Qb = (bf16*)(ws + WS_Q), *Kb = (bf16*)(ws + WS_K), *Vb = (bf16*)(ws + WS_V), *Hb = (bf16*)(ws + WS_H);
    const float* x = args.in[0]; float* out = args.out;
    const int G = gridDim.x; int vcu; { const int bx = blockIdx.x; vcu = (G % 8 == 0) ? (bx % 8) * (G / 8) + bx / 8 : bx; }
    for (int u = tid; u < (LDS_BYTES - LDSCTL_OFF) / 4; u += NWAVES * 64) ((LAS unsigned*)(L + LDSCTL_OFF))[u] = 0u;
    __syncthreads();
    XcdBarrier bar; bar.bar = (unsigned*)(ctl + CW_BAR); bar.x = 0; bar.st = nullptr;
    if (MK_N_LAUNCHES == 1) bar = xcd_barrier_post((unsigned*)(ctl + CW_BAR), MISC + 8);
    const int lo = args.ph_lo, hi = args.ph_hi;
#define IN(k) (lo <= (k) && (k) < hi)
#ifndef PROBE_SCALE
#define PROBE_SCALE 0.01f
#endif
#ifdef PROBE_A
#define STAMP(k) do { if (blockIdx.x == 0 && tid == 0) MISC[16 + (k)] = (unsigned)__builtin_amdgcn_s_memrealtime(); } while (0)
#else
#define STAMP(k) do {} while (0)
#endif
#define SEAM(k) do { if (IN(k) && IN((k) + 1)) xcd_barrier(bar); STAMP((k) + 1); } while (0)
    STAMP(0);

    if (IN(0)) {
        LAS float* scr = (LAS float*)(L + RING_OFF + wave * 16384);
        const int gw = vcu * NWAVES + wave, NGW = G * NWAVES;
        const float *mix_norm = args.in[1], *mlp_norm = args.in[2], *w_in = args.in[11], *w_out = args.in[12];
        constexpr int I_QKV0 = (D / 64) * (3072 / 32), I_O = (D / 64) * (D / 32), I_IN = (D / 64) * (FF / 32), I_OUT = (FF / 64) * (D / 32), I_QKV1 = (D / 64) * (1536 / 32);
        constexpr int NITEMS = I_QKV0 + I_QKV1 + 2 * (I_O + I_IN + I_OUT);
        for (int it = gw; it < NITEMS; it += NGW) {
            int r = it;
            if (r < I_QKV0) { p0_transpose_item(args.in[4], mix_norm, D, 3072, Wqkv0, scr, r, lane); continue; } r -= I_QKV0;
            if (r < I_O) { p0_transpose_item(args.in[6], nullptr, D, D, Wo0, scr, r, lane); continue; } r -= I_O;
            if (r < I_IN) { p0_transpose_item(w_in, mlp_norm, D, FF, Win0, scr, r, lane); continue; } r -= I_IN;
            if (r < I_OUT) { p0_transpose_item(w_out, nullptr, FF, D, Wout0, scr, r, lane); continue; } r -= I_OUT;
            if (r < I_QKV1) { p0_transpose_item(args.in[7], mix_norm + D, D, 1536, Wqkv1, scr, r, lane); continue; } r -= I_QKV1;
            if (r < I_O) { p0_transpose_item(args.in[9], nullptr, D, D, Wo1, scr, r, lane); continue; } r -= I_O;
            if (r < I_IN) { p0_transpose_item(w_in + (size_t)D * FF, mlp_norm + D, D, FF, Win1, scr, r, lane); continue; } r -= I_IN;
            p0_transpose_item(w_out + (size_t)D * FF, nullptr, FF, D, Wout1, scr, r, lane);
        }
        for (int i = vcu * (NWAVES * 64) + tid; i < 16 * 257 + 16; i += G * NWAVES * 64) {
            if (i < 16 * 257) { const int h = i / 257, rel = i % 257 - 128; const int n = rel < 0 ? -rel : rel; int bk;
                if (n < 8) bk = n; else { const int k = (31 - __clz(n * n)) - 6; bk = 8 + (k < 7 ? k : 7); }
                if (rel > 0) bk += 16;
                tblg[i] = args.in[10][bk * 16 + h] * LOG2E; }
            else tblg[i] = args.in[8][i - 16 * 257] * LOG2E;
        }
        for (int m = gw; m < M; m += NGW) {
            const GAS f32x4* xr = (const GAS f32x4*)(x + (size_t)m * D) + lane; GAS unsigned long long* o8 = (GAS unsigned long long*)(XB + (size_t)m * D) + lane;
            float s = 0.f;
#pragma unroll
            for (int j = 0; j < 4; ++j) { const f32x4 v = xr[64 * j]; s += (v.x * v.x + v.y * v.y) + (v.z * v.z + v.w * v.w);
                o8[64 * j] = (unsigned long long)pk2(v.x, v.y) | ((unsigned long long)pk2(v.z, v.w) << 32); }
            s = wave_sum(s);
            if (lane < 16) ssq[(size_t)m * 16 + lane] = lane == 0 ? s : 0.f;
        }
    }
    SEAM(0);
    if (IN(1)) { pg8::Gemm g{XB, Wqkv0, M, 3072, D}; pg8::StaticOrder S; S.init(M, 3072, G, (int)blockIdx.x);
        pg8::EpiQKV E{Qb, Kb, Vb, D, C2, ssq};
        pg8::gemm_phase<pg8::EpiQKV, pg8::StaticOrder, PG8_ALIGN, PG8_SP2>(L + RING_OFF, g, S, E); }
    SEAM(1);
#ifdef PROBE_NA
    if (IN(2)) { att::na_phase(L + RING_OFF, Qb, Kb, Vb, (bf16*)(ws + 448 * MiB), args.in[5], vcu, G); xcd_barrier(bar); STAMP(13);
                 att::na_phase(L + RING_OFF, Qb, Kb, Vb, (bf16*)(ws + 448 * MiB), args.in[5], vcu, G); xcd_barrier(bar); STAMP(14); }
#endif
    if (IN(2)) att::na_phase(L + RING_OFF, Qb, Kb, Vb, Qb, args.in[5], vcu, G);
    SEAM(2);
    if (IN(3)) { pg8::Gemm g{Qb, Wo0, M, D, D}; pg8::StaticOrder S; S.init(M, D, G, (int)blockIdx.x);
        pg8::EpiRes2<true, false> E{x, nullptr, XB, ssq};
        pg8::gemm_phase<pg8::EpiRes2<true, false>, pg8::StaticOrder, PG8_ALIGN, PG8_SP2>(L + RING_OFF, g, S, E); }
    SEAM(3);
    if (IN(4)) { pg8::Gemm g{XB, Win0, M, FF, D}; pg8::StaticOrder S; S.init(M, FF, G, (int)blockIdx.x);
        pg8::EpiUp E{Hb, ssq};
        pg8::gemm_phase<pg8::EpiUp, pg8::StaticOrder, PG8_ALIGN, PG8_SP2>(L + RING_OFF, g, S, E); }
    SEAM(4);
    if (IN(5)) { pg8::Gemm g{Hb, Wout0, M, D, FF}; pg8::StaticOrder S; S.init(M, D, G, (int)blockIdx.x);
        pg8::EpiRes2<false, false> E{nullptr, nullptr, XB, ssq};
        pg8::gemm_phase<pg8::EpiRes2<false, false>, pg8::StaticOrder, PG8_ALIGN, PG8_SP2>(L + RING_OFF, g, S, E); }
    SEAM(5);
    if (IN(6)) { pg8::Gemm g{XB, Wqkv1, M, 1536, D}; pg8::StaticOrder S; S.init(M, 1536, G, (int)blockIdx.x);
        pg8::EpiQKV E{Qb, Kb, Vb, 256, C2, ssq};
        pg8::gemm_phase<pg8::EpiQKV, pg8::StaticOrder, PG8_ALIGN, PG8_SP2>(L + RING_OFF, g, S, E); }
    SEAM(6);
    if (IN(7)) att::swa_phase(L + RING_OFF, Qb, Kb, Vb, Qb, tblg, vcu, G);
    SEAM(7);
    if (IN(8)) { pg8::Gemm g{Qb, Wo1, M, D, D}; pg8::StaticOrder S; S.init(M, D, G, (int)blockIdx.x);
        pg8::EpiRes2<false, false> E{nullptr, nullptr, XB, ssq};
        pg8::gemm_phase<pg8::EpiRes2<false, false>, pg8::StaticOrder, PG8_ALIGN, PG8_SP2>(L + RING_OFF, g, S, E); }
    SEAM(8);
    if (IN(9)) { pg8::Gemm g{XB, Win1, M, FF, D}; pg8::StaticOrder S; S.init(M, FF, G, (int)blockIdx.x);
        pg8::EpiUp E{Hb, ssq};
        pg8::gemm_phase<pg8::EpiUp, pg8::StaticOrder, PG8_ALIGN, PG8_SP2>(L + RING_OFF, g, S, E); }
    SEAM(9);
    if (IN(10)) { pg8::Gemm g{Hb, Wout1, M, D, FF}; pg8::StaticOrder S; S.init(M, D, G, (int)blockIdx.x);
        pg8::EpiRes2<false, true> E{nullptr, out, XB, ssq};
        pg8::gemm_phase<pg8::EpiRes2<false, true>, pg8::StaticOrder, PG8_ALIGN, PG8_SP2>(L + RING_OFF, g, S, E); }
    SEAM(10);
    if (IN(11)) {
        const int gw = vcu * NWAVES + wave, NGW = G * NWAVES; const GAS f32x4* gr = (const GAS f32x4*)args.in[3] + lane;
        const f32x4 g0 = gr[0], g1 = gr[64], g2 = gr[128], g3 = gr[192];
        for (int m = gw; m < M; m += NGW) {
            const float r = pg8::rstd16(ssq, m); GAS f32x4* xr = (GAS f32x4*)(out + (size_t)m * D) + lane;
            const f32x4 v0 = xr[0], v1 = xr[64], v2 = xr[128], v3 = xr[192];
            xr[0] = v0 * r * g0; xr[64] = v1 * r * g1; xr[128] = v2 * r * g2; xr[192] = v3 * r * g3;
        }
    }
#ifdef PROBE_A
    xcd_barrier(bar); STAMP(12);
    if (blockIdx.x == 0) { __syncthreads();
        #if defined(PROBE_SW)
        const float ta = (float)MISC[40] * 0.01f, tb2 = (float)MISC[41] * 0.001f;
#elif defined(PROBE_NA)
        const float ta = (float)(MISC[16 + 13] - MISC[16 + 2]) * 0.01f, tb2 = (float)(MISC[16 + 14] - MISC[16 + 13]) * 0.01f;
#else
        const float ta = (float)(MISC[16 + PROBE_A + 1] - MISC[16 + PROBE_A]) * 0.01f, tb2 = (float)(MISC[16 + PROBE_B + 1] - MISC[16 + PROBE_B]) * 0.01f;
#endif
        if (tid == 0) out[0] += ta * PROBE_SCALE;
        out[D + tid] += tb2 * PROBE_SCALE; out[D + 512 + tid] += tb2 * PROBE_SCALE; }
#endif
#undef IN
#undef SEAM
}

extern "C" void kernel_launch(void* const* d_in, const int* in_sizes, int n_in, void* d_out, int out_size, void* d_ws, size_t ws_size, hipStream_t stream) {
    static int grid = 0;
    if (grid == 0) {
        if (n_in != 13 || in_sizes[0] != M * D || out_size != M * D || ws_size < WS_END) { fprintf(stderr, "kernel_launch: unexpected shapes (n_in %d in0 %d out %d ws %zu)\n", n_in, n_in > 0 ? in_sizes[0] : -1, out_size, ws_size); grid = -1; return; }
        int dev = 0, cus = 0, per_cu = 0;
        if (hipGetDevice(&dev) != hipSuccess || hipDeviceGetAttribute(&cus, hipDeviceAttributeMultiprocessorCount, dev) != hipSuccess) { grid = -1; return; }
        if (hipFuncSetAttribute((const void*)mk_fwd, hipFuncAttributeMaxDynamicSharedMemorySize, LDS_BYTES) != hipSuccess) { fprintf(stderr, "kernel_launch: hipFuncSetAttribute failed\n"); grid = -1; return; }
        if (hipOccupancyMaxActiveBlocksPerMultiprocessor(&per_cu, (const void*)mk_fwd, NWAVES * 64, LDS_BYTES) != hipSuccess || per_cu < 1) { fprintf(stderr, "kernel_launch: occupancy query says %d blocks per CU\n", per_cu); grid = -1; (void)hipGetLastError(); return; }
        (void)hipGetLastError();
        grid = cus;
    }
    if (grid < 0) return;
    (void)hipMemsetAsync((unsigned char*)d_ws + WS_CTL, 0, 1 * MiB, stream);
    Args a{}; for (int i = 0; i < 13; ++i) a.in[i] = (const float*)d_in[i]; a.out = (float*)d_out; a.ws = (unsigned char*)d_ws;
#if MK_N_LAUNCHES == 1
    a.ph_lo = 0; a.ph_hi = NPHASE; hipLaunchKernelGGL(mk_fwd, dim3(grid), dim3(NWAVES * 64), LDS_BYTES, stream, a);
#else
    for (int p = 0; p < NPHASE; ++p) { a.ph_lo = p; a.ph_hi = p + 1; hipLaunchKernelGGL(mk_fwd, dim3(grid), dim3(NWAVES * 64), LDS_BYTES, stream, a); }
#endif
}
```

```cpp
#include <hip/hip_runtime.h>
#include <cstdint>
#include <cstdio>

typedef unsigned short bf16;
constexpr int BATCH = 4, SEQ = 8192, D = 1024, NH = 16, HD = 64, KVH = 4, FF = 4096, M = BATCH * SEQ;
constexpr int GW = 64, ROWS = SEQ / GW, KR = 8, KC = 16, WINDOW = 128;
constexpr float EPS = 1e-6f, LOG2E = 1.4426950408889634f, C2 = 0.125f * LOG2E;
constexpr size_t MiB = 1u << 20;
constexpr size_t WS_CTL = 0, WS_SSQ = 1 * MiB, WS_TBL = 3 * MiB, WS_SSQ2 = 50 * MiB;
constexpr size_t WS_WQKV0 = 4 * MiB, WS_WO0 = 10 * MiB, WS_WIN0 = 12 * MiB, WS_WOUT0 = 20 * MiB, WS_WQKV1 = 28 * MiB, WS_WO1 = 31 * MiB, WS_WIN1 = 33 * MiB, WS_WOUT1 = 41 * MiB;
constexpr size_t WS_XB = 64 * MiB, WS_Q = 128 * MiB, WS_K = 192 * MiB, WS_V = 256 * MiB, WS_H = 128 * MiB, WS_END = 384 * MiB;

__device__ __forceinline__ unsigned f2bf(float f) { unsigned u = __builtin_bit_cast(unsigned, f); return (u + 0x7fffu + ((u >> 16) & 1u)) >> 16; }
__device__ __forceinline__ float bf2f(bf16 b) { return __builtin_bit_cast(float, (unsigned)b << 16); }
__device__ __forceinline__ float wave_sum(float v) {
#pragma unroll
    for (int o = 1; o < 64; o <<= 1) v += __shfl_xor(v, o);
    return v;
}
__device__ __forceinline__ float row_rstd(const float* ssq, int row) {
    const float4* p = (const float4*)(ssq + (size_t)row * 16);
    float4 a = p[0], b = p[1], c = p[2], d = p[3];
    float s = ((a.x + a.y) + (a.z + a.w)) + ((b.x + b.y) + (b.z + b.w)) + ((c.x + c.y) + (c.z + c.w)) + ((d.x + d.y) + (d.z + d.w));
    return 1.0f / sqrtf(s * (1.0f / D) + EPS);
}


namespace pg8 {
#define PG8_LAS __attribute__((address_space(3)))
typedef unsigned short bf16_t;
typedef short bf16x8 __attribute__((ext_vector_type(8)));
typedef float f32x4 __attribute__((ext_vector_type(4)));
typedef unsigned u32x4 __attribute__((ext_vector_type(4)));
constexpr int BM = 256, BK = 64, HALF = 128, HTB = HALF * BK * 2  , STAGE_BYTES = 8 * HTB, NXCD = 8, WGM = 8;

__host__ __device__ __forceinline__ int lds_byte(int r, int c) { const int st = (r >> 4) * 2 + (c >> 5), rr = r & 15, cc = c & 31, ob = rr * 64 + cc * 2; return st * 1024 + (ob ^ (((ob >> 9) & 1) << 5)); }
__host__ __device__ __forceinline__ void stage_rc(int b, int& R, int& C) { const int st = b / 1024, sb = b % 1024, swz = sb ^ (((sb >> 9) & 1) << 5); R = (st >> 1) * 16 + swz / 64; C = (st & 1) * 32 + (swz % 64) / 2; }
__host__ __device__ __forceinline__ int perm32(int rho) { const int n = rho >> 4, i = rho & 15; return 8 * (i >> 2) + 4 * n + (i & 3); }

struct Unit { int pm, pn; };
struct Gemm { const bf16_t* A; const bf16_t* Bt; int M, N, K; };

struct StaticOrder {
    int nM, nN, nwg, G, c;
    __host__ __device__ void init(int M, int N, int G_, int c_) { nM = M / BM; nN = N / BM; nwg = nM * nN; G = G_; c = c_; }
    __host__ __device__ bool next(int i, Unit& u) const {
        const long L = (long)i * G + c; if (L >= nwg) return false;
        int wgid = (int)L; { const int q = nwg / NXCD, r = nwg % NXCD, xcd = wgid % NXCD, off = wgid / NXCD; wgid = (xcd < r ? xcd * (q + 1) : r * (q + 1) + (xcd - r) * q) + off; }
        const int nig = WGM * nN, gid = wgid / nig, fm = gid * WGM, gsz = (nM - fm) < WGM ? (nM - fm) : WGM;
        u.pm = fm + ((wgid % nig) % gsz); u.pn = (wgid % nig) / gsz; return true;
    }
    __device__ __forceinline__ void a_ready(const Unit&) const {}
    __device__ __forceinline__ void done(const Unit&) const {}
};

__device__ __forceinline__ unsigned cvt_pk_bf16(float lo, float hi) { unsigned r; asm volatile("v_cvt_pk_bf16_f32 %0, %1, %2" : "=v"(r) : "v"(lo), "v"(hi)); return r; }
typedef float f32x2 __attribute__((ext_vector_type(2)));
__device__ __forceinline__ float rstd16(const float* ssq, int row) {
    const f32x4* p = (const f32x4*)(ssq + (size_t)row * 16);
    const f32x4 a = p[0], b = p[1], c = p[2], d = p[3];
    const float s = (((a[0] + a[1]) + (a[2] + a[3])) + ((b[0] + b[1]) + (b[2] + b[3]))) + (((c[0] + c[1]) + (c[2] + c[3])) + ((d[0] + d[1]) + (d[2] + d[3])));
    return __builtin_amdgcn_rsqf(s * (1.0f / 1024.0f) + 1e-6f);
}
__device__ __forceinline__ float row_ssq_q(const float* ssq, int row, int fq) {
    const f32x4 a = *(const f32x4*)(ssq + (size_t)row * 16 + 4 * fq);
    float s = (a[0] + a[1]) + (a[2] + a[3]); s += __shfl_xor(s, 16); s += __shfl_xor(s, 32); return s;
}
struct EpiQKV {
    static constexpr bool PERM = true, AFTER_DRAIN = false;
    bf16_t *Q, *Kp, *V; int kvw; float qscale; const float* ssq;
    __device__ __forceinline__ void operator()(const f32x4 (&acc)[2][2][4][2], const Unit& u, int wr, int wc, int fr, int fq) const {
        int colt = u.pn * BM; bf16_t* base; float sc = 1.f; bool hm = true;
        if (colt < 1024) { base = Q; sc = qscale; hm = false; } else if (colt < 1024 + kvw) { base = Kp; colt -= 1024; } else { base = V; colt -= 1024 + kvw; }
        const int col0 = colt + wc * 32 + 8 * fq, row0 = u.pm * BM + wr * 64 + fr, nhk = kvw >> 6;
#pragma unroll
        for (int ai = 0; ai < 2; ++ai)
#pragma unroll
            for (int m = 0; m < 4; ++m) { const int row = row0 + ai * HALF + m * 16; const float rs = __builtin_amdgcn_rsqf(row_ssq_q(ssq, row, fq) * (1.0f / 1024.0f) + 1e-6f) * sc; const int bb = row >> 13, tk = row & 8191;
#pragma unroll
                for (int bj = 0; bj < 2; ++bj) { const f32x4 v0 = acc[ai][bj][m][0] * rs, v1 = acc[ai][bj][m][1] * rs; const int cc = col0 + bj * HALF;
                    u32x4 w; w.x = cvt_pk_bf16(v0[0], v0[1]); w.y = cvt_pk_bf16(v0[2], v0[3]); w.z = cvt_pk_bf16(v1[0], v1[1]); w.w = cvt_pk_bf16(v1[2], v1[3]);
                    bf16_t* p = hm ? base + ((size_t)(bb * nhk + (cc >> 6)) * 8192 + tk) * 64 + (cc & 63) : base + (size_t)row * 1024 + cc;
                    *(u32x4*)p = w; } }
    }
};
struct EpiUp {
    static constexpr bool PERM = true, AFTER_DRAIN = false;
    bf16_t* Hh;
    __device__ __forceinline__ void operator()(const f32x4 (&acc)[2][2][4][2], const Unit& u, int wr, int wc, int fr, int fq) const {
        const int col0 = u.pn * BM + wc * 32 + 8 * fq, row0 = u.pm * BM + wr * 64 + fr;
#pragma unroll
        for (int ai = 0; ai < 2; ++ai)
#pragma unroll
            for (int m = 0; m < 4; ++m) { const int row = row0 + ai * HALF + m * 16; bf16_t* rowp = Hh + (size_t)row * 4096 + col0;
#pragma unroll
                for (int bj = 0; bj < 2; ++bj) { f32x4 v0 = acc[ai][bj][m][0], v1 = acc[ai][bj][m][1];
#pragma unroll
                    for (int e = 0; e < 4; ++e) { const float a = __builtin_fmaxf(v0[e], 0.f), b = __builtin_fmaxf(v1[e], 0.f); v0[e] = a * a; v1[e] = b * b; }
                    u32x4 w; w.x = cvt_pk_bf16(v0[0], v0[1]); w.y = cvt_pk_bf16(v0[2], v0[3]); w.z = cvt_pk_bf16(v1[0], v1[1]); w.w = cvt_pk_bf16(v1[2], v1[3]);
                    *(u32x4*)(rowp + bj * HALF) = w; } }
    }
};
struct EpiRes {
    static constexpr bool PERM = false, AFTER_DRAIN = false;
    const float* base; float* out; bf16_t* xb; float* ssq;
    __device__ __forceinline__ void operator()(const f32x4 (&acc)[2][2][4][2], const Unit& u, int wr, int wc, int fr, int fq) const {
        typedef unsigned u32x2v __attribute__((ext_vector_type(2)));
        const int col0 = u.pn * BM + wc * 32 + 4 * fq, row0 = u.pm * BM + wr * 64 + fr;
#pragma unroll
        for (int ai = 0; ai < 2; ++ai)
#pragma unroll
            for (int m = 0; m < 4; ++m) { const int row = row0 + ai * HALF + m * 16; const size_t off = (size_t)row * 1024 + col0; float s = 0.f;
#pragma unroll
                for (int bj = 0; bj < 2; ++bj)
#pragma unroll
                    for (int n = 0; n < 2; ++n) { const f32x4 bs = *(const f32x4*)(base + off + bj * HALF + n * 16); const f32x4 o = bs + acc[ai][bj][m][n];
                        *(f32x4*)(out + off + bj * HALF + n * 16) = o; s += (o[0] * o[0] + o[1] * o[1]) + (o[2] * o[2] + o[3] * o[3]);
                        u32x2v w; w.x = cvt_pk_bf16(o[0], o[1]); w.y = cvt_pk_bf16(o[2], o[3]); *(u32x2v*)(xb + off + bj * HALF + n * 16) = w; }
                s += __shfl_xor(s, 16); s += __shfl_xor(s, 32);
                if (fq == 0) ssq[(size_t)row * 16 + u.pn * 4 + wc] = s; }
    }
};
template <bool BASE_F32, bool OUT_F32, bool RSQ> struct EpiRes2 {
    static constexpr bool PERM = true, AFTER_DRAIN = false;
    const float* basef; float* outf; bf16_t* xb; float* ssq; const float* ssq_in;
    __device__ __forceinline__ void operator()(const f32x4 (&acc)[2][2][4][2], const Unit& u, int wr, int wc, int fr, int fq) const {
        const int col0 = u.pn * BM + wc * 32 + 8 * fq, row0 = u.pm * BM + wr * 64 + fr;
#pragma unroll
        for (int ai = 0; ai < 2; ++ai)
#pragma unroll
            for (int m = 0; m < 4; ++m) { const int row = row0 + ai * HALF + m * 16; const size_t off = (size_t)row * 1024 + col0; float s = 0.f;
                float r2 = 1.f; if (RSQ) r2 = 1.0f / (row_ssq_q(ssq_in, row, fq) * (1.0f / 1024.0f) + 1e-6f);
#pragma unroll
                for (int bj = 0; bj < 2; ++bj) { f32x4 b0, b1;
                    if (BASE_F32) { b0 = *(const f32x4*)(basef + off + bj * HALF); b1 = *(const f32x4*)(basef + off + bj * HALF + 4); }
                    else { const u32x4 w = *(const u32x4*)(xb + off + bj * HALF);
                        b0 = (f32x4){__builtin_bit_cast(float, w.x << 16), __builtin_bit_cast(float, w.x & 0xffff0000u), __builtin_bit_cast(float, w.y << 16), __builtin_bit_cast(float, w.y & 0xffff0000u)};
                        b1 = (f32x4){__builtin_bit_cast(float, w.z << 16), __builtin_bit_cast(float, w.z & 0xffff0000u), __builtin_bit_cast(float, w.w << 16), __builtin_bit_cast(float, w.w & 0xffff0000u)}; }
                    const f32x4 o0 = b0 + acc[ai][bj][m][0] * r2, o1 = b1 + acc[ai][bj][m][1] * r2;
                    s += ((o0[0] * o0[0] + o0[1] * o0[1]) + (o0[2] * o0[2] + o0[3] * o0[3])) + ((o1[0] * o1[0] + o1[1] * o1[1]) + (o1[2] * o1[2] + o1[3] * o1[3]));
                    if (OUT_F32) { *(f32x4*)(outf + off + bj * HALF) = o0; *(f32x4*)(outf + off + bj * HALF + 4) = o1; }
                    else { u32x4 w; w.x = cvt_pk_bf16(o0[0], o0[1]); w.y = cvt_pk_bf16(o0[2], o0[3]); w.z = cvt_pk_bf16(o1[0], o1[1]); w.w = cvt_pk_bf16(o1[2], o1[3]); *(u32x4*)(xb + off + bj * HALF) = w; } }
                s += __shfl_xor(s, 16); s += __shfl_xor(s, 32);
                if (fq == 0) ssq[(size_t)row * 16 + u.pn * 4 + wc] = s; }
    }
};
template <class Epi, class Sched, bool ALIGN_EPI = false, bool SP2 = false>
__device__ __forceinline__ void gemm_phase(PG8_LAS unsigned char* lds, const Gemm g, const Sched& S, const Epi& E) {
    const int tid = threadIdx.x, wid = __builtin_amdgcn_readfirstlane(tid >> 6), lane = tid & 63, wr = wid >> 2, wc = wid & 3, fr = lane & 15, fq = lane >> 4;
    const int K = g.K, nt = K / BK;
    unsigned voffA[2], voffB[2];
#pragma unroll
    for (int i = 0; i < 2; ++i) { int R, C; stage_rc(tid * 16 + i * 8192, R, C); const int Rb = Epi::PERM ? ((R & ~31) + perm32(R & 31)) : R;
        voffA[i] = (unsigned)(R * K + C) * 2u; voffB[i] = (unsigned)(Rb * K + C) * 2u; }
    const size_t kstep = (size_t)(BK * 2);
    const size_t hstep = (size_t)HALF * K * 2;
    const size_t tstep = 2 * hstep;
    const unsigned ldsw = (unsigned)wid * 1024u;
    const int aoff = lds_byte(wr * 64 + fr, fq * 8), boff = lds_byte(wc * 32 + fr, fq * 8);
#define PG8_SA(b, h) (((b) * 2 + (h)) * HTB)
#define PG8_SB(b, h) ((4 + (b) * 2 + (h)) * HTB)
#define PG8_STAGE(bufoff, gbase, voff) do { _Pragma("unroll") for (int _i = 0; _i < 2; ++_i) \
        __builtin_amdgcn_global_load_lds((const unsigned*)((const char*)(gbase) + (voff)[_i]), (PG8_LAS unsigned*)(lds + (bufoff) + ldsw + _i * 8192), 16, 0, 0); } while (0)
#define PG8_LDA(dst, b, h) do { _Pragma("unroll") for (int m = 0; m < 4; ++m) _Pragma("unroll") for (int k = 0; k < 2; ++k) dst[m][k] = *(const PG8_LAS bf16x8*)(lds + PG8_SA(b, h) + aoff + m * 2048 + k * 1024); } while (0)
#define PG8_LDB(dst, b, h) do { _Pragma("unroll") for (int n = 0; n < 2; ++n) _Pragma("unroll") for (int k = 0; k < 2; ++k) dst[n][k] = *(const PG8_LAS bf16x8*)(lds + PG8_SB(b, h) + boff + n * 2048 + k * 1024); } while (0)
#define PG8_MMA(ai, bj, At, Bt) do { __builtin_amdgcn_s_setprio(1); _Pragma("unroll") for (int m = 0; m < 4; ++m) _Pragma("unroll") for (int n = 0; n < 2; ++n) _Pragma("unroll") for (int k = 0; k < 2; ++k) \
        acc[ai][bj][m][n] = __builtin_amdgcn_mfma_f32_16x16x32_bf16(Bt[n][k], At[m][k], acc[ai][bj][m][n], 0, 0, 0); __builtin_amdgcn_s_setprio(0); } while (0)
#define PG8_WAIT_V(n) asm volatile("s_waitcnt vmcnt(" #n ")" ::: "memory")
#define PG8_WAIT_L(n) asm volatile("s_waitcnt lgkmcnt(" #n ")" ::: "memory")
#define PG8_BAR __builtin_amdgcn_s_barrier()
#define PG8_SCHED __builtin_amdgcn_sched_barrier(0)
    Unit cur, nxt; int ui = 0;
    if (!S.next(0, cur)) return;
    f32x4 acc[2][2][4][2];
#pragma unroll
    for (int a = 0; a < 2; ++a)
#pragma unroll
        for (int b = 0; b < 2; ++b)
#pragma unroll
            for (int m = 0; m < 4; ++m)
#pragma unroll
                for (int n = 0; n < 2; ++n) acc[a][b][m][n] = (f32x4){0.f, 0.f, 0.f, 0.f};
    bf16x8 At[4][2], B0[2][2], B1[2][2];
    const char* cA = (const char*)g.A + (size_t)cur.pm * tstep; const char* cB = (const char*)g.Bt + (size_t)cur.pn * tstep;
    S.a_ready(cur);
    if constexpr (SP2) {
        PG8_STAGE(PG8_SB(0, 0), cB, voffB); PG8_STAGE(PG8_SB(0, 1), cB + hstep, voffB); PG8_STAGE(PG8_SA(0, 0), cA, voffA); PG8_STAGE(PG8_SA(0, 1), cA + hstep, voffA);
        if (wr == 1) PG8_BAR;
        PG8_WAIT_V(2); PG8_BAR;
        PG8_STAGE(PG8_SB(1, 0), cB + kstep, voffB); PG8_STAGE(PG8_SA(1, 0), cA + kstep, voffA); PG8_STAGE(PG8_SB(1, 1), cB + hstep + kstep, voffB);
        PG8_WAIT_V(6); PG8_BAR;
    } else {
        PG8_STAGE(PG8_SB(0, 0), cB, voffB); PG8_STAGE(PG8_SA(0, 0), cA, voffA); PG8_STAGE(PG8_SB(0, 1), cB + hstep, voffB); PG8_STAGE(PG8_SA(0, 1), cA + hstep, voffA);
        if (wr == 1) PG8_BAR;
        PG8_WAIT_V(4); PG8_BAR;
        PG8_STAGE(PG8_SB(1, 0), cB + kstep, voffB); PG8_STAGE(PG8_SA(1, 0), cA + kstep, voffA); PG8_STAGE(PG8_SB(1, 1), cB + hstep + kstep, voffB);
        PG8_WAIT_V(6); PG8_BAR;
    }
    for (;;) {
        const bool has_next = S.next(ui + 1, nxt);
        const char* nA = has_next ? (const char*)g.A + (size_t)nxt.pm * tstep : cA; const char* nB = has_next ? (const char*)g.Bt + (size_t)nxt.pn * tstep : cB;
        for (int t = 0; t < nt; t += 2) {
            const bool last = (t == nt - 2);
            const char* a1 = cA + (size_t)(t + 1) * kstep;
            const char* a2 = last ? nA : cA + (size_t)(t + 2) * kstep; const char* b2 = last ? nB : cB + (size_t)(t + 2) * kstep;
            const char* a3 = a2 + kstep; const char* b3 = b2 + kstep;
            if (last && has_next) S.a_ready(nxt);
            if constexpr (SP2) {
            PG8_LDB(B0, 0, 0); PG8_LDB(B1, 0, 1); PG8_SCHED; PG8_LDA(At, 0, 0); PG8_STAGE(PG8_SA(1, 1), a1 + hstep, voffA);
            PG8_WAIT_V(8); PG8_WAIT_L(0); PG8_BAR; PG8_MMA(0, 0, At, B0); PG8_MMA(0, 1, At, B1); PG8_BAR; PG8_SCHED;
            PG8_LDA(At, 0, 1); PG8_STAGE(PG8_SB(0, 0), b2, voffB); PG8_STAGE(PG8_SB(0, 1), b2 + hstep, voffB); PG8_STAGE(PG8_SA(0, 0), a2, voffA);
            PG8_WAIT_V(8); PG8_WAIT_L(0); PG8_BAR; PG8_MMA(1, 0, At, B0); PG8_MMA(1, 1, At, B1); PG8_BAR; PG8_SCHED;
            PG8_LDB(B0, 1, 0); PG8_LDB(B1, 1, 1); PG8_SCHED; PG8_LDA(At, 1, 0); PG8_STAGE(PG8_SA(0, 1), a2 + hstep, voffA);
            PG8_WAIT_V(8); PG8_WAIT_L(0); PG8_BAR; PG8_MMA(0, 0, At, B0); PG8_MMA(0, 1, At, B1); PG8_BAR; PG8_SCHED;
            PG8_LDA(At, 1, 1); PG8_STAGE(PG8_SB(1, 0), b3, voffB); PG8_STAGE(PG8_SB(1, 1), b3 + hstep, voffB); PG8_STAGE(PG8_SA(1, 0), a3, voffA);
            PG8_WAIT_V(8); PG8_WAIT_L(0); PG8_BAR; PG8_MMA(1, 0, At, B0); PG8_MMA(1, 1, At, B1); PG8_BAR; PG8_SCHED;
            } else {
            PG8_LDB(B0, 0, 0); PG8_SCHED; PG8_LDA(At, 0, 0); PG8_STAGE(PG8_SA(1, 1), a1 + hstep, voffA);
            PG8_WAIT_L(8); PG8_BAR; PG8_WAIT_L(0); PG8_MMA(0, 0, At, B0); PG8_BAR; PG8_SCHED;
            PG8_LDB(B1, 0, 1); PG8_STAGE(PG8_SB(0, 0), b2, voffB);
            PG8_BAR; PG8_WAIT_L(0); PG8_MMA(0, 1, At, B1); PG8_BAR;
            PG8_LDA(At, 0, 1); PG8_STAGE(PG8_SA(0, 0), a2, voffA);
            PG8_BAR; PG8_WAIT_L(0); PG8_MMA(1, 0, At, B0); PG8_BAR; PG8_SCHED;
            PG8_STAGE(PG8_SB(0, 1), b2 + hstep, voffB);
            PG8_WAIT_V(6); PG8_BAR; PG8_MMA(1, 1, At, B1); PG8_BAR;
            PG8_LDB(B0, 1, 0); PG8_SCHED; PG8_LDA(At, 1, 0); PG8_STAGE(PG8_SA(0, 1), a2 + hstep, voffA);
            PG8_WAIT_L(8); PG8_BAR; PG8_WAIT_L(0); PG8_MMA(0, 0, At, B0); PG8_BAR; PG8_SCHED;
            PG8_LDB(B1, 1, 1); PG8_STAGE(PG8_SB(1, 0), b3, voffB);
            PG8_BAR; PG8_WAIT_L(0); PG8_MMA(0, 1, At, B1); PG8_BAR;
            PG8_LDA(At, 1, 1); PG8_STAGE(PG8_SA(1, 0), a3, voffA);
            PG8_BAR; PG8_WAIT_L(0); PG8_MMA(1, 0, At, B0); PG8_BAR; PG8_SCHED;
            PG8_STAGE(PG8_SB(1, 1), b3 + hstep, voffB);
            PG8_WAIT_V(6); PG8_BAR; PG8_MMA(1, 1, At, B1); PG8_BAR;
            }
        }
        if constexpr (ALIGN_EPI) { if (wr == 0) PG8_BAR; }
        if constexpr (!Epi::AFTER_DRAIN) { E(acc, cur, wr, wc, fr, fq); S.done(cur); }
        if (!has_next) break;
#pragma unroll
        for (int a = 0; a < 2; ++a)
#pragma unroll
            for (int b = 0; b < 2; ++b)
#pragma unroll
                for (int m = 0; m < 4; ++m)
#pragma unroll
                    for (int n = 0; n < 2; ++n) acc[a][b][m][n] = (f32x4){0.f, 0.f, 0.f, 0.f};
        cur = nxt; cA = nA; cB = nB; ++ui;
        if constexpr (ALIGN_EPI) { if (wr == 1) PG8_BAR; }
    }
    PG8_WAIT_V(0);
    if constexpr (!ALIGN_EPI) { if (wr == 0) PG8_BAR; }
    PG8_BAR;
    if constexpr (Epi::AFTER_DRAIN) { E.fused(acc, cur, wr, wc, fr, fq, lds, wid, lane); S.done(cur); }
#undef PG8_SA
#undef PG8_SB
#undef PG8_STAGE
#undef PG8_LDA
#undef PG8_LDB
#undef PG8_MMA
#undef PG8_WAIT_V
#undef PG8_WAIT_L
#undef PG8_BAR
#undef PG8_SCHED
}
}

#define GAS __attribute__((address_space(1)))
#define LAS __attribute__((address_space(3)))
typedef unsigned v4u __attribute__((ext_vector_type(4)));
typedef float f32x4 __attribute__((ext_vector_type(4)));
typedef short bf16x8 __attribute__((ext_vector_type(8)));
typedef GAS unsigned gu32;
typedef GAS unsigned long long gu64;
#define RLX_AGENT __ATOMIC_RELAXED, __HIP_MEMORY_SCOPE_AGENT
#define LDS_WAIT() asm volatile("s_waitcnt lgkmcnt(0)" ::: "memory")
#define VM_WAIT() asm volatile("s_waitcnt vmcnt(0)" ::: "memory")
__device__ __forceinline__ unsigned long long rt() { return __builtin_amdgcn_s_memrealtime(); }
__device__ __forceinline__ unsigned pk2(float lo, float hi) { return f2bf(lo) | (f2bf(hi) << 16); }

#define XB_TMO      128
#define XB_XCNT(j)  (256  + 64 * (j))
#define XB_XSUB(j)  (1280 + 64 * (j))
#define XB_XGEN(j)  (2304 + 64 * (j))
#define XB_TOP      3328
#define XB_TOPGEN   3392
#define XCD_BAR_WORDS 3456
#define XB_SPIN_CAP (1u << 18)

__device__ __forceinline__ unsigned xb_ld(unsigned* p)              { return __hip_atomic_load(p, __ATOMIC_RELAXED, __HIP_MEMORY_SCOPE_AGENT); }
__device__ __forceinline__ unsigned xb_add(unsigned* p, unsigned v) { return __hip_atomic_fetch_add(p, v, __ATOMIC_RELAXED, __HIP_MEMORY_SCOPE_AGENT); }
__device__ __forceinline__ unsigned xb_xcc_id() { return (unsigned)__builtin_amdgcn_s_getreg((3 << 11) | 20) & 0xFu; }
#define XB_SPIN(cond, bar) do { unsigned _sp = 0; while (cond) { __builtin_amdgcn_s_sleep(1); \
    if ((++_sp & 255u) == 0u) { if (xb_ld(&(bar)[XB_TMO])) break; if (_sp > XB_SPIN_CAP) { atomicAdd(&(bar)[XB_TMO], 1u); break; } } } } while (0)

struct XcdBarrier {
    unsigned* bar; unsigned x;
    volatile LAS unsigned* st;
};

__device__ __forceinline__ XcdBarrier xcd_barrier_post(unsigned* bar, volatile LAS unsigned* st) {
    XcdBarrier b; b.bar = bar; b.x = xb_xcc_id(); b.st = st;
    if (threadIdx.x == 0) (void)xb_add(&bar[XB_XCNT(b.x)], 1u);
    return b;
}
__device__ __forceinline__ void xcd_barrier_complete(unsigned* bar, unsigned x, unsigned& nloc, unsigned& nx) {
    const unsigned G = gridDim.x * gridDim.y * gridDim.z;
    unsigned sum, cnt, mine, sp = 0u;
    for (;;) {
        sum = 0u; cnt = 0u; mine = 0u;
#pragma unroll
        for (unsigned j = 0; j < 16; ++j) { const unsigned c = xb_ld(&bar[XB_XCNT(j)]); sum += c; cnt += (c > 0u) ? 1u : 0u; mine = (j == x) ? c : mine; }
        if (sum == G) break;
        __builtin_amdgcn_s_sleep(1);
        if ((++sp & 255u) == 0u) { if (xb_ld(&bar[XB_TMO])) break; if (sp > XB_SPIN_CAP) { atomicAdd(&bar[XB_TMO], 1u); break; } }
    }
    nloc = mine > 0u ? mine : 1u; nx = cnt > 0u ? cnt : 1u;
}

__device__ __forceinline__ void xcd_barrier(const XcdBarrier& b) {
    asm volatile("s_waitcnt vmcnt(0)" ::: "memory");
    __syncthreads();
    if (threadIdx.x == 0) {
        unsigned* bar = b.bar;
        __builtin_amdgcn_s_waitcnt(0);
        unsigned nloc = b.st[0], nx = b.st[1];
        if (nloc == 0u) { xcd_barrier_complete(bar, b.x, nloc, nx); b.st[0] = nloc; b.st[1] = nx; }
        const unsigned old = xb_add(&bar[XB_XSUB(b.x)], 1u);
        const unsigned gen = old / nloc;
        if (old + 1u == (gen + 1u) * nloc) {
            __builtin_amdgcn_fence(__ATOMIC_RELEASE, "agent");
            asm volatile("s_waitcnt vmcnt(0)" ::: "memory");
            const unsigned og = xb_add(&bar[XB_TOP], 1u);
            const unsigned tg = og / nx;
            if (og + 1u == (tg + 1u) * nx) xb_add(&bar[XB_TOPGEN], 1u);
            else XB_SPIN(xb_ld(&bar[XB_TOPGEN]) == tg, bar);
            __builtin_amdgcn_fence(__ATOMIC_ACQUIRE, "agent");
            xb_add(&bar[XB_XGEN(b.x)], 1u);
            asm volatile("s_waitcnt vmcnt(0)" ::: "memory");
        } else {
            XB_SPIN(xb_ld(&bar[XB_XGEN(b.x)]) == gen, bar);
            __builtin_amdgcn_fence(__ATOMIC_ACQUIRE, "agent");
            asm volatile("s_waitcnt vmcnt(0)" ::: "memory");
        }
    }
    __syncthreads();
}

namespace att {
typedef short bf16x8 __attribute__((ext_vector_type(8)));
typedef short s16x4 __attribute__((ext_vector_type(4)));
typedef float f32x4 __attribute__((ext_vector_type(4)));
typedef unsigned u32x2 __attribute__((ext_vector_type(2)));
typedef LAS const char* lptr;
constexpr float NEG = -INFINITY;
__device__ __forceinline__ int fK(int t) { return (t >> 1) & 7; }
__device__ __forceinline__ int fV(int t) { return (((t >> 1) & 3) << 1) | ((t >> 3) & 1); }
__device__ __forceinline__ s16x4 vtr(lptr p) { typedef short v4i16_t __attribute__((ext_vector_type(4))); return __builtin_bit_cast(s16x4, __builtin_amdgcn_ds_read_tr16_b64_v4i16((LAS v4i16_t*)p)); }
__device__ __forceinline__ unsigned cvtpk(float lo, float hi) { unsigned r; asm volatile("v_cvt_pk_bf16_f32 %0, %1, %2" : "=v"(r) : "v"(lo), "v"(hi)); return r; }
__device__ __forceinline__ float xor16(float v) { return __builtin_bit_cast(float, __builtin_amdgcn_ds_swizzle(__builtin_bit_cast(int, v), 0x401F)); }
__device__ __forceinline__ float max4(float v) { v = __builtin_fmaxf(v, xor16(v)); return __builtin_fmaxf(v, __shfl_xor(v, 32)); }
__device__ __forceinline__ float sum4(float v) { v += xor16(v); return v + __shfl_xor(v, 32); }

struct Item { bf16x8 q0, q1; f32x4 o0, o1, o2, o3; float m, l; int ka, va; };
__device__ __forceinline__ void item_init(Item& it, float m0, float l0) { it.o0 = it.o1 = it.o2 = it.o3 = (f32x4){0.f, 0.f, 0.f, 0.f}; it.m = m0; it.l = l0; }
__device__ __forceinline__ void item_addr(Item& it, int w0, int lane) {
    const int fr = lane & 15, fq = lane >> 4, rk = w0 + fr, rv = w0 + 4 * fq + (fr >> 2);
    it.ka = rk * 128 + ((fq ^ fK(rk)) << 4);
    it.va = 8192 + rv * 128 + (((((fr & 3) >> 1)) ^ fV(rv)) << 4) + 8 * (fr & 1);
}
__device__ __forceinline__ void half_step(Item& it, lptr slot, f32x4 b0, f32x4 b1) {
    lptr kp = slot + it.ka;
    const bf16x8 k00 = *(const LAS bf16x8*)(kp), k01 = *(const LAS bf16x8*)(kp + 2048);
    lptr kp1 = slot + (it.ka ^ 64);
    const bf16x8 k10 = *(const LAS bf16x8*)(kp1), k11 = *(const LAS bf16x8*)(kp1 + 2048);
    f32x4 s0 = __builtin_amdgcn_mfma_f32_16x16x32_bf16(k00, it.q0, b0, 0, 0, 0);
    f32x4 s1 = __builtin_amdgcn_mfma_f32_16x16x32_bf16(k01, it.q0, b1, 0, 0, 0);
    s0 = __builtin_amdgcn_mfma_f32_16x16x32_bf16(k10, it.q1, s0, 0, 0, 0);
    s1 = __builtin_amdgcn_mfma_f32_16x16x32_bf16(k11, it.q1, s1, 0, 0, 0);
    float mx = __builtin_fmaxf(__builtin_fmaxf(__builtin_fmaxf(s0[0], s0[1]), __builtin_fmaxf(s0[2], s0[3])), __builtin_fmaxf(__builtin_fmaxf(s1[0], s1[1]), __builtin_fmaxf(s1[2], s1[3])));
    mx = max4(mx);
    const float mn = __builtin_fmaxf(it.m, mx), al = __builtin_amdgcn_exp2f(it.m - mn);
    it.m = mn;
#pragma unroll
    for (int e = 0; e < 4; ++e) { s0[e] = __builtin_amdgcn_exp2f(s0[e] - mn); s1[e] = __builtin_amdgcn_exp2f(s1[e] - mn); }
    it.l = it.l * al + (((s0[0] + s0[1]) + (s0[2] + s0[3])) + ((s1[0] + s1[1]) + (s1[2] + s1[3])));
    it.o0 *= al; it.o1 *= al; it.o2 *= al; it.o3 *= al;
    typedef unsigned u32x4 __attribute__((ext_vector_type(4)));
    u32x4 pw; pw.x = cvtpk(s0[0], s0[1]); pw.y = cvtpk(s0[2], s0[3]); pw.z = cvtpk(s1[0], s1[1]); pw.w = cvtpk(s1[2], s1[3]);
    const bf16x8 pf = __builtin_bit_cast(bf16x8, pw);
#define ATT_PV(dt, O) do { lptr vp = slot + (it.va ^ ((dt) << 5)); const s16x4 lo = vtr(vp), hi = vtr(vp + 2048); \
        const bf16x8 vf = (bf16x8){lo[0], lo[1], lo[2], lo[3], hi[0], hi[1], hi[2], hi[3]}; O = __builtin_amdgcn_mfma_f32_16x16x32_bf16(vf, pf, O, 0, 0, 0); } while (0)
    ATT_PV(0, it.o0); ATT_PV(1, it.o1); ATT_PV(2, it.o2); ATT_PV(3, it.o3);
#undef ATT_PV
}
__device__ __forceinline__ void item_store(Item& it, bf16* orow, int lane) {
    const float rl = 1.0f / sum4(it.l); const int fq = lane >> 4;
    u32x2 w;
    w.x = cvtpk(it.o0[0] * rl, it.o0[1] * rl); w.y = cvtpk(it.o0[2] * rl, it.o0[3] * rl); *(u32x2*)(orow + 0 + 4 * fq) = w;
    w.x = cvtpk(it.o1[0] * rl, it.o1[1] * rl); w.y = cvtpk(it.o1[2] * rl, it.o1[3] * rl); *(u32x2*)(orow + 16 + 4 * fq) = w;
    w.x = cvtpk(it.o2[0] * rl, it.o2[1] * rl); w.y = cvtpk(it.o2[2] * rl, it.o2[3] * rl); *(u32x2*)(orow + 32 + 4 * fq) = w;
    w.x = cvtpk(it.o3[0] * rl, it.o3[1] * rl); w.y = cvtpk(it.o3[2] * rl, it.o3[3] * rl); *(u32x2*)(orow + 48 + 4 * fq) = w;
}
__device__ __forceinline__ void glds16(const void* gsrc, unsigned lds_dst) { unsigned keep;
    asm volatile("s_mov_b32 %0, m0\n\ts_mov_b32 m0, %2\n\ts_nop 0\n\tglobal_load_lds_dwordx4 %1, off\n\ts_mov_b32 m0, %0" : "=&s"(keep) : "v"(gsrc), "s"(lds_dst) : "memory"); }
__device__ __forceinline__ unsigned lds_u32(LAS unsigned char* p) { return (unsigned)__builtin_amdgcn_readfirstlane((int)(unsigned)(uintptr_t)p); }
#define ATT_WAITV(n) asm volatile("s_waitcnt vmcnt(" #n ")" ::: "memory")
#define ATT_BAR() do { asm volatile("s_waitcnt lgkmcnt(0)" ::: "memory"); __builtin_amdgcn_s_barrier(); asm volatile("" ::: "memory"); } while (0)
__device__ __forceinline__ void wait_vm(int n) {
    if (n >= 31) ATT_WAITV(31); else if (n >= 28) ATT_WAITV(28); else if (n >= 25) ATT_WAITV(25); else if (n >= 22) ATT_WAITV(22); else if (n >= 19) ATT_WAITV(19); else if (n >= 16) ATT_WAITV(16);
    else if (n >= 10) ATT_WAITV(10); else if (n >= 9) ATT_WAITV(9); else if (n >= 8) ATT_WAITV(8); else if (n >= 6) ATT_WAITV(6); else if (n >= 4) ATT_WAITV(4); else if (n >= 3) ATT_WAITV(3); else if (n >= 2) ATT_WAITV(2); else ATT_WAITV(0);
}

constexpr int NA_SLOT = 24576, NA_NS = 5, NA_PD = 3, NA_TBL = NA_NS * NA_SLOT;
struct NaCtx { LAS unsigned char* L; const bf16 *Q, *Kh, *Vh; bf16* O; const float* rpb; int tid, lane, wid, fr, fq, tok, cp; };
__device__ __forceinline__ void na_item_cols(int ct, int fr, int fq, int lane, Item& it, int& tbi, f32x4 (&mk)[2]) {
    const int w0 = ct == 0 ? 0 : ct == 1 ? 8 : ct == 2 ? 24 : 32, c = ct * 16 + fr; int cs = c - KC / 2; cs = cs < 0 ? 0 : (cs > GW - KC ? GW - KC : cs);
    item_addr(it, w0, lane); tbi = 16 + w0 + 4 * fq - c + 15;
    const int dl = w0 + 4 * fq - cs;
#pragma unroll
    for (int kt = 0; kt < 2; ++kt)
#pragma unroll
        for (int e = 0; e < 4; ++e) { const int x = dl + 16 * kt + e; mk[kt][e] = (x >= 0 && x <= 15) ? 0.f : NEG; }
}
__device__ __forceinline__ void na_table(const NaCtx& c, int h) {
    LAS float* tb = (LAS float*)(c.L + NA_TBL);
    for (int i = c.tid; i < 15 * 64; i += 512) { const int dr = i >> 6, ix = i & 63, dc = ix - 16; const float v = (dc >= 0 && dc < 31) ? c.rpb[(h * 15 + dr) * 31 + dc] * LOG2E : 0.f;
        tb[i] = v; tb[15 * 64 + i] = (ix >= 23 && ix <= 38) ? v : NEG; }
}
__device__ __forceinline__ void na_edge(const NaCtx& c, int b, int h, int r0, int klo) {
    LAS unsigned char* L = c.L; LAS float* tb = (LAS float*)(L + NA_TBL); const int wid = c.wid; int lane = c.lane; asm volatile("" : "+v"(lane));
    const int fr = lane & 15, fq = lane >> 4;
    const size_t plane = ((size_t)(b * NH + h) * SEQ) * HD;
    const bf16* ksrc = c.Kh + plane + (size_t)klo * GW * HD + c.tok * HD + ((c.cp ^ fK(c.tok)) << 3); const bf16* vsrc = c.Vh + plane + (size_t)klo * GW * HD + c.tok * HD + ((c.cp ^ fV(c.tok)) << 3);
    ATT_BAR();
    for (int t = 0; t < NA_PD; ++t) { const unsigned d = lds_u32(L + t * NA_SLOT + wid * 1024); glds16(ksrc + (size_t)t * GW * HD, d); glds16(vsrc + (size_t)t * GW * HD, d + 8192u); }
    na_table(c, h);
    const int r = r0 + (wid >> 1);
    Item it[2]; int tbi[2]; f32x4 mk[2][2];
#pragma unroll
    for (int i = 0; i < 2; ++i) { const int ct = 2 * (wid & 1) + i;
        const bf16* qp = c.Q + ((size_t)b * SEQ + (size_t)r * GW + ct * 16 + fr) * D + h * HD + 8 * fq;
        it[i].q0 = *(const bf16x8*)qp; it[i].q1 = *(const bf16x8*)(qp + 32);
        item_init(it[i], -1e30f, 0.f); na_item_cols(ct, fr, fq, lane, it[i], tbi[i], mk[i]); }
    __builtin_amdgcn_s_waitcnt(0x0F70);
    for (int t = 0; t < KR; ++t) {
        if (t + NA_PD < KR) { const unsigned d = lds_u32(L + ((t + NA_PD) % NA_NS) * NA_SLOT + wid * 1024); glds16(ksrc + (size_t)(t + NA_PD) * GW * HD, d); glds16(vsrc + (size_t)(t + NA_PD) * GW * HD, d + 8192u); }
        wait_vm(2 * (KR - 1 - t < NA_PD ? KR - 1 - t : NA_PD));
        ATT_BAR();
        lptr slot = (lptr)(L + (t % NA_NS) * NA_SLOT); const int dr = klo + t - r + KR - 1;
#pragma unroll
        for (int i = 0; i < 2; ++i) { const LAS float* bp = tb + dr * 64 + tbi[i]; f32x4 b0, b1;
#pragma unroll
            for (int e = 0; e < 4; ++e) { b0[e] = bp[e] + mk[i][0][e]; b1[e] = bp[16 + e] + mk[i][1][e]; }
            half_step(it[i], slot, b0, b1); }
    }
#pragma unroll
    for (int i = 0; i < 2; ++i) { const int cc = (2 * (wid & 1) + i) * 16 + fr; item_store(it[i], c.O + ((size_t)b * SEQ + (size_t)r * GW + cc) * D + h * HD, lane); }
    __builtin_amdgcn_s_waitcnt(0x0F70);
}
__device__ __forceinline__ void na_strip(const NaCtx& c, int b, int h, int ra, int rb) {
    LAS unsigned char* L = c.L; LAS float* tb = (LAS float*)(L + NA_TBL); const int wid = c.wid; int lane = c.lane; asm volatile("" : "+v"(lane));
    const int fr = lane & 15, fq = lane >> 4;
    const int klo = ra - 4, nt = rb - ra + 7;
    const size_t plane = ((size_t)(b * NH + h) * SEQ) * HD;
    const bf16* ksrc = c.Kh + plane + (size_t)klo * GW * HD + c.tok * HD + ((c.cp ^ fK(c.tok)) << 3); const bf16* vsrc = c.Vh + plane + (size_t)klo * GW * HD + c.tok * HD + ((c.cp ^ fV(c.tok)) << 3);
    const bf16* qsrc = c.Q + ((size_t)b * SEQ + c.tok) * D + h * HD + ((c.cp ^ fK(c.tok)) << 3);
#define NA_DMA(step) do { const int s_ = (step); const unsigned d = lds_u32(L + (s_ % NA_NS) * NA_SLOT + wid * 1024); int rq = ra + s_; rq = rq < rb ? rq : rb - 1; \
        glds16(ksrc + (size_t)s_ * GW * HD, d); glds16(vsrc + (size_t)s_ * GW * HD, d + 8192u); glds16(qsrc + (size_t)rq * GW * D, d + 16384u); } while (0)
    ATT_BAR();
    for (int t = 0; t < NA_PD; ++t) NA_DMA(t);
    na_table(c, h);
    Item it[4]; int tbi[4]; f32x4 mk[2][2];
#pragma unroll
    for (int i = 0; i < 4; ++i) { f32x4 dummy[2]; na_item_cols(i, fr, fq, lane, it[i], tbi[i], (i == 0 || i == 3) ? mk[i == 3] : dummy); item_init(it[i], -1e30f, 0.f); it[i].q0 = it[i].q1 = (bf16x8){0, 0, 0, 0, 0, 0, 0, 0}; }
    __builtin_amdgcn_s_waitcnt(0x0F70);
    for (int t = 0; t < nt; ++t) {
        if (t + NA_PD < nt) NA_DMA(t + NA_PD);
        const int j = t - wid, ph = j & 7, r = ra + t - ph;
        wait_vm(3 * (nt - 1 - t < NA_PD ? nt - 1 - t : NA_PD));
        ATT_BAR();
        if (j >= 0 && r < rb) {
            lptr slot = (lptr)(L + (t % NA_NS) * NA_SLOT);
            if (ph == 0) {
#pragma unroll
                for (int i = 0; i < 4; ++i) { const int rk = i * 16 + fr; lptr qp = slot + 16384 + rk * 128; const int sw = fq ^ fK(rk);
                    it[i].q0 = *(const LAS bf16x8*)(qp + (sw << 4)); it[i].q1 = *(const LAS bf16x8*)(qp + ((sw ^ 4) << 4)); item_init(it[i], -1e30f, 0.f); }
            }
            const LAS float* tbr = tb + (ph + 3) * 64;
#pragma unroll
            for (int i = 0; i < 4; ++i) { const LAS float* bp = tbr + tbi[i] + ((i == 1 || i == 2) ? 15 * 64 : 0); f32x4 b0, b1;
#pragma unroll
                for (int e = 0; e < 4; ++e) { b0[e] = bp[e]; b1[e] = bp[16 + e]; if (i == 0 || i == 3) { b0[e] += mk[i == 3][0][e]; b1[e] += mk[i == 3][1][e]; } }
                half_step(it[i], slot, b0, b1);
                if (i == 1) __builtin_amdgcn_sched_barrier(0); }
            if (ph == 7) {
#pragma unroll
                for (int i = 0; i < 4; ++i) item_store(it[i], c.O + ((size_t)b * SEQ + (size_t)r * GW + i * 16 + fr) * D + h * HD, lane);
            }
        }
    }
#undef NA_DMA
    __builtin_amdgcn_s_waitcnt(0x0F70);
}
__device__ __forceinline__ void na_phase(LAS unsigned char* L, const bf16* Q, const bf16* Kh, const bf16* Vh, bf16* O, const float* rpb, int vcu, int G) {
    NaCtx c; c.L = L; c.Q = Q; c.Kh = Kh; c.Vh = Vh; c.O = O; c.rpb = rpb; c.tid = threadIdx.x; c.lane = c.tid & 63; c.wid = __builtin_amdgcn_readfirstlane(c.tid >> 6); c.fr = c.lane & 15; c.fq = c.lane >> 4;
    c.tok = c.wid * 8 + (c.lane >> 3); c.cp = c.lane & 7;
    for (int task = vcu; task < BATCH * NH * 4; task += G) {
        const int qd = task & 3, h = (task >> 2) % NH, b = task / (4 * NH);
        if (qd == 0) na_edge(c, b, h, 0, 0);
        na_strip(c, b, h, qd == 0 ? 4 : 32 * qd, qd == 3 ? ROWS - 4 : 32 * qd + 32);
        if (qd == 3) na_edge(c, b, h, ROWS - 4, ROWS - KR);
    }
}

constexpr int SW_SLOT = 16384, SW_NS = 7, SW_TBL = SW_NS * SW_SLOT;
__device__ __forceinline__ void swa_phase(LAS unsigned char* L, const bf16* Q, const bf16* Kh, const bf16* Vh, bf16* O, const float* tblg, int vcu, int G) {
    const int tid = threadIdx.x, lane = tid & 63, wid = __builtin_amdgcn_readfirstlane(tid >> 6), fr = lane & 15, fq = lane >> 4;
    LAS float* tb = (LAS float*)(L + SW_TBL);
    const int tok = wid * 8 + (lane >> 3), cp = lane & 7;
    constexpr int NQB = SEQ / 64, QPT = 8, NTASK = BATCH * KVH * (NQB / QPT);
    for (int task = vcu; task < NTASK; task += G) {
        const int q0 = (task % (NQB / QPT)) * QPT, kv = (task / (NQB / QPT)) % KVH, b = task / (NQB / QPT * KVH);
        const size_t plane = ((size_t)(b * KVH + kv) * SEQ) * HD;
        const bf16* ksrc = Kh + plane + tok * HD + ((cp ^ fK(tok)) << 3); const bf16* vsrc = Vh + plane + tok * HD + ((cp ^ fV(tok)) << 3);
        const int cmax = q0 + QPT + 1 > NQB - 1 ? NQB - 1 : q0 + QPT + 1;
#define SW_DMA(ch) do { const int c_ = (ch); if (c_ >= 0 && c_ <= cmax) { const unsigned d = lds_u32(L + (c_ % SW_NS) * SW_SLOT + wid * 1024); glds16(ksrc + (size_t)c_ * 64 * HD, d); glds16(vsrc + (size_t)c_ * 64 * HD, d + 8192u); } } while (0)
        ATT_BAR();
        for (int ch = q0 - 2; ch <= q0 + 3; ++ch) SW_DMA(ch);
        for (int i = tid; i < 4 * 384; i += 512) { const int g = i / 384, rel = i % 384 - 192; tb[i] = (rel >= -WINDOW && rel <= WINDOW) ? tblg[(kv * 4 + g) * 257 + rel + WINDOW] : NEG; }
        const int g = wid >> 1, hq = kv * 4 + g; const float sink2 = tblg[16 * 257 + hq];
        Item it[2]; int tbi[2]; bf16x8 qn[2][2];
        const bf16* qbase = Q + ((size_t)b * SEQ + fr) * D + hq * HD + 8 * fq;
#pragma unroll
        for (int i = 0; i < 2; ++i) { const int qt = 2 * (wid & 1) + i; const bf16* qp = qbase + (size_t)(64 * q0 + 16 * qt) * D;
            qn[i][0] = *(const bf16x8*)qp; qn[i][1] = *(const bf16x8*)(qp + 32);
            item_addr(it[i], 0, lane); tbi[i] = g * 384 + 192 + 4 * fq - 16 * qt - fr; }
        __builtin_amdgcn_s_waitcnt(0x0F70);
        for (int qb = q0; qb < q0 + QPT; ++qb) {
            ATT_BAR();
            if (qb > q0) SW_DMA(qb + 3);
#pragma unroll
            for (int i = 0; i < 2; ++i) { it[i].q0 = qn[i][0]; it[i].q1 = qn[i][1]; item_init(it[i], sink2, fq == 0 ? 1.f : 0.f); }
            if (qb + 1 < q0 + QPT) {
#pragma unroll
                for (int i = 0; i < 2; ++i) { const int qt = 2 * (wid & 1) + i; const bf16* qp = qbase + (size_t)(64 * (qb + 1) + 16 * qt) * D; qn[i][0] = *(const bf16x8*)qp; qn[i][1] = *(const bf16x8*)(qp + 32); }
            }
            const int clo = qb - 2 < 0 ? 0 : qb - 2, chi_ = qb + 2 > NQB - 1 ? NQB - 1 : qb + 2;
#ifdef PROBE_SW
            unsigned long long pt0 = 0, pc0 = 0; if (qb == q0 + 3) { pt0 = __builtin_amdgcn_s_memrealtime(); pc0 = __builtin_amdgcn_s_memtime(); }
#endif
            for (int cb = clo; cb <= chi_; ++cb) {
                lptr slot = (lptr)(L + (cb % SW_NS) * SW_SLOT);
#pragma unroll
                for (int hs = 0; hs < 2; ++hs)
#pragma unroll
                    for (int i = 0; i < 2; ++i) { const int qt = 2 * (wid & 1) + i, k0 = 64 * cb + 32 * hs, tq0 = 64 * qb + 16 * qt;
                        if (k0 + 31 >= tq0 - WINDOW && k0 <= tq0 + 15 + WINDOW) {
                            const LAS float* bp = tb + tbi[i] + 64 * (cb - qb) + 32 * hs; f32x4 b0, b1;
#pragma unroll
                            for (int e = 0; e < 4; ++e) { b0[e] = bp[e]; b1[e] = bp[16 + e]; }
                            half_step(it[i], slot + hs * 4096, b0, b1); } }
            }
#ifdef PROBE_SW
            if (qb == q0 + 3) { asm volatile("" :: "v"(it[0].o0), "v"(it[1].o0)); const unsigned long long pt1 = __builtin_amdgcn_s_memrealtime(), pc1 = __builtin_amdgcn_s_memtime();
                if (blockIdx.x == 0 && tid == 0 && task == vcu) { volatile LAS unsigned* MI = (volatile LAS unsigned*)(L + 131072 + 320); MI[40] = (unsigned)(pt1 - pt0); MI[41] = (unsigned)(pc1 - pc0); } }
#endif
#pragma unroll
            for (int i = 0; i < 2; ++i) { const int qt = 2 * (wid & 1) + i; item_store(it[i], O + ((size_t)b * SEQ + (size_t)qb * 64 + qt * 16 + fr) * D + hq * HD, lane); }
            __builtin_amdgcn_s_waitcnt(0x0F70);
        }
#undef SW_DMA
    }
}
#undef ATT_WAITV
#undef ATT_BAR
}

#ifndef PG8_SP2
#define PG8_SP2 true
#endif
#ifndef PG8_ALIGN
#define PG8_ALIGN true
#endif
#ifndef MK_N_LAUNCHES
#define MK_N_LAUNCHES 1
#endif
constexpr int NWAVES = 8;
constexpr int RING_OFF = 0, RING_BYTES = 131072, LDSCTL_OFF = RING_BYTES, MISC_OFF = LDSCTL_OFF + 320, LDS_BYTES = 147456;
constexpr int CW_BAR = 4096;
constexpr int NPHASE = 12;

__device__ __forceinline__ void p0_transpose_item(const float* W, const float* g, int K, int N, bf16* WT, LAS float* scr, int item, int lane) {
    const int nblk = N / 32, kb = item / nblk, nb = item % nblk, k0 = 64 * kb, n0 = 32 * nb;
    float wv[32];
#pragma unroll
    for (int i = 0; i < 32; ++i) { const int kk = 2 * i + (lane >> 5); wv[i] = W[(size_t)(k0 + kk) * N + n0 + (lane & 31)]; }
#pragma unroll
    for (int i = 0; i < 32; ++i) { const int kk = 2 * i + (lane >> 5); scr[kk * 33 + (lane & 31)] = wv[i] * (g ? g[k0 + kk] : 1.0f); }
    LDS_WAIT(); asm volatile("" ::: "memory");
    const int c = lane & 7;
#pragma unroll
    for (int j = 0; j < 4; ++j) { const int n = (lane >> 3) + 8 * j; const LAS float* s = scr + (8 * c) * 33 + n;
        v4u o; o.x = pk2(s[0 * 33], s[1 * 33]); o.y = pk2(s[2 * 33], s[3 * 33]); o.z = pk2(s[4 * 33], s[5 * 33]); o.w = pk2(s[6 * 33], s[7 * 33]);
        *(GAS v4u*)(WT + (size_t)(n0 + n) * K + k0 + 8 * c) = o; }
    LDS_WAIT(); asm volatile("" ::: "memory");
}

struct Args { const float* in[13]; float* out; unsigned char* ws; int ph_lo, ph_hi; };
__global__ void __launch_bounds__(NWAVES * 64, 2) mk_fwd(Args args) {
    extern __shared__ __attribute__((aligned(16))) unsigned char lds[];
    LAS unsigned char* L = (LAS unsigned char*)lds;
    volatile LAS unsigned* MISC = (volatile LAS unsigned*)(L + MISC_OFF);
    const int tid = threadIdx.x, lane = tid & 63, wave = __builtin_amdgcn_readfirstlane(tid >> 6);
    unsigned char* ws = args.ws;
    gu32* ctl = (gu32*)(ws + WS_CTL);
    float* ssqA = (float*)(ws + WS_SSQ); float* ssqB = (float*)(ws + WS_SSQ2); float* tblg = (float*)(ws + WS_TBL);
    bf16 *Wqkv0 = (bf16*)(ws + WS_WQKV0), *Wo0 = (bf16*)(ws + WS_WO0), *Win0 = (bf16*)(ws + WS_WIN0), *Wout0 = (bf16*)(ws + WS_WOUT0);
    bf16 *Wqkv1 = (bf16*)(ws + WS_WQKV1), *Wo1 = (bf16*)(ws + WS_WO1), *Win1 = (bf16*)(ws + WS_WIN1), *Wout1 = (bf16*)(ws + WS_WOUT1);
    bf16 *XB = (bf16*)(ws + WS_XB), *Qb = (bf16*)(ws + WS_Q), *Kb = (bf16*)(ws + WS_K), *Vb = (bf16*)(ws + WS_V), *Hb = (bf16*)(ws + WS_H);
    const float* x = args.in[0]; float* out = args.out;
    const int G = gridDim.x; int vcu; { const int bx = blockIdx.x; vcu = (G % 8 == 0) ? (bx % 8) * (G / 8) + bx / 8 : bx; }
    for (int u = tid; u < (LDS_BYTES - LDSCTL_OFF) / 4; u += NWAVES * 64) ((LAS unsigned*)(L + LDSCTL_OFF))[u] = 0u;
    __syncthreads();
    XcdBarrier bar; bar.bar = (unsigned*)(ctl + CW_BAR); bar.x = 0; bar.st = nullptr;
    if (MK_N_LAUNCHES == 1) bar = xcd_barrier_post((unsigned*)(ctl + CW_BAR), MISC + 8);
    const int lo = args.ph_lo, hi = args.ph_hi;
#define IN(k) (lo <= (k) && (k) < hi)
#ifndef PROBE_SCALE
#define PROBE_SCALE 0.01f
#endif
#ifdef PROBE_A
#define STAMP(k) do { if (blockIdx.x == 0 && tid == 0) MISC[16 + (k)] = (unsigned)__builtin_amdgcn_s_memrealtime(); } while (0)
#else
#define STAMP(k) do {} while (0)
#endif
#define SEAM(k) do { if (IN(k) && IN((k) + 1)) xcd_barrier(bar); STAMP((k) + 1); } while (0)
    STAMP(0);

    if (IN(0)) {
        LAS float* scr = (LAS float*)(L + RING_OFF + wave * 16384);
        const int gw = vcu * NWAVES + wave, NGW = G * NWAVES;
        const float *mix_norm = args.in[1], *mlp_norm = args.in[2], *w_in = args.in[11], *w_out = args.in[12];
        constexpr int I_QKV0 = (D / 64) * (3072 / 32), I_O = (D / 64) * (D / 32), I_IN = (D / 64) * (FF / 32), I_OUT = (FF / 64) * (D / 32), I_QKV1 = (D / 64) * (1536 / 32);
        constexpr int NITEMS = I_QKV0 + I_QKV1 + 2 * (I_O + I_IN + I_OUT);
        for (int it = gw; it < NITEMS; it += NGW) {
            int r = it;
            if (r < I_QKV0) { p0_transpose_item(args.in[4], mix_norm, D, 3072, Wqkv0, scr, r, lane); continue; } r -= I_QKV0;
            if (r < I_O) { p0_transpose_item(args.in[6], nullptr, D, D, Wo0, scr, r, lane); continue; } r -= I_O;
            if (r < I_IN) { p0_transpose_item(w_in, mlp_norm, D, FF, Win0, scr, r, lane); continue; } r -= I_IN;
            if (r < I_OUT) { p0_transpose_item(w_out, nullptr, FF, D, Wout0, scr, r, lane); continue; } r -= I_OUT;
            if (r < I_QKV1) { p0_transpose_item(args.in[7], mix_norm + D, D, 1536, Wqkv1, scr, r, lane); continue; } r -= I_QKV1;
            if (r < I_O) { p0_transpose_item(args.in[9], nullptr, D, D, Wo1, scr, r, lane); continue; } r -= I_O;
            if (r < I_IN) { p0_transpose_item(w_in + (size_t)D * FF, mlp_norm + D, D, FF, Win1, scr, r, lane); continue; } r -= I_IN;
            p0_transpose_item(w_out + (size_t)D * FF, nullptr, FF, D, Wout1, scr, r, lane);
        }
        for (int i = vcu * (NWAVES * 64) + tid; i < 16 * 257 + 16; i += G * NWAVES * 64) {
            if (i < 16 * 257) { const int h = i / 257, rel = i % 257 - 128; const int n = rel < 0 ? -rel : rel; int bk;
                if (n < 8) bk = n; else { const int k = (31 - __clz(n * n)) - 6; bk = 8 + (k < 7 ? k : 7); }
                if (rel > 0) bk += 16;
                tblg[i] = args.in[10][bk * 16 + h] * LOG2E; }
            else tblg[i] = args.in[8][i - 16 * 257] * LOG2E;
        }
        for (int m0 = gw * 4; m0 < M; m0 += NGW * 4) {
            f32x4 v[4][4];
#pragma unroll
            for (int r = 0; r < 4; ++r) { const GAS f32x4* xr = (const GAS f32x4*)(x + (size_t)(m0 + r) * D) + lane;
#pragma unroll
                for (int j = 0; j < 4; ++j) v[r][j] = xr[64 * j]; }
#pragma unroll
            for (int r = 0; r < 4; ++r) { GAS unsigned long long* o8 = (GAS unsigned long long*)(XB + (size_t)(m0 + r) * D) + lane; float s = 0.f;
#pragma unroll
                for (int j = 0; j < 4; ++j) { const f32x4 w = v[r][j]; s += (w.x * w.x + w.y * w.y) + (w.z * w.z + w.w * w.w);
                    o8[64 * j] = (unsigned long long)pk2(w.x, w.y) | ((unsigned long long)pk2(w.z, w.w) << 32); }
                s = wave_sum(s);
                if (lane < 16) ssqB[(size_t)(m0 + r) * 16 + lane] = lane == 0 ? s : 0.f; }
        }
    }
    SEAM(0);
    if (IN(1)) { pg8::Gemm g{XB, Wqkv0, M, 3072, D}; pg8::StaticOrder S; S.init(M, 3072, G, (int)blockIdx.x);
        pg8::EpiQKV E{Qb, Kb, Vb, D, C2, ssqB};
        pg8::gemm_phase<pg8::EpiQKV, pg8::StaticOrder, PG8_ALIGN, PG8_SP2>(L + RING_OFF, g, S, E); }
    SEAM(1);
#ifdef PROBE_NA
    if (IN(2)) { att::na_phase(L + RING_OFF, Qb, Kb, Vb, (bf16*)(ws + 448 * MiB), args.in[5], vcu, G); xcd_barrier(bar); STAMP(13);
                 att::na_phase(L + RING_OFF, Qb, Kb, Vb, (bf16*)(ws + 448 * MiB), args.in[5], vcu, G); xcd_barrier(bar); STAMP(14); }
#endif
    if (IN(2)) att::na_phase(L + RING_OFF, Qb, Kb, Vb, Qb, args.in[5], vcu, G);
    SEAM(2);
    if (IN(3)) { pg8::Gemm g{Qb, Wo0, M, D, D}; pg8::StaticOrder S; S.init(M, D, G, (int)blockIdx.x);
        pg8::EpiRes2<true, false, false> E{x, nullptr, XB, ssqA, nullptr};
        pg8::gemm_phase<pg8::EpiRes2<true, false, false>, pg8::StaticOrder, PG8_ALIGN, PG8_SP2>(L + RING_OFF, g, S, E); }
    SEAM(3);
    if (IN(4)) { pg8::Gemm g{XB, Win0, M, FF, D}; pg8::StaticOrder S; S.init(M, FF, G, (int)blockIdx.x);
        pg8::EpiUp E{Hb};
        pg8::gemm_phase<pg8::EpiUp, pg8::StaticOrder, PG8_ALIGN, PG8_SP2>(L + RING_OFF, g, S, E); }
    SEAM(4);
    if (IN(5)) { pg8::Gemm g{Hb, Wout0, M, D, FF}; pg8::StaticOrder S; S.init(M, D, G, (int)blockIdx.x);
        pg8::EpiRes2<false, false, true> E{nullptr, nullptr, XB, ssqB, ssqA};
        pg8::gemm_phase<pg8::EpiRes2<false, false, true>, pg8::StaticOrder, PG8_ALIGN, PG8_SP2>(L + RING_OFF, g, S, E); }
    SEAM(5);
    if (IN(6)) { pg8::Gemm g{XB, Wqkv1, M, 1536, D}; pg8::StaticOrder S; S.init(M, 1536, G, (int)blockIdx.x);
        pg8::EpiQKV E{Qb, Kb, Vb, 256, C2, ssqB};
        pg8::gemm_phase<pg8::EpiQKV, pg8::StaticOrder, PG8_ALIGN, PG8_SP2>(L + RING_OFF, g, S, E); }
    SEAM(6);
    if (IN(7)) att::swa_phase(L + RING_OFF, Qb, Kb, Vb, Qb, tblg, vcu, G);
    SEAM(7);
    if (IN(8)) { pg8::Gemm g{Qb, Wo1, M, D, D}; pg8::StaticOrder S; S.init(M, D, G, (int)blockIdx.x);
        pg8::EpiRes2<false, false, false> E{nullptr, nullptr, XB, ssqA, nullptr};
        pg8::gemm_phase<pg8::EpiRes2<false, false, false>, pg8::StaticOrder, PG8_ALIGN, PG8_SP2>(L + RING_OFF, g, S, E); }
    SEAM(8);
    if (IN(9)) { pg8::Gemm g{XB, Win1, M, FF, D}; pg8::StaticOrder S; S.init(M, FF, G, (int)blockIdx.x);
        pg8::EpiUp E{Hb};
        pg8::gemm_phase<pg8::EpiUp, pg8::StaticOrder, PG8_ALIGN, PG8_SP2>(L + RING_OFF, g, S, E); }
    SEAM(9);
    if (IN(10)) { pg8::Gemm g{Hb, Wout1, M, D, FF}; pg8::StaticOrder S; S.init(M, D, G, (int)blockIdx.x);
        pg8::EpiRes2<false, true, true> E{nullptr, out, XB, ssqB, ssqA};
        pg8::gemm_phase<pg8::EpiRes2<false, true, true>, pg8::StaticOrder, PG8_ALIGN, PG8_SP2>(L + RING_OFF, g, S, E); }
    SEAM(10);
    if (IN(11)) {
        const int gw = vcu * NWAVES + wave, NGW = G * NWAVES; const GAS f32x4* gr = (const GAS f32x4*)args.in[3] + lane;
        const f32x4 g0 = gr[0], g1 = gr[64], g2 = gr[128], g3 = gr[192];
        for (int m0 = gw * 4; m0 < M; m0 += NGW * 4) {
            f32x4 v[4][4]; float r[4];
#pragma unroll
            for (int q = 0; q < 4; ++q) { const GAS f32x4* xr = (const GAS f32x4*)(out + (size_t)(m0 + q) * D) + lane; r[q] = pg8::rstd16(ssqB, m0 + q);
                v[q][0] = xr[0]; v[q][1] = xr[64]; v[q][2] = xr[128]; v[q][3] = xr[192]; }
#pragma unroll
            for (int q = 0; q < 4; ++q) { GAS f32x4* xr = (GAS f32x4*)(out + (size_t)(m0 + q) * D) + lane;
                xr[0] = v[q][0] * r[q] * g0; xr[64] = v[q][1] * r[q] * g1; xr[128] = v[q][2] * r[q] * g2; xr[192] = v[q][3] * r[q] * g3; }
        }
    }
#ifdef PROBE_A
    xcd_barrier(bar); STAMP(12);
    if (blockIdx.x == 0) { __syncthreads();
        #if defined(PROBE_SW)
        const float ta = (float)MISC[40] * 0.01f, tb2 = (float)MISC[41] * 0.001f;
#elif defined(PROBE_NA)
        const float ta = (float)(MISC[16 + 13] - MISC[16 + 2]) * 0.01f, tb2 = (float)(MISC[16 + 14] - MISC[16 + 13]) * 0.01f;
#else
        const float ta = (float)(MISC[16 + PROBE_A + 1] - MISC[16 + PROBE_A]) * 0.01f, tb2 = (float)(MISC[16 + PROBE_B + 1] - MISC[16 + PROBE_B]) * 0.01f;
#endif
        if (tid == 0) out[0] += ta * PROBE_SCALE;
        out[D + tid] += tb2 * PROBE_SCALE; out[D + 512 + tid] += tb2 * PROBE_SCALE; }
#endif
#undef IN
#undef SEAM
}

extern "C" void kernel_launch(void* const* d_in, const int* in_sizes, int n_in, void* d_out, int out_size, void* d_ws, size_t ws_size, hipStream_t stream) {
    static int grid = 0;
    if (grid == 0) {
        if (n_in != 13 || in_sizes[0] != M * D || out_size != M * D || ws_size < WS_END) { fprintf(stderr, "kernel_launch: unexpected shapes (n_in %d in0 %d out %d ws %zu)\n", n_in, n_in > 0 ? in_sizes[0] : -1, out_size, ws_size); grid = -1; return; }
        int dev = 0, cus = 0, per_cu = 0;
        if (hipGetDevice(&dev) != hipSuccess || hipDeviceGetAttribute(&cus, hipDeviceAttributeMultiprocessorCount, dev) != hipSuccess) { grid = -1; return; }
        if (hipFuncSetAttribute((const void*)mk_fwd, hipFuncAttributeMaxDynamicSharedMemorySize, LDS_BYTES) != hipSuccess) { fprintf(stderr, "kernel_launch: hipFuncSetAttribute failed\n"); grid = -1; return; }
        if (hipOccupancyMaxActiveBlocksPerMultiprocessor(&per_cu, (const void*)mk_fwd, NWAVES * 64, LDS_BYTES) != hipSuccess || per_cu < 1) { fprintf(stderr, "kernel_launch: occupancy query says %d blocks per CU\n", per_cu); grid = -1; (void)hipGetLastError(); return; }
        (void)hipGetLastError();
        grid = cus;
    }
    if (grid < 0) return;
    (void)hipMemsetAsync((unsigned char*)d_ws + WS_CTL, 0, 1 * MiB, stream);
    Args a{}; for (int i = 0; i < 13; ++i) a.in[i] = (const float*)d_in[i]; a.out = (float*)d_out; a.ws = (unsigned char*)d_ws;
#if MK_N_LAUNCHES == 1
    a.ph_lo = 0; a.ph_hi = NPHASE; hipLaunchKernelGGL(mk_fwd, dim3(grid), dim3(NWAVES * 64), LDS_BYTES, stream, a);
#else
    for (int p = 0; p < NPHASE; ++p) { a.ph_lo = p; a.ph_hi = p + 1; hipLaunchKernelGGL(mk_fwd, dim3(grid), dim3(NWAVES * 64), LDS_BYTES, stream, a); }
#endif
}
```

```cpp
#include <hip/hip_runtime.h>
#include <cstdint>
#include <cstdio>

typedef unsigned short bf16;
constexpr int BATCH = 4, SEQ = 8192, D = 1024, NH = 16, HD = 64, KVH = 4, FF = 4096, M = BATCH * SEQ;
constexpr int GW = 64, ROWS = SEQ / GW, KR = 8, KC = 16, WINDOW = 128;
constexpr float EPS = 1e-6f, LOG2E = 1.4426950408889634f, C2 = 0.125f * LOG2E;
constexpr size_t MiB = 1u << 20;
constexpr size_t WS_CTL = 0, WS_SSQ = 1 * MiB, WS_TBL = 3 * MiB, WS_SSQ2 = 50 * MiB;
constexpr size_t WS_WQKV0 = 4 * MiB, WS_WO0 = 10 * MiB, WS_WIN0 = 12 * MiB, WS_WOUT0 = 20 * MiB, WS_WQKV1 = 28 * MiB, WS_WO1 = 31 * MiB, WS_WIN1 = 33 * MiB, WS_WOUT1 = 41 * MiB;
constexpr size_t WS_XB = 64 * MiB, WS_Q = 128 * MiB, WS_K = 192 * MiB, WS_V = 256 * MiB, WS_H = 128 * MiB, WS_END = 384 * MiB;

__device__ __forceinline__ unsigned f2bf(float f) { unsigned u = __builtin_bit_cast(unsigned, f); return (u + 0x7fffu + ((u >> 16) & 1u)) >> 16; }
__device__ __forceinline__ float bf2f(bf16 b) { return __builtin_bit_cast(float, (unsigned)b << 16); }
__device__ __forceinline__ float wave_sum(float v) {
#pragma unroll
    for (int o = 1; o < 64; o <<= 1) v += __shfl_xor(v, o);
    return v;
}
__device__ __forceinline__ float row_rstd(const float* ssq, int row) {
    const float4* p = (const float4*)(ssq + (size_t)row * 16);
    float4 a = p[0], b = p[1], c = p[2], d = p[3];
    float s = ((a.x + a.y) + (a.z + a.w)) + ((b.x + b.y) + (b.z + b.w)) + ((c.x + c.y) + (c.z + c.w)) + ((d.x + d.y) + (d.z + d.w));
    return 1.0f / sqrtf(s * (1.0f / D) + EPS);
}


namespace pg8 {
#define PG8_LAS __attribute__((address_space(3)))
typedef unsigned short bf16_t;
typedef short bf16x8 __attribute__((ext_vector_type(8)));
typedef float f32x4 __attribute__((ext_vector_type(4)));
typedef unsigned u32x4 __attribute__((ext_vector_type(4)));
constexpr int BM = 256, BK = 64, HALF = 128, HTB = HALF * BK * 2  , STAGE_BYTES = 8 * HTB, NXCD = 8, WGM = 8;

__host__ __device__ __forceinline__ int lds_byte(int r, int c) { const int st = (r >> 4) * 2 + (c >> 5), rr = r & 15, cc = c & 31, ob = rr * 64 + cc * 2; return st * 1024 + (ob ^ (((ob >> 9) & 1) << 5)); }
__host__ __device__ __forceinline__ void stage_rc(int b, int& R, int& C) { const int st = b / 1024, sb = b % 1024, swz = sb ^ (((sb >> 9) & 1) << 5); R = (st >> 1) * 16 + swz / 64; C = (st & 1) * 32 + (swz % 64) / 2; }
__host__ __device__ __forceinline__ int perm32(int rho) { const int n = rho >> 4, i = rho & 15; return 8 * (i >> 2) + 4 * n + (i & 3); }

struct Unit { int pm, pn; };
struct Gemm { const bf16_t* A; const bf16_t* Bt; int M, N, K; };

struct StaticOrder {
    int nM, nN, nwg, G, c;
    __host__ __device__ void init(int M, int N, int G_, int c_) { nM = M / BM; nN = N / BM; nwg = nM * nN; G = G_; c = c_; }
    __host__ __device__ bool next(int i, Unit& u) const {
        const long L = (long)i * G + c; if (L >= nwg) return false;
        int wgid = (int)L; { const int q = nwg / NXCD, r = nwg % NXCD, xcd = wgid % NXCD, off = wgid / NXCD; wgid = (xcd < r ? xcd * (q + 1) : r * (q + 1) + (xcd - r) * q) + off; }
        const int nig = WGM * nN, gid = wgid / nig, fm = gid * WGM, gsz = (nM - fm) < WGM ? (nM - fm) : WGM;
        u.pm = fm + ((wgid % nig) % gsz); u.pn = (wgid % nig) / gsz; return true;
    }
    __device__ __forceinline__ void a_ready(const Unit&) const {}
    __device__ __forceinline__ void done(const Unit&) const {}
};

__device__ __forceinline__ unsigned cvt_pk_bf16(float lo, float hi) { unsigned r; asm volatile("v_cvt_pk_bf16_f32 %0, %1, %2" : "=v"(r) : "v"(lo), "v"(hi)); return r; }
typedef float f32x2 __attribute__((ext_vector_type(2)));
__device__ __forceinline__ float rstd16(const float* ssq, int row) {
    const f32x4* p = (const f32x4*)(ssq + (size_t)row * 16);
    const f32x4 a = p[0], b = p[1], c = p[2], d = p[3];
    const float s = (((a[0] + a[1]) + (a[2] + a[3])) + ((b[0] + b[1]) + (b[2] + b[3]))) + (((c[0] + c[1]) + (c[2] + c[3])) + ((d[0] + d[1]) + (d[2] + d[3])));
    return __builtin_amdgcn_rsqf(s * (1.0f / 1024.0f) + 1e-6f);
}
__device__ __forceinline__ float row_ssq_q(const float* ssq, int row, int fq) {
    const f32x4 a = *(const f32x4*)(ssq + (size_t)row * 16 + 4 * fq);
    float s = (a[0] + a[1]) + (a[2] + a[3]); s += __shfl_xor(s, 16); s += __shfl_xor(s, 32); return s;
}
struct EpiQKV {
    static constexpr bool PERM = true, AFTER_DRAIN = false;
    bf16_t *Q, *Kp, *V; int kvw; float qscale; const float* ssq;
    __device__ __forceinline__ void operator()(const f32x4 (&acc)[2][2][4][2], const Unit& u, int wr, int wc, int fr, int fq) const {
        int colt = u.pn * BM; bf16_t* base; float sc = 1.f; bool hm = true;
        if (colt < 1024) { base = Q; sc = qscale; hm = false; } else if (colt < 1024 + kvw) { base = Kp; colt -= 1024; } else { base = V; colt -= 1024 + kvw; }
        const int col0 = colt + wc * 32 + 8 * fq, row0 = u.pm * BM + wr * 64 + fr, nhk = kvw >> 6;
#pragma unroll
        for (int ai = 0; ai < 2; ++ai)
#pragma unroll
            for (int m = 0; m < 4; ++m) { const int row = row0 + ai * HALF + m * 16; const float rs = __builtin_amdgcn_rsqf(row_ssq_q(ssq, row, fq) * (1.0f / 1024.0f) + 1e-6f) * sc; const int bb = row >> 13, tk = row & 8191;
#pragma unroll
                for (int bj = 0; bj < 2; ++bj) { const f32x4 v0 = acc[ai][bj][m][0] * rs, v1 = acc[ai][bj][m][1] * rs; const int cc = col0 + bj * HALF;
                    u32x4 w; w.x = cvt_pk_bf16(v0[0], v0[1]); w.y = cvt_pk_bf16(v0[2], v0[3]); w.z = cvt_pk_bf16(v1[0], v1[1]); w.w = cvt_pk_bf16(v1[2], v1[3]);
                    bf16_t* p = hm ? base + ((size_t)(bb * nhk + (cc >> 6)) * 8192 + tk) * 64 + (cc & 63) : base + (size_t)row * 1024 + cc;
                    *(u32x4*)p = w; } }
    }
};
struct EpiUp {
    static constexpr bool PERM = true, AFTER_DRAIN = false;
    bf16_t* Hh;
    __device__ __forceinline__ void operator()(const f32x4 (&acc)[2][2][4][2], const Unit& u, int wr, int wc, int fr, int fq) const {
        const int col0 = u.pn * BM + wc * 32 + 8 * fq, row0 = u.pm * BM + wr * 64 + fr;
#pragma unroll
        for (int ai = 0; ai < 2; ++ai)
#pragma unroll
            for (int m = 0; m < 4; ++m) { const int row = row0 + ai * HALF + m * 16; bf16_t* rowp = Hh + (size_t)row * 4096 + col0;
#pragma unroll
                for (int bj = 0; bj < 2; ++bj) { f32x4 v0 = acc[ai][bj][m][0], v1 = acc[ai][bj][m][1];
#pragma unroll
                    for (int e = 0; e < 4; ++e) { const float a = __builtin_fmaxf(v0[e], 0.f), b = __builtin_fmaxf(v1[e], 0.f); v0[e] = a * a; v1[e] = b * b; }
                    u32x4 w; w.x = cvt_pk_bf16(v0[0], v0[1]); w.y = cvt_pk_bf16(v0[2], v0[3]); w.z = cvt_pk_bf16(v1[0], v1[1]); w.w = cvt_pk_bf16(v1[2], v1[3]);
                    *(u32x4*)(rowp + bj * HALF) = w; } }
    }
};
struct EpiRes {
    static constexpr bool PERM = false, AFTER_DRAIN = false;
    const float* base; float* out; bf16_t* xb; float* ssq;
    __device__ __forceinline__ void operator()(const f32x4 (&acc)[2][2][4][2], const Unit& u, int wr, int wc, int fr, int fq) const {
        typedef unsigned u32x2v __attribute__((ext_vector_type(2)));
        const int col0 = u.pn * BM + wc * 32 + 4 * fq, row0 = u.pm * BM + wr * 64 + fr;
#pragma unroll
        for (int ai = 0; ai < 2; ++ai)
#pragma unroll
            for (int m = 0; m < 4; ++m) { const int row = row0 + ai * HALF + m * 16; const size_t off = (size_t)row * 1024 + col0; float s = 0.f;
#pragma unroll
                for (int bj = 0; bj < 2; ++bj)
#pragma unroll
                    for (int n = 0; n < 2; ++n) { const f32x4 bs = *(const f32x4*)(base + off + bj * HALF + n * 16); const f32x4 o = bs + acc[ai][bj][m][n];
                        *(f32x4*)(out + off + bj * HALF + n * 16) = o; s += (o[0] * o[0] + o[1] * o[1]) + (o[2] * o[2] + o[3] * o[3]);
                        u32x2v w; w.x = cvt_pk_bf16(o[0], o[1]); w.y = cvt_pk_bf16(o[2], o[3]); *(u32x2v*)(xb + off + bj * HALF + n * 16) = w; }
                s += __shfl_xor(s, 16); s += __shfl_xor(s, 32);
                if (fq == 0) ssq[(size_t)row * 16 + u.pn * 4 + wc] = s; }
    }
};
template <bool BASE_F32, bool OUT_F32, bool RSQ> struct EpiRes2 {
    static constexpr bool PERM = true, AFTER_DRAIN = false;
    const float* basef; float* outf; bf16_t* xb; float* ssq; const float* ssq_in;
    __device__ __forceinline__ void operator()(const f32x4 (&acc)[2][2][4][2], const Unit& u, int wr, int wc, int fr, int fq) const {
        const int col0 = u.pn * BM + wc * 32 + 8 * fq, row0 = u.pm * BM + wr * 64 + fr;
#pragma unroll
        for (int ai = 0; ai < 2; ++ai)
#pragma unroll
            for (int m = 0; m < 4; ++m) { const int row = row0 + ai * HALF + m * 16; const size_t off = (size_t)row * 1024 + col0; float s = 0.f;
                float r2 = 1.f; if (RSQ) r2 = 1.0f / (row_ssq_q(ssq_in, row, fq) * (1.0f / 1024.0f) + 1e-6f);
#pragma unroll
                for (int bj = 0; bj < 2; ++bj) { f32x4 b0, b1;
                    if (BASE_F32) { b0 = *(const f32x4*)(basef + off + bj * HALF); b1 = *(const f32x4*)(basef + off + bj * HALF + 4); }
                    else { const u32x4 w = *(const u32x4*)(xb + off + bj * HALF);
                        b0 = (f32x4){__builtin_bit_cast(float, w.x << 16), __builtin_bit_cast(float, w.x & 0xffff0000u), __builtin_bit_cast(float, w.y << 16), __builtin_bit_cast(float, w.y & 0xffff0000u)};
                        b1 = (f32x4){__builtin_bit_cast(float, w.z << 16), __builtin_bit_cast(float, w.z & 0xffff0000u), __builtin_bit_cast(float, w.w << 16), __builtin_bit_cast(float, w.w & 0xffff0000u)}; }
                    const f32x4 o0 = b0 + acc[ai][bj][m][0] * r2, o1 = b1 + acc[ai][bj][m][1] * r2;
                    s += ((o0[0] * o0[0] + o0[1] * o0[1]) + (o0[2] * o0[2] + o0[3] * o0[3])) + ((o1[0] * o1[0] + o1[1] * o1[1]) + (o1[2] * o1[2] + o1[3] * o1[3]));
                    if (OUT_F32) { *(f32x4*)(outf + off + bj * HALF) = o0; *(f32x4*)(outf + off + bj * HALF + 4) = o1; }
                    else { u32x4 w; w.x = cvt_pk_bf16(o0[0], o0[1]); w.y = cvt_pk_bf16(o0[2], o0[3]); w.z = cvt_pk_bf16(o1[0], o1[1]); w.w = cvt_pk_bf16(o1[2], o1[3]); *(u32x4*)(xb + off + bj * HALF) = w; } }
                s += __shfl_xor(s, 16); s += __shfl_xor(s, 32);
                if (fq == 0) ssq[(size_t)row * 16 + u.pn * 4 + wc] = s; }
    }
};
template <class Epi, class Sched, bool ALIGN_EPI = false, bool SP2 = false>
__device__ __forceinline__ void gemm_phase(PG8_LAS unsigned char* lds, const Gemm g, const Sched& S, const Epi& E) {
    const int tid = threadIdx.x, wid = __builtin_amdgcn_readfirstlane(tid >> 6), lane = tid & 63, wr = wid >> 2, wc = wid & 3, fr = lane & 15, fq = lane >> 4;
    const int K = g.K, nt = K / BK;
    unsigned voffA[2], voffB[2];
#pragma unroll
    for (int i = 0; i < 2; ++i) { int R, C; stage_rc(tid * 16 + i * 8192, R, C); const int Rb = Epi::PERM ? ((R & ~31) + perm32(R & 31)) : R;
        voffA[i] = (unsigned)(R * K + C) * 2u; voffB[i] = (unsigned)(Rb * K + C) * 2u; }
    const size_t kstep = (size_t)(BK * 2);
    const size_t hstep = (size_t)HALF * K * 2;
    const size_t tstep = 2 * hstep;
    const unsigned ldsw = (unsigned)wid * 1024u;
    const int aoff = lds_byte(wr * 64 + fr, fq * 8), boff = lds_byte(wc * 32 + fr, fq * 8);
#define PG8_SA(b, h) (((b) * 2 + (h)) * HTB)
#define PG8_SB(b, h) ((4 + (b) * 2 + (h)) * HTB)
#define PG8_STAGE(bufoff, gbase, voff) do { _Pragma("unroll") for (int _i = 0; _i < 2; ++_i) \
        __builtin_amdgcn_global_load_lds((const unsigned*)((const char*)(gbase) + (voff)[_i]), (PG8_LAS unsigned*)(lds + (bufoff) + ldsw + _i * 8192), 16, 0, 0); } while (0)
#define PG8_LDA(dst, b, h) do { _Pragma("unroll") for (int m = 0; m < 4; ++m) _Pragma("unroll") for (int k = 0; k < 2; ++k) dst[m][k] = *(const PG8_LAS bf16x8*)(lds + PG8_SA(b, h) + aoff + m * 2048 + k * 1024); } while (0)
#define PG8_LDB(dst, b, h) do { _Pragma("unroll") for (int n = 0; n < 2; ++n) _Pragma("unroll") for (int k = 0; k < 2; ++k) dst[n][k] = *(const PG8_LAS bf16x8*)(lds + PG8_SB(b, h) + boff + n * 2048 + k * 1024); } while (0)
#define PG8_MMA(ai, bj, At, Bt) do { __builtin_amdgcn_s_setprio(1); _Pragma("unroll") for (int m = 0; m < 4; ++m) _Pragma("unroll") for (int n = 0; n < 2; ++n) _Pragma("unroll") for (int k = 0; k < 2; ++k) \
        acc[ai][bj][m][n] = __builtin_amdgcn_mfma_f32_16x16x32_bf16(Bt[n][k], At[m][k], acc[ai][bj][m][n], 0, 0, 0); __builtin_amdgcn_s_setprio(0); } while (0)
#define PG8_WAIT_V(n) asm volatile("s_waitcnt vmcnt(" #n ")" ::: "memory")
#define PG8_WAIT_L(n) asm volatile("s_waitcnt lgkmcnt(" #n ")" ::: "memory")
#define PG8_BAR __builtin_amdgcn_s_barrier()
#define PG8_SCHED __builtin_amdgcn_sched_barrier(0)
    Unit cur, nxt; int ui = 0;
    if (!S.next(0, cur)) return;
    f32x4 acc[2][2][4][2];
#pragma unroll
    for (int a = 0; a < 2; ++a)
#pragma unroll
        for (int b = 0; b < 2; ++b)
#pragma unroll
            for (int m = 0; m < 4; ++m)
#pragma unroll
                for (int n = 0; n < 2; ++n) acc[a][b][m][n] = (f32x4){0.f, 0.f, 0.f, 0.f};
    bf16x8 At[4][2], B0[2][2], B1[2][2];
    const char* cA = (const char*)g.A + (size_t)cur.pm * tstep; const char* cB = (const char*)g.Bt + (size_t)cur.pn * tstep;
    S.a_ready(cur);
    if constexpr (SP2) {
        PG8_STAGE(PG8_SB(0, 0), cB, voffB); PG8_STAGE(PG8_SB(0, 1), cB + hstep, voffB); PG8_STAGE(PG8_SA(0, 0), cA, voffA); PG8_STAGE(PG8_SA(0, 1), cA + hstep, voffA);
        if (wr == 1) PG8_BAR;
        PG8_WAIT_V(2); PG8_BAR;
        PG8_STAGE(PG8_SB(1, 0), cB + kstep, voffB); PG8_STAGE(PG8_SA(1, 0), cA + kstep, voffA); PG8_STAGE(PG8_SB(1, 1), cB + hstep + kstep, voffB);
        PG8_WAIT_V(6); PG8_BAR;
    } else {
        PG8_STAGE(PG8_SB(0, 0), cB, voffB); PG8_STAGE(PG8_SA(0, 0), cA, voffA); PG8_STAGE(PG8_SB(0, 1), cB + hstep, voffB); PG8_STAGE(PG8_SA(0, 1), cA + hstep, voffA);
        if (wr == 1) PG8_BAR;
        PG8_WAIT_V(4); PG8_BAR;
        PG8_STAGE(PG8_SB(1, 0), cB + kstep, voffB); PG8_STAGE(PG8_SA(1, 0), cA + kstep, voffA); PG8_STAGE(PG8_SB(1, 1), cB + hstep + kstep, voffB);
        PG8_WAIT_V(6); PG8_BAR;
    }
    for (;;) {
        const bool has_next = S.next(ui + 1, nxt);
        const char* nA = has_next ? (const char*)g.A + (size_t)nxt.pm * tstep : cA; const char* nB = has_next ? (const char*)g.Bt + (size_t)nxt.pn * tstep : cB;
#ifdef PROBE_GEMM
        unsigned long long pg_t0 = __builtin_amdgcn_s_memrealtime(), pg_c0 = __builtin_amdgcn_s_memtime();
#endif
        for (int t = 0; t < nt; t += 2) {
            const bool last = (t == nt - 2);
            const char* a1 = cA + (size_t)(t + 1) * kstep;
            const char* a2 = last ? nA : cA + (size_t)(t + 2) * kstep; const char* b2 = last ? nB : cB + (size_t)(t + 2) * kstep;
            const char* a3 = a2 + kstep; const char* b3 = b2 + kstep;
            if (last && has_next) S.a_ready(nxt);
            if constexpr (SP2) {
            PG8_LDB(B0, 0, 0); PG8_LDB(B1, 0, 1); PG8_SCHED; PG8_LDA(At, 0, 0); PG8_STAGE(PG8_SA(1, 1), a1 + hstep, voffA);
            PG8_WAIT_V(8); PG8_WAIT_L(0); PG8_BAR; PG8_MMA(0, 0, At, B0); PG8_MMA(0, 1, At, B1); PG8_BAR; PG8_SCHED;
            PG8_LDA(At, 0, 1); PG8_STAGE(PG8_SB(0, 0), b2, voffB); PG8_STAGE(PG8_SB(0, 1), b2 + hstep, voffB); PG8_STAGE(PG8_SA(0, 0), a2, voffA);
            PG8_WAIT_V(8); PG8_WAIT_L(0); PG8_BAR; PG8_MMA(1, 0, At, B0); PG8_MMA(1, 1, At, B1); PG8_BAR; PG8_SCHED;
            PG8_LDB(B0, 1, 0); PG8_LDB(B1, 1, 1); PG8_SCHED; PG8_LDA(At, 1, 0); PG8_STAGE(PG8_SA(0, 1), a2 + hstep, voffA);
            PG8_WAIT_V(8); PG8_WAIT_L(0); PG8_BAR; PG8_MMA(0, 0, At, B0); PG8_MMA(0, 1, At, B1); PG8_BAR; PG8_SCHED;
            PG8_LDA(At, 1, 1); PG8_STAGE(PG8_SB(1, 0), b3, voffB); PG8_STAGE(PG8_SB(1, 1), b3 + hstep, voffB); PG8_STAGE(PG8_SA(1, 0), a3, voffA);
            PG8_WAIT_V(8); PG8_WAIT_L(0); PG8_BAR; PG8_MMA(1, 0, At, B0); PG8_MMA(1, 1, At, B1); PG8_BAR; PG8_SCHED;
            } else {
            PG8_LDB(B0, 0, 0); PG8_SCHED; PG8_LDA(At, 0, 0); PG8_STAGE(PG8_SA(1, 1), a1 + hstep, voffA);
            PG8_WAIT_L(8); PG8_BAR; PG8_WAIT_L(0); PG8_MMA(0, 0, At, B0); PG8_BAR; PG8_SCHED;
            PG8_LDB(B1, 0, 1); PG8_STAGE(PG8_SB(0, 0), b2, voffB);
            PG8_BAR; PG8_WAIT_L(0); PG8_MMA(0, 1, At, B1); PG8_BAR;
            PG8_LDA(At, 0, 1); PG8_STAGE(PG8_SA(0, 0), a2, voffA);
            PG8_BAR; PG8_WAIT_L(0); PG8_MMA(1, 0, At, B0); PG8_BAR; PG8_SCHED;
            PG8_STAGE(PG8_SB(0, 1), b2 + hstep, voffB);
            PG8_WAIT_V(6); PG8_BAR; PG8_MMA(1, 1, At, B1); PG8_BAR;
            PG8_LDB(B0, 1, 0); PG8_SCHED; PG8_LDA(At, 1, 0); PG8_STAGE(PG8_SA(0, 1), a2 + hstep, voffA);
            PG8_WAIT_L(8); PG8_BAR; PG8_WAIT_L(0); PG8_MMA(0, 0, At, B0); PG8_BAR; PG8_SCHED;
            PG8_LDB(B1, 1, 1); PG8_STAGE(PG8_SB(1, 0), b3, voffB);
            PG8_BAR; PG8_WAIT_L(0); PG8_MMA(0, 1, At, B1); PG8_BAR;
            PG8_LDA(At, 1, 1); PG8_STAGE(PG8_SA(1, 0), a3, voffA);
            PG8_BAR; PG8_WAIT_L(0); PG8_MMA(1, 0, At, B0); PG8_BAR; PG8_SCHED;
            PG8_STAGE(PG8_SB(1, 1), b3 + hstep, voffB);
            PG8_WAIT_V(6); PG8_BAR; PG8_MMA(1, 1, At, B1); PG8_BAR;
            }
        }
#ifdef PROBE_GEMM
        unsigned long long pg_t1 = __builtin_amdgcn_s_memrealtime(), pg_c1 = __builtin_amdgcn_s_memtime();
#endif
        if constexpr (ALIGN_EPI) { if (wr == 0) PG8_BAR; }
        if constexpr (!Epi::AFTER_DRAIN) { E(acc, cur, wr, wc, fr, fq); S.done(cur); }
        if (!has_next) break;
#pragma unroll
        for (int a = 0; a < 2; ++a)
#pragma unroll
            for (int b = 0; b < 2; ++b)
#pragma unroll
                for (int m = 0; m < 4; ++m)
#pragma unroll
                    for (int n = 0; n < 2; ++n) acc[a][b][m][n] = (f32x4){0.f, 0.f, 0.f, 0.f};
#ifdef PROBE_GEMM
        if (ui == 1 && g.N == PROBE_GEMM && blockIdx.x == 0 && tid == 0) { volatile PG8_LAS unsigned* MI = (volatile PG8_LAS unsigned*)(lds + 131072 + 320); MI[40] = (unsigned)(pg_t1 - pg_t0); MI[41] = (unsigned)(pg_c1 - pg_c0); }
#endif
        cur = nxt; cA = nA; cB = nB; ++ui;
        if constexpr (ALIGN_EPI) { if (wr == 1) PG8_BAR; }
    }
    PG8_WAIT_V(0);
    if constexpr (!ALIGN_EPI) { if (wr == 0) PG8_BAR; }
    PG8_BAR;
    if constexpr (Epi::AFTER_DRAIN) { E.fused(acc, cur, wr, wc, fr, fq, lds, wid, lane); S.done(cur); }
#undef PG8_SA
#undef PG8_SB
#undef PG8_STAGE
#undef PG8_LDA
#undef PG8_LDB
#undef PG8_MMA
#undef PG8_WAIT_V
#undef PG8_WAIT_L
#undef PG8_BAR
#undef PG8_SCHED
}
}

#define GAS __attribute__((address_space(1)))
#define LAS __attribute__((address_space(3)))
typedef unsigned v4u __attribute__((ext_vector_type(4)));
typedef float f32x4 __attribute__((ext_vector_type(4)));
typedef short bf16x8 __attribute__((ext_vector_type(8)));
typedef GAS unsigned gu32;
typedef GAS unsigned long long gu64;
#define RLX_AGENT __ATOMIC_RELAXED, __HIP_MEMORY_SCOPE_AGENT
#define LDS_WAIT() asm volatile("s_waitcnt lgkmcnt(0)" ::: "memory")
#define VM_WAIT() asm volatile("s_waitcnt vmcnt(0)" ::: "memory")
__device__ __forceinline__ unsigned long long rt() { return __builtin_amdgcn_s_memrealtime(); }
__device__ __forceinline__ unsigned pk2(float lo, float hi) { return f2bf(lo) | (f2bf(hi) << 16); }

#define XB_TMO      128
#define XB_XCNT(j)  (256  + 64 * (j))
#define XB_XSUB(j)  (1280 + 64 * (j))
#define XB_XGEN(j)  (2304 + 64 * (j))
#define XB_TOP      3328
#define XB_TOPGEN   3392
#define XCD_BAR_WORDS 3456
#define XB_SPIN_CAP (1u << 18)

__device__ __forceinline__ unsigned xb_ld(unsigned* p)              { return __hip_atomic_load(p, __ATOMIC_RELAXED, __HIP_MEMORY_SCOPE_AGENT); }
__device__ __forceinline__ unsigned xb_add(unsigned* p, unsigned v) { return __hip_atomic_fetch_add(p, v, __ATOMIC_RELAXED, __HIP_MEMORY_SCOPE_AGENT); }
__device__ __forceinline__ unsigned xb_xcc_id() { return (unsigned)__builtin_amdgcn_s_getreg((3 << 11) | 20) & 0xFu; }
#define XB_SPIN(cond, bar) do { unsigned _sp = 0; while (cond) { __builtin_amdgcn_s_sleep(1); \
    if ((++_sp & 255u) == 0u) { if (xb_ld(&(bar)[XB_TMO])) break; if (_sp > XB_SPIN_CAP) { atomicAdd(&(bar)[XB_TMO], 1u); break; } } } } while (0)

struct XcdBarrier {
    unsigned* bar; unsigned x;
    volatile LAS unsigned* st;
};

__device__ __forceinline__ XcdBarrier xcd_barrier_post(unsigned* bar, volatile LAS unsigned* st) {
    XcdBarrier b; b.bar = bar; b.x = xb_xcc_id(); b.st = st;
    if (threadIdx.x == 0) (void)xb_add(&bar[XB_XCNT(b.x)], 1u);
    return b;
}
__device__ __forceinline__ void xcd_barrier_complete(unsigned* bar, unsigned x, unsigned& nloc, unsigned& nx) {
    const unsigned G = gridDim.x * gridDim.y * gridDim.z;
    unsigned sum, cnt, mine, sp = 0u;
    for (;;) {
        sum = 0u; cnt = 0u; mine = 0u;
#pragma unroll
        for (unsigned j = 0; j < 16; ++j) { const unsigned c = xb_ld(&bar[XB_XCNT(j)]); sum += c; cnt += (c > 0u) ? 1u : 0u; mine = (j == x) ? c : mine; }
        if (sum == G) break;
        __builtin_amdgcn_s_sleep(1);
        if ((++sp & 255u) == 0u) { if (xb_ld(&bar[XB_TMO])) break; if (sp > XB_SPIN_CAP) { atomicAdd(&bar[XB_TMO], 1u); break; } }
    }
    nloc = mine > 0u ? mine : 1u; nx = cnt > 0u ? cnt : 1u;
}

__device__ __forceinline__ void xcd_barrier(const XcdBarrier& b) {
    asm volatile("s_waitcnt vmcnt(0)" ::: "memory");
    __syncthreads();
    if (threadIdx.x == 0) {
        unsigned* bar = b.bar;
        __builtin_amdgcn_s_waitcnt(0);
        unsigned nloc = b.st[0], nx = b.st[1];
        if (nloc == 0u) { xcd_barrier_complete(bar, b.x, nloc, nx); b.st[0] = nloc; b.st[1] = nx; }
        const unsigned old = xb_add(&bar[XB_XSUB(b.x)], 1u);
        const unsigned gen = old / nloc;
        if (old + 1u == (gen + 1u) * nloc) {
            __builtin_amdgcn_fence(__ATOMIC_RELEASE, "agent");
            asm volatile("s_waitcnt vmcnt(0)" ::: "memory");
            const unsigned og = xb_add(&bar[XB_TOP], 1u);
            const unsigned tg = og / nx;
            if (og + 1u == (tg + 1u) * nx) xb_add(&bar[XB_TOPGEN], 1u);
            else XB_SPIN(xb_ld(&bar[XB_TOPGEN]) == tg, bar);
            __builtin_amdgcn_fence(__ATOMIC_ACQUIRE, "agent");
            xb_add(&bar[XB_XGEN(b.x)], 1u);
            asm volatile("s_waitcnt vmcnt(0)" ::: "memory");
        } else {
            XB_SPIN(xb_ld(&bar[XB_XGEN(b.x)]) == gen, bar);
            __builtin_amdgcn_fence(__ATOMIC_ACQUIRE, "agent");
            asm volatile("s_waitcnt vmcnt(0)" ::: "memory");
        }
    }
    __syncthreads();
}

namespace att {
typedef short bf16x8 __attribute__((ext_vector_type(8)));
typedef short s16x4 __attribute__((ext_vector_type(4)));
typedef float f32x4 __attribute__((ext_vector_type(4)));
typedef unsigned u32x2 __attribute__((ext_vector_type(2)));
typedef LAS const char* lptr;
constexpr float NEG = -INFINITY;
__device__ __forceinline__ int fK(int t) { return (t >> 1) & 7; }
__device__ __forceinline__ int fV(int t) { return (((t >> 1) & 3) << 1) | ((t >> 3) & 1); }
__device__ __forceinline__ s16x4 vtr(lptr p) { typedef short v4i16_t __attribute__((ext_vector_type(4))); return __builtin_bit_cast(s16x4, __builtin_amdgcn_ds_read_tr16_b64_v4i16((LAS v4i16_t*)p)); }
__device__ __forceinline__ unsigned cvtpk(float lo, float hi) { unsigned r; asm volatile("v_cvt_pk_bf16_f32 %0, %1, %2" : "=v"(r) : "v"(lo), "v"(hi)); return r; }
__device__ __forceinline__ float xor16(float v) { return __builtin_bit_cast(float, __builtin_amdgcn_ds_swizzle(__builtin_bit_cast(int, v), 0x401F)); }
__device__ __forceinline__ float max4(float v) { v = __builtin_fmaxf(v, xor16(v)); return __builtin_fmaxf(v, __shfl_xor(v, 32)); }
__device__ __forceinline__ float sum4(float v) { v += xor16(v); return v + __shfl_xor(v, 32); }

struct Item { bf16x8 q0, q1; f32x4 o0, o1, o2, o3; float m, l; int ka, va; };
__device__ __forceinline__ void item_init(Item& it, float m0, float l0) { it.o0 = it.o1 = it.o2 = it.o3 = (f32x4){0.f, 0.f, 0.f, 0.f}; it.m = m0; it.l = l0; }
__device__ __forceinline__ void item_addr(Item& it, int w0, int lane) {
    const int fr = lane & 15, fq = lane >> 4, rk = w0 + fr, rv = w0 + 4 * fq + (fr >> 2);
    it.ka = rk * 128 + ((fq ^ fK(rk)) << 4);
    it.va = 8192 + rv * 128 + (((((fr & 3) >> 1)) ^ fV(rv)) << 4) + 8 * (fr & 1);
}
__device__ __forceinline__ void half_step(Item& it, lptr slot, f32x4 b0, f32x4 b1) {
    lptr kp = slot + it.ka;
    const bf16x8 k00 = *(const LAS bf16x8*)(kp), k01 = *(const LAS bf16x8*)(kp + 2048);
    lptr kp1 = slot + (it.ka ^ 64);
    const bf16x8 k10 = *(const LAS bf16x8*)(kp1), k11 = *(const LAS bf16x8*)(kp1 + 2048);
    f32x4 s0 = __builtin_amdgcn_mfma_f32_16x16x32_bf16(k00, it.q0, b0, 0, 0, 0);
    f32x4 s1 = __builtin_amdgcn_mfma_f32_16x16x32_bf16(k01, it.q0, b1, 0, 0, 0);
    s0 = __builtin_amdgcn_mfma_f32_16x16x32_bf16(k10, it.q1, s0, 0, 0, 0);
    s1 = __builtin_amdgcn_mfma_f32_16x16x32_bf16(k11, it.q1, s1, 0, 0, 0);
    float mx = __builtin_fmaxf(__builtin_fmaxf(__builtin_fmaxf(s0[0], s0[1]), __builtin_fmaxf(s0[2], s0[3])), __builtin_fmaxf(__builtin_fmaxf(s1[0], s1[1]), __builtin_fmaxf(s1[2], s1[3])));
    if (__builtin_expect(__any(mx > it.m + 8.0f), 0)) {
        mx = max4(mx);
        const float mn = __builtin_fmaxf(it.m, mx), al = __builtin_amdgcn_exp2f(it.m - mn);
        it.m = mn; it.l *= al; it.o0 *= al; it.o1 *= al; it.o2 *= al; it.o3 *= al;
    }
    const float mn = it.m;
#pragma unroll
    for (int e = 0; e < 4; ++e) { s0[e] = __builtin_amdgcn_exp2f(s0[e] - mn); s1[e] = __builtin_amdgcn_exp2f(s1[e] - mn); }
    it.l += (((s0[0] + s0[1]) + (s0[2] + s0[3])) + ((s1[0] + s1[1]) + (s1[2] + s1[3])));
    typedef unsigned u32x4 __attribute__((ext_vector_type(4)));
    u32x4 pw; pw.x = cvtpk(s0[0], s0[1]); pw.y = cvtpk(s0[2], s0[3]); pw.z = cvtpk(s1[0], s1[1]); pw.w = cvtpk(s1[2], s1[3]);
    const bf16x8 pf = __builtin_bit_cast(bf16x8, pw);
#define ATT_PV(dt, O) do { lptr vp = slot + (it.va ^ ((dt) << 5)); const s16x4 lo = vtr(vp), hi = vtr(vp + 2048); \
        const bf16x8 vf = (bf16x8){lo[0], lo[1], lo[2], lo[3], hi[0], hi[1], hi[2], hi[3]}; O = __builtin_amdgcn_mfma_f32_16x16x32_bf16(vf, pf, O, 0, 0, 0); } while (0)
    ATT_PV(0, it.o0); ATT_PV(1, it.o1); ATT_PV(2, it.o2); ATT_PV(3, it.o3);
#undef ATT_PV
}
__device__ __forceinline__ void item_store(Item& it, bf16* orow, int lane) {
    const float rl = 1.0f / sum4(it.l); const int fq = lane >> 4;
    u32x2 w;
    w.x = cvtpk(it.o0[0] * rl, it.o0[1] * rl); w.y = cvtpk(it.o0[2] * rl, it.o0[3] * rl); *(u32x2*)(orow + 0 + 4 * fq) = w;
    w.x = cvtpk(it.o1[0] * rl, it.o1[1] * rl); w.y = cvtpk(it.o1[2] * rl, it.o1[3] * rl); *(u32x2*)(orow + 16 + 4 * fq) = w;
    w.x = cvtpk(it.o2[0] * rl, it.o2[1] * rl); w.y = cvtpk(it.o2[2] * rl, it.o2[3] * rl); *(u32x2*)(orow + 32 + 4 * fq) = w;
    w.x = cvtpk(it.o3[0] * rl, it.o3[1] * rl); w.y = cvtpk(it.o3[2] * rl, it.o3[3] * rl); *(u32x2*)(orow + 48 + 4 * fq) = w;
}
__device__ __forceinline__ void glds16(const void* gsrc, unsigned lds_dst) { unsigned keep;
    asm volatile("s_mov_b32 %0, m0\n\ts_mov_b32 m0, %2\n\ts_nop 0\n\tglobal_load_lds_dwordx4 %1, off\n\ts_mov_b32 m0, %0" : "=&s"(keep) : "v"(gsrc), "s"(lds_dst) : "memory"); }
__device__ __forceinline__ unsigned lds_u32(LAS unsigned char* p) { return (unsigned)__builtin_amdgcn_readfirstlane((int)(unsigned)(uintptr_t)p); }
#define ATT_WAITV(n) asm volatile("s_waitcnt vmcnt(" #n ")" ::: "memory")
#define ATT_BAR() do { asm volatile("s_waitcnt lgkmcnt(0)" ::: "memory"); __builtin_amdgcn_s_barrier(); asm volatile("" ::: "memory"); } while (0)
__device__ __forceinline__ void wait_vm(int n) {
    if (n >= 31) ATT_WAITV(31); else if (n >= 28) ATT_WAITV(28); else if (n >= 25) ATT_WAITV(25); else if (n >= 22) ATT_WAITV(22); else if (n >= 19) ATT_WAITV(19); else if (n >= 16) ATT_WAITV(16);
    else if (n >= 10) ATT_WAITV(10); else if (n >= 9) ATT_WAITV(9); else if (n >= 8) ATT_WAITV(8); else if (n >= 6) ATT_WAITV(6); else if (n >= 4) ATT_WAITV(4); else if (n >= 3) ATT_WAITV(3); else if (n >= 2) ATT_WAITV(2); else ATT_WAITV(0);
}

constexpr int NA_SLOT = 24576, NA_NS = 5, NA_PD = 3, NA_TBL = NA_NS * NA_SLOT;
struct NaCtx { LAS unsigned char* L; const bf16 *Q, *Kh, *Vh; bf16* O; const float* rpb; int tid, lane, wid, fr, fq, tok, cp; };
__device__ __forceinline__ void na_item_cols(int ct, int fr, int fq, int lane, Item& it, int& tbi, f32x4 (&mk)[2]) {
    const int w0 = ct == 0 ? 0 : ct == 1 ? 8 : ct == 2 ? 24 : 32, c = ct * 16 + fr; int cs = c - KC / 2; cs = cs < 0 ? 0 : (cs > GW - KC ? GW - KC : cs);
    item_addr(it, w0, lane); tbi = 16 + w0 + 4 * fq - c + 15;
    const int dl = w0 + 4 * fq - cs;
#pragma unroll
    for (int kt = 0; kt < 2; ++kt)
#pragma unroll
        for (int e = 0; e < 4; ++e) { const int x = dl + 16 * kt + e; mk[kt][e] = (x >= 0 && x <= 15) ? 0.f : NEG; }
}
__device__ __forceinline__ void na_table(const NaCtx& c, int h) {
    LAS float* tb = (LAS float*)(c.L + NA_TBL);
    for (int i = c.tid; i < 15 * 64; i += 512) { const int dr = i >> 6, ix = i & 63, dc = ix - 16; const float v = (dc >= 0 && dc < 31) ? c.rpb[(h * 15 + dr) * 31 + dc] * LOG2E : 0.f;
        tb[i] = v; tb[15 * 64 + i] = (ix >= 23 && ix <= 38) ? v : NEG; }
}
__device__ __forceinline__ void na_edge(const NaCtx& c, int b, int h, int r0, int klo) {
    LAS unsigned char* L = c.L; LAS float* tb = (LAS float*)(L + NA_TBL); const int wid = c.wid; int lane = c.lane; asm volatile("" : "+v"(lane));
    const int fr = lane & 15, fq = lane >> 4;
    const size_t plane = ((size_t)(b * NH + h) * SEQ) * HD;
    const bf16* ksrc = c.Kh + plane + (size_t)klo * GW * HD + c.tok * HD + ((c.cp ^ fK(c.tok)) << 3); const bf16* vsrc = c.Vh + plane + (size_t)klo * GW * HD + c.tok * HD + ((c.cp ^ fV(c.tok)) << 3);
    ATT_BAR();
    for (int t = 0; t < NA_PD; ++t) { const unsigned d = lds_u32(L + t * NA_SLOT + wid * 1024); glds16(ksrc + (size_t)t * GW * HD, d); glds16(vsrc + (size_t)t * GW * HD, d + 8192u); }
    na_table(c, h);
    const int r = r0 + (wid >> 1);
    Item it[2]; int tbi[2]; f32x4 mk[2][2];
#pragma unroll
    for (int i = 0; i < 2; ++i) { const int ct = 2 * (wid & 1) + i;
        const bf16* qp = c.Q + ((size_t)b * SEQ + (size_t)r * GW + ct * 16 + fr) * D + h * HD + 8 * fq;
        it[i].q0 = *(const bf16x8*)qp; it[i].q1 = *(const bf16x8*)(qp + 32);
        item_init(it[i], -1e30f, 0.f); na_item_cols(ct, fr, fq, lane, it[i], tbi[i], mk[i]); }
    __builtin_amdgcn_s_waitcnt(0x0F70);
    for (int t = 0; t < KR; ++t) {
        if (t + NA_PD < KR) { const unsigned d = lds_u32(L + ((t + NA_PD) % NA_NS) * NA_SLOT + wid * 1024); glds16(ksrc + (size_t)(t + NA_PD) * GW * HD, d); glds16(vsrc + (size_t)(t + NA_PD) * GW * HD, d + 8192u); }
        wait_vm(2 * (KR - 1 - t < NA_PD ? KR - 1 - t : NA_PD));
        ATT_BAR();
        lptr slot = (lptr)(L + (t % NA_NS) * NA_SLOT); const int dr = klo + t - r + KR - 1;
#pragma unroll
        for (int i = 0; i < 2; ++i) { const LAS float* bp = tb + dr * 64 + tbi[i]; f32x4 b0, b1;
#pragma unroll
            for (int e = 0; e < 4; ++e) { b0[e] = bp[e] + mk[i][0][e]; b1[e] = bp[16 + e] + mk[i][1][e]; }
            half_step(it[i], slot, b0, b1); }
    }
#pragma unroll
    for (int i = 0; i < 2; ++i) { const int cc = (2 * (wid & 1) + i) * 16 + fr; item_store(it[i], c.O + ((size_t)b * SEQ + (size_t)r * GW + cc) * D + h * HD, lane); }
    __builtin_amdgcn_s_waitcnt(0x0F70);
}
__device__ __forceinline__ void na_strip(const NaCtx& c, int b, int h, int ra, int rb) {
    LAS unsigned char* L = c.L; LAS float* tb = (LAS float*)(L + NA_TBL); const int wid = c.wid; int lane = c.lane; asm volatile("" : "+v"(lane));
    const int fr = lane & 15, fq = lane >> 4;
    const int klo = ra - 4, nt = rb - ra + 7;
    const size_t plane = ((size_t)(b * NH + h) * SEQ) * HD;
    const bf16* ksrc = c.Kh + plane + (size_t)klo * GW * HD + c.tok * HD + ((c.cp ^ fK(c.tok)) << 3); const bf16* vsrc = c.Vh + plane + (size_t)klo * GW * HD + c.tok * HD + ((c.cp ^ fV(c.tok)) << 3);
    const bf16* qsrc = c.Q + ((size_t)b * SEQ + c.tok) * D + h * HD + ((c.cp ^ fK(c.tok)) << 3);
#define NA_DMA(step) do { const int s_ = (step); const unsigned d = lds_u32(L + (s_ % NA_NS) * NA_SLOT + wid * 1024); int rq = ra + s_; rq = rq < rb ? rq : rb - 1; \
        glds16(ksrc + (size_t)s_ * GW * HD, d); glds16(vsrc + (size_t)s_ * GW * HD, d + 8192u); glds16(qsrc + (size_t)rq * GW * D, d + 16384u); } while (0)
    ATT_BAR();
    for (int t = 0; t < NA_PD; ++t) NA_DMA(t);
    na_table(c, h);
    Item it[4]; int tbi[4]; f32x4 mk[2][2];
#pragma unroll
    for (int i = 0; i < 4; ++i) { f32x4 dummy[2]; na_item_cols(i, fr, fq, lane, it[i], tbi[i], (i == 0 || i == 3) ? mk[i == 3] : dummy); item_init(it[i], -1e30f, 0.f); it[i].q0 = it[i].q1 = (bf16x8){0, 0, 0, 0, 0, 0, 0, 0}; }
    __builtin_amdgcn_s_waitcnt(0x0F70);
    for (int t = 0; t < nt; ++t) {
        if (t + NA_PD < nt) NA_DMA(t + NA_PD);
        const int j = t - wid, ph = j & 7, r = ra + t - ph;
        wait_vm(3 * (nt - 1 - t < NA_PD ? nt - 1 - t : NA_PD));
        ATT_BAR();
        if (j >= 0 && r < rb) {
            lptr slot = (lptr)(L + (t % NA_NS) * NA_SLOT);
            if (ph == 0) {
#pragma unroll
                for (int i = 0; i < 4; ++i) { const int rk = i * 16 + fr; lptr qp = slot + 16384 + rk * 128; const int sw = fq ^ fK(rk);
                    it[i].q0 = *(const LAS bf16x8*)(qp + (sw << 4)); it[i].q1 = *(const LAS bf16x8*)(qp + ((sw ^ 4) << 4)); item_init(it[i], -1e30f, 0.f); }
            }
            const LAS float* tbr = tb + (ph + 3) * 64;
#pragma unroll
            for (int i = 0; i < 4; ++i) { const LAS float* bp = tbr + tbi[i] + ((i == 1 || i == 2) ? 15 * 64 : 0); f32x4 b0, b1;
#pragma unroll
                for (int e = 0; e < 4; ++e) { b0[e] = bp[e]; b1[e] = bp[16 + e]; if (i == 0 || i == 3) { b0[e] += mk[i == 3][0][e]; b1[e] += mk[i == 3][1][e]; } }
                half_step(it[i], slot, b0, b1);
                if (i == 1) __builtin_amdgcn_sched_barrier(0); }
            if (ph == 7) {
#pragma unroll
                for (int i = 0; i < 4; ++i) item_store(it[i], c.O + ((size_t)b * SEQ + (size_t)r * GW + i * 16 + fr) * D + h * HD, lane);
            }
        }
    }
#undef NA_DMA
    __builtin_amdgcn_s_waitcnt(0x0F70);
}
__device__ __forceinline__ void na_phase(LAS unsigned char* L, const bf16* Q, const bf16* Kh, const bf16* Vh, bf16* O, const float* rpb, int vcu, int G) {
    NaCtx c; c.L = L; c.Q = Q; c.Kh = Kh; c.Vh = Vh; c.O = O; c.rpb = rpb; c.tid = threadIdx.x; c.lane = c.tid & 63; c.wid = __builtin_amdgcn_readfirstlane(c.tid >> 6); c.fr = c.lane & 15; c.fq = c.lane >> 4;
    c.tok = c.wid * 8 + (c.lane >> 3); c.cp = c.lane & 7;
    for (int task = vcu; task < BATCH * NH * 4; task += G) {
        const int qd = task & 3, h = (task >> 2) % NH, b = task / (4 * NH);
        if (qd == 0) na_edge(c, b, h, 0, 0);
        na_strip(c, b, h, qd == 0 ? 4 : 32 * qd, qd == 3 ? ROWS - 4 : 32 * qd + 32);
        if (qd == 3) na_edge(c, b, h, ROWS - 4, ROWS - KR);
    }
}

constexpr int SW_SLOT = 16384, SW_NS = 7, SW_TBL = SW_NS * SW_SLOT;
__device__ __forceinline__ void swa_phase(LAS unsigned char* L, const bf16* Q, const bf16* Kh, const bf16* Vh, bf16* O, const float* tblg, int vcu, int G) {
    const int tid = threadIdx.x, lane = tid & 63, wid = __builtin_amdgcn_readfirstlane(tid >> 6), fr = lane & 15, fq = lane >> 4;
    LAS float* tb = (LAS float*)(L + SW_TBL);
    const int tok = wid * 8 + (lane >> 3), cp = lane & 7;
    constexpr int NQB = SEQ / 64, QPT = 8, NTASK = BATCH * KVH * (NQB / QPT);
    for (int task = vcu; task < NTASK; task += G) {
        const int q0 = (task % (NQB / QPT)) * QPT, kv = (task / (NQB / QPT)) % KVH, b = task / (NQB / QPT * KVH);
        const size_t plane = ((size_t)(b * KVH + kv) * SEQ) * HD;
        const bf16* ksrc = Kh + plane + tok * HD + ((cp ^ fK(tok)) << 3); const bf16* vsrc = Vh + plane + tok * HD + ((cp ^ fV(tok)) << 3);
        const int cmax = q0 + QPT + 1 > NQB - 1 ? NQB - 1 : q0 + QPT + 1;
#define SW_DMA(ch) do { const int c_ = (ch); if (c_ >= 0 && c_ <= cmax) { const unsigned d = lds_u32(L + (c_ % SW_NS) * SW_SLOT + wid * 1024); glds16(ksrc + (size_t)c_ * 64 * HD, d); glds16(vsrc + (size_t)c_ * 64 * HD, d + 8192u); } } while (0)
        ATT_BAR();
        for (int ch = q0 - 2; ch <= q0 + 3; ++ch) SW_DMA(ch);
        for (int i = tid; i < 4 * 384; i += 512) { const int g = i / 384, rel = i % 384 - 192; tb[i] = (rel >= -WINDOW && rel <= WINDOW) ? tblg[(kv * 4 + g) * 257 + rel + WINDOW] : NEG; }
        const int g = wid >> 1, hq = kv * 4 + g; const float sink2 = tblg[16 * 257 + hq];
        Item it[2]; int tbi[2]; bf16x8 qn[2][2];
        const bf16* qbase = Q + ((size_t)b * SEQ + fr) * D + hq * HD + 8 * fq;
#pragma unroll
        for (int i = 0; i < 2; ++i) { const int qt = 2 * (wid & 1) + i; const bf16* qp = qbase + (size_t)(64 * q0 + 16 * qt) * D;
            qn[i][0] = *(const bf16x8*)qp; qn[i][1] = *(const bf16x8*)(qp + 32);
            item_addr(it[i], 0, lane); tbi[i] = g * 384 + 192 + 4 * fq - 16 * qt - fr; }
        __builtin_amdgcn_s_waitcnt(0x0F70);
        for (int qb = q0; qb < q0 + QPT; ++qb) {
            ATT_BAR();
            if (qb > q0) SW_DMA(qb + 3);
#pragma unroll
            for (int i = 0; i < 2; ++i) { it[i].q0 = qn[i][0]; it[i].q1 = qn[i][1]; item_init(it[i], sink2, fq == 0 ? 1.f : 0.f); }
            if (qb + 1 < q0 + QPT) {
#pragma unroll
                for (int i = 0; i < 2; ++i) { const int qt = 2 * (wid & 1) + i; const bf16* qp = qbase + (size_t)(64 * (qb + 1) + 16 * qt) * D; qn[i][0] = *(const bf16x8*)qp; qn[i][1] = *(const bf16x8*)(qp + 32); }
            }
            const int clo = qb - 2 < 0 ? 0 : qb - 2, chi_ = qb + 2 > NQB - 1 ? NQB - 1 : qb + 2;
#ifdef PROBE_SW
            unsigned long long pt0 = 0, pc0 = 0; if (qb == q0 + 3) { pt0 = __builtin_amdgcn_s_memrealtime(); pc0 = __builtin_amdgcn_s_memtime(); }
#endif
            for (int cb = clo; cb <= chi_; ++cb) {
                lptr slot = (lptr)(L + (cb % SW_NS) * SW_SLOT);
#pragma unroll
                for (int hs = 0; hs < 2; ++hs)
#pragma unroll
                    for (int i = 0; i < 2; ++i) { const int qt = 2 * (wid & 1) + i, k0 = 64 * cb + 32 * hs, tq0 = 64 * qb + 16 * qt;
                        if (k0 + 31 >= tq0 - WINDOW && k0 <= tq0 + 15 + WINDOW) {
                            const LAS float* bp = tb + tbi[i] + 64 * (cb - qb) + 32 * hs; f32x4 b0, b1;
#pragma unroll
                            for (int e = 0; e < 4; ++e) { b0[e] = bp[e]; b1[e] = bp[16 + e]; }
                            half_step(it[i], slot + hs * 4096, b0, b1); } }
            }
#ifdef PROBE_SW
            if (qb == q0 + 3) { asm volatile("" :: "v"(it[0].o0), "v"(it[1].o0)); const unsigned long long pt1 = __builtin_amdgcn_s_memrealtime(), pc1 = __builtin_amdgcn_s_memtime();
                if (blockIdx.x == 0 && tid == 0 && task == vcu) { volatile LAS unsigned* MI = (volatile LAS unsigned*)(L + 131072 + 320); MI[40] = (unsigned)(pt1 - pt0); MI[41] = (unsigned)(pc1 - pc0); } }
#endif
#pragma unroll
            for (int i = 0; i < 2; ++i) { const int qt = 2 * (wid & 1) + i; item_store(it[i], O + ((size_t)b * SEQ + (size_t)qb * 64 + qt * 16 + fr) * D + hq * HD, lane); }
            __builtin_amdgcn_s_waitcnt(0x0F70);
        }
#undef SW_DMA
    }
}
#undef ATT_WAITV
#undef ATT_BAR
}

#ifndef PG8_SP2
#define PG8_SP2 true
#endif
#ifndef PG8_ALIGN
#define PG8_ALIGN true
#endif
#ifndef MK_N_LAUNCHES
#define MK_N_LAUNCHES 1
#endif
constexpr int NWAVES = 8;
constexpr int RING_OFF = 0, RING_BYTES = 131072, LDSCTL_OFF = RING_BYTES, MISC_OFF = LDSCTL_OFF + 320, LDS_BYTES = 147456;
constexpr int CW_BAR = 4096;
constexpr int NPHASE = 12;

__device__ __forceinline__ void p0_transpose_item(const float* W, const float* g, int K, int N, bf16* WT, LAS float* scr, int item, int lane) {
    const int nblk = N / 32, kb = item / nblk, nb = item % nblk, k0 = 64 * kb, n0 = 32 * nb;
    float wv[32];
#pragma unroll
    for (int i = 0; i < 32; ++i) { const int kk = 2 * i + (lane >> 5); wv[i] = W[(size_t)(k0 + kk) * N + n0 + (lane & 31)]; }
#pragma unroll
    for (int i = 0; i < 32; ++i) { const int kk = 2 * i + (lane >> 5); scr[kk * 33 + (lane & 31)] = wv[i] * (g ? g[k0 + kk] : 1.0f); }
    LDS_WAIT(); asm volatile("" ::: "memory");
    const int c = lane & 7;
#pragma unroll
    for (int j = 0; j < 4; ++j) { const int n = (lane >> 3) + 8 * j; const LAS float* s = scr + (8 * c) * 33 + n;
        v4u o; o.x = pk2(s[0 * 33], s[1 * 33]); o.y = pk2(s[2 * 33], s[3 * 33]); o.z = pk2(s[4 * 33], s[5 * 33]); o.w = pk2(s[6 * 33], s[7 * 33]);
        *(GAS v4u*)(WT + (size_t)(n0 + n) * K + k0 + 8 * c) = o; }
    LDS_WAIT(); asm volatile("" ::: "memory");
}

struct Args { const float* in[13]; float* out; unsigned char* ws; int ph_lo, ph_hi; };
__global__ void __launch_bounds__(NWAVES * 64, 2) mk_fwd(Args args) {
    extern __shared__ __attribute__((aligned(16))) unsigned char lds[];
    LAS unsigned char* L = (LAS unsigned char*)lds;
    volatile LAS unsigned* MISC = (volatile LAS unsigned*)(L + MISC_OFF);
    const int tid = threadIdx.x, lane = tid & 63, wave = __builtin_amdgcn_readfirstlane(tid >> 6);
    unsigned char* ws = args.ws;
    gu32* ctl = (gu32*)(ws + WS_CTL);
    float* ssqA = (float*)(ws + WS_SSQ); float* ssqB = (float*)(ws + WS_SSQ2); float* tblg = (float*)(ws + WS_TBL);
    bf16 *Wqkv0 = (bf16*)(ws + WS_WQKV0), *Wo0 = (bf16*)(ws + WS_WO0), *Win0 = (bf16*)(ws + WS_WIN0), *Wout0 = (bf16*)(ws + WS_WOUT0);
    bf16 *Wqkv1 = (bf16*)(ws + WS_WQKV1), *Wo1 = (bf16*)(ws + WS_WO1), *Win1 = (bf16*)(ws + WS_WIN1), *Wout1 = (bf16*)(ws + WS_WOUT1);
    bf16 *XB = (bf16*)(ws + WS_XB), *Qb = (bf16*)(ws + WS_Q), *Kb = (bf16*)(ws + WS_K), *Vb = (bf16*)(ws + WS_V), *Hb = (bf16*)(ws + WS_H);
    const float* x = args.in[0]; float* out = args.out;
    const int G = gridDim.x; int vcu; { const int bx = blockIdx.x; vcu = (G % 8 == 0) ? (bx % 8) * (G / 8) + bx / 8 : bx; }
    for (int u = tid; u < (LDS_BYTES - LDSCTL_OFF) / 4; u += NWAVES * 64) ((LAS unsigned*)(L + LDSCTL_OFF))[u] = 0u;
    __syncthreads();
    XcdBarrier bar; bar.bar = (unsigned*)(ctl + CW_BAR); bar.x = 0; bar.st = nullptr;
    if (MK_N_LAUNCHES == 1) bar = xcd_barrier_post((unsigned*)(ctl + CW_BAR), MISC + 8);
    const int lo = args.ph_lo, hi = args.ph_hi;
#define IN(k) (lo <= (k) && (k) < hi)
#ifndef PROBE_SCALE
#define PROBE_SCALE 0.01f
#endif
#ifdef PROBE_A
#define STAMP(k) do { if (blockIdx.x == 0 && tid == 0) MISC[16 + (k)] = (unsigned)__builtin_amdgcn_s_memrealtime(); } while (0)
#else
#define STAMP(k) do {} while (0)
#endif
#define SEAM(k) do { if (IN(k) && IN((k) + 1)) xcd_barrier(bar); STAMP((k) + 1); } while (0)
    STAMP(0);

    if (IN(0)) {
        LAS float* scr = (LAS float*)(L + RING_OFF + wave * 16384);
        const int gw = vcu * NWAVES + wave, NGW = G * NWAVES;
        const float *mix_norm = args.in[1], *mlp_norm = args.in[2], *w_in = args.in[11], *w_out = args.in[12];
        constexpr int I_QKV0 = (D / 64) * (3072 / 32), I_O = (D / 64) * (D / 32), I_IN = (D / 64) * (FF / 32), I_OUT = (FF / 64) * (D / 32), I_QKV1 = (D / 64) * (1536 / 32);
        constexpr int NITEMS = I_QKV0 + I_QKV1 + 2 * (I_O + I_IN + I_OUT);
        for (int it = gw; it < NITEMS; it += NGW) {
            int r = it;
            if (r < I_QKV0) { p0_transpose_item(args.in[4], mix_norm, D, 3072, Wqkv0, scr, r, lane); continue; } r -= I_QKV0;
            if (r < I_O) { p0_transpose_item(args.in[6], nullptr, D, D, Wo0, scr, r, lane); continue; } r -= I_O;
            if (r < I_IN) { p0_transpose_item(w_in, mlp_norm, D, FF, Win0, scr, r, lane); continue; } r -= I_IN;
            if (r < I_OUT) { p0_transpose_item(w_out, nullptr, FF, D, Wout0, scr, r, lane); continue; } r -= I_OUT;
            if (r < I_QKV1) { p0_transpose_item(args.in[7], mix_norm + D, D, 1536, Wqkv1, scr, r, lane); continue; } r -= I_QKV1;
            if (r < I_O) { p0_transpose_item(args.in[9], nullptr, D, D, Wo1, scr, r, lane); continue; } r -= I_O;
            if (r < I_IN) { p0_transpose_item(w_in + (size_t)D * FF, mlp_norm + D, D, FF, Win1, scr, r, lane); continue; } r -= I_IN;
            p0_transpose_item(w_out + (size_t)D * FF, nullptr, FF, D, Wout1, scr, r, lane);
        }
        for (int i = vcu * (NWAVES * 64) + tid; i < 16 * 257 + 16; i += G * NWAVES * 64) {
            if (i < 16 * 257) { const int h = i / 257, rel = i % 257 - 128; const int n = rel < 0 ? -rel : rel; int bk;
                if (n < 8) bk = n; else { const int k = (31 - __clz(n * n)) - 6; bk = 8 + (k < 7 ? k : 7); }
                if (rel > 0) bk += 16;
                tblg[i] = args.in[10][bk * 16 + h] * LOG2E; }
            else tblg[i] = args.in[8][i - 16 * 257] * LOG2E;
        }
        for (int m0 = gw * 4; m0 < M; m0 += NGW * 4) {
            f32x4 v[4][4];
#pragma unroll
            for (int r = 0; r < 4; ++r) { const GAS f32x4* xr = (const GAS f32x4*)(x + (size_t)(m0 + r) * D) + lane;
#pragma unroll
                for (int j = 0; j < 4; ++j) v[r][j] = xr[64 * j]; }
#pragma unroll
            for (int r = 0; r < 4; ++r) { GAS unsigned long long* o8 = (GAS unsigned long long*)(XB + (size_t)(m0 + r) * D) + lane; float s = 0.f;
#pragma unroll
                for (int j = 0; j < 4; ++j) { const f32x4 w = v[r][j]; s += (w.x * w.x + w.y * w.y) + (w.z * w.z + w.w * w.w);
                    o8[64 * j] = (unsigned long long)pk2(w.x, w.y) | ((unsigned long long)pk2(w.z, w.w) << 32); }
                s = wave_sum(s);
                if (lane < 16) ssqB[(size_t)(m0 + r) * 16 + lane] = lane == 0 ? s : 0.f; }
        }
    }
    SEAM(0);
    if (IN(1)) { pg8::Gemm g{XB, Wqkv0, M, 3072, D}; pg8::StaticOrder S; S.init(M, 3072, G, (int)blockIdx.x);
        pg8::EpiQKV E{Qb, Kb, Vb, D, C2, ssqB};
        pg8::gemm_phase<pg8::EpiQKV, pg8::StaticOrder, PG8_ALIGN, PG8_SP2>(L + RING_OFF, g, S, E); }
    SEAM(1);
#ifdef PROBE_NA
    if (IN(2)) { att::na_phase(L + RING_OFF, Qb, Kb, Vb, (bf16*)(ws + 448 * MiB), args.in[5], vcu, G); xcd_barrier(bar); STAMP(13);
                 att::na_phase(L + RING_OFF, Qb, Kb, Vb, (bf16*)(ws + 448 * MiB), args.in[5], vcu, G); xcd_barrier(bar); STAMP(14); }
#endif
    if (IN(2)) att::na_phase(L + RING_OFF, Qb, Kb, Vb, Qb, args.in[5], vcu, G);
    SEAM(2);
    if (IN(3)) { pg8::Gemm g{Qb, Wo0, M, D, D}; pg8::StaticOrder S; S.init(M, D, G, (int)blockIdx.x);
        pg8::EpiRes2<true, false, false> E{x, nullptr, XB, ssqA, nullptr};
        pg8::gemm_phase<pg8::EpiRes2<true, false, false>, pg8::StaticOrder, PG8_ALIGN, PG8_SP2>(L + RING_OFF, g, S, E); }
    SEAM(3);
    if (IN(4)) { pg8::Gemm g{XB, Win0, M, FF, D}; pg8::StaticOrder S; S.init(M, FF, G, (int)blockIdx.x);
        pg8::EpiUp E{Hb};
        pg8::gemm_phase<pg8::EpiUp, pg8::StaticOrder, PG8_ALIGN, PG8_SP2>(L + RING_OFF, g, S, E); }
    SEAM(4);
    if (IN(5)) { pg8::Gemm g{Hb, Wout0, M, D, FF}; pg8::StaticOrder S; S.init(M, D, G, (int)blockIdx.x);
        pg8::EpiRes2<false, false, true> E{nullptr, nullptr, XB, ssqB, ssqA};
        pg8::gemm_phase<pg8::EpiRes2<false, false, true>, pg8::StaticOrder, PG8_ALIGN, PG8_SP2>(L + RING_OFF, g, S, E); }
    SEAM(5);
    if (IN(6)) { pg8::Gemm g{XB, Wqkv1, M, 1536, D}; pg8::StaticOrder S; S.init(M, 1536, G, (int)blockIdx.x);
        pg8::EpiQKV E{Qb, Kb, Vb, 256, C2, ssqB};
        pg8::gemm_phase<pg8::EpiQKV, pg8::StaticOrder, PG8_ALIGN, PG8_SP2>(L + RING_OFF, g, S, E); }
    SEAM(6);
    if (IN(7)) att::swa_phase(L + RING_OFF, Qb, Kb, Vb, Qb, tblg, vcu, G);
    SEAM(7);
    if (IN(8)) { pg8::Gemm g{Qb, Wo1, M, D, D}; pg8::StaticOrder S; S.init(M, D, G, (int)blockIdx.x);
        pg8::EpiRes2<false, false, false> E{nullptr, nullptr, XB, ssqA, nullptr};
        pg8::gemm_phase<pg8::EpiRes2<false, false, false>, pg8::StaticOrder, PG8_ALIGN, PG8_SP2>(L + RING_OFF, g, S, E); }
    SEAM(8);
    if (IN(9)) { pg8::Gemm g{XB, Win1, M, FF, D}; pg8::StaticOrder S; S.init(M, FF, G, (int)blockIdx.x);
        pg8::EpiUp E{Hb};
        pg8::gemm_phase<pg8::EpiUp, pg8::StaticOrder, PG8_ALIGN, PG8_SP2>(L + RING_OFF, g, S, E); }
    SEAM(9);
    if (IN(10)) { pg8::Gemm g{Hb, Wout1, M, D, FF}; pg8::StaticOrder S; S.init(M, D, G, (int)blockIdx.x);
        pg8::EpiRes2<false, false, true> E{nullptr, nullptr, XB, ssqB, ssqA};
        pg8::gemm_phase<pg8::EpiRes2<false, false, true>, pg8::StaticOrder, PG8_ALIGN, PG8_SP2>(L + RING_OFF, g, S, E); }
    SEAM(10);
    if (IN(11)) {
        const int gw = vcu * NWAVES + wave, NGW = G * NWAVES; const GAS f32x4* gr = (const GAS f32x4*)args.in[3] + lane;
        const f32x4 g0 = gr[0], g1 = gr[64], g2 = gr[128], g3 = gr[192];
        for (int m0 = gw * 4; m0 < M; m0 += NGW * 4) {
            unsigned long long w[4][4]; float r[4];
#pragma unroll
            for (int q = 0; q < 4; ++q) { const GAS unsigned long long* xr = (const GAS unsigned long long*)(XB + (size_t)(m0 + q) * D) + lane; r[q] = pg8::rstd16(ssqB, m0 + q);
                w[q][0] = xr[0]; w[q][1] = xr[64]; w[q][2] = xr[128]; w[q][3] = xr[192]; }
#pragma unroll
            for (int q = 0; q < 4; ++q) { GAS f32x4* xo = (GAS f32x4*)(out + (size_t)(m0 + q) * D) + lane;
#pragma unroll
                for (int j = 0; j < 4; ++j) { const unsigned lo = (unsigned)w[q][j], hi = (unsigned)(w[q][j] >> 32);
                    const f32x4 v = (f32x4){__builtin_bit_cast(float, lo << 16), __builtin_bit_cast(float, lo & 0xffff0000u), __builtin_bit_cast(float, hi << 16), __builtin_bit_cast(float, hi & 0xffff0000u)};
                    const f32x4 gg = j == 0 ? g0 : j == 1 ? g1 : j == 2 ? g2 : g3; xo[64 * j] = v * r[q] * gg; } }
        }
    }
#ifdef PROBE_A
    xcd_barrier(bar); STAMP(12);
    if (blockIdx.x == 0) { __syncthreads();
        #if defined(PROBE_GEMM)
        const float ta = (float)MISC[40] * 0.01f, tb2 = (float)MISC[41] * 0.001f;
#elif defined(PROBE_SW)
        const float ta = (float)MISC[40] * 0.01f, tb2 = (float)MISC[41] * 0.001f;
#elif defined(PROBE_NA)
        const float ta = (float)(MISC[16 + 13] - MISC[16 + 2]) * 0.01f, tb2 = (float)(MISC[16 + 14] - MISC[16 + 13]) * 0.01f;
#else
        const float ta = (float)(MISC[16 + PROBE_A + 1] - MISC[16 + PROBE_A]) * 0.01f, tb2 = (float)(MISC[16 + PROBE_B + 1] - MISC[16 + PROBE_B]) * 0.01f;
#endif
        if (tid == 0) out[0] += ta * PROBE_SCALE;
        out[D + tid] += tb2 * PROBE_SCALE; out[D + 512 + tid] += tb2 * PROBE_SCALE; }
#endif
#undef IN
#undef SEAM
}

extern "C" void kernel_launch(void* const* d_in, const int* in_sizes, int n_in, void* d_out, int out_size, void* d_ws, size_t ws_size, hipStream_t stream) {
    static int grid = 0;
    if (grid == 0) {
        if (n_in != 13 || in_sizes[0] != M * D || out_size != M * D || ws_size < WS_END) { fprintf(stderr, "kernel_launch: unexpected shapes (n_in %d in0 %d out %d ws %zu)\n", n_in, n_in > 0 ? in_sizes[0] : -1, out_size, ws_size); grid = -1; return; }
        int dev = 0, cus = 0, per_cu = 0;
        if (hipGetDevice(&dev) != hipSuccess || hipDeviceGetAttribute(&cus, hipDeviceAttributeMultiprocessorCount, dev) != hipSuccess) { grid = -1; return; }
        if (hipFuncSetAttribute((const void*)mk_fwd, hipFuncAttributeMaxDynamicSharedMemorySize, LDS_BYTES) != hipSuccess) { fprintf(stderr, "kernel_launch: hipFuncSetAttribute failed\n"); grid = -1; return; }
        if (hipOccupancyMaxActiveBlocksPerMultiprocessor(&per_cu, (const void*)mk_fwd, NWAVES * 64, LDS_BYTES) != hipSuccess || per_cu < 1) { fprintf(stderr, "kernel_launch: occupancy query says %d blocks per CU\n", per_cu); grid = -1; (void)hipGetLastError(); return; }
        (void)hipGetLastError();
        grid = cus;
    }
    if (grid < 0) return;
    (void)hipMemsetAsync((unsigned char*)d_ws + WS_CTL, 0, 1 * MiB, stream);
    Args a{}; for (int i = 0; i < 13; ++i) a.in[i] = (const float*)d_in[i]; a.out = (float*)d_out; a.ws = (unsigned char*)d_ws;
#if MK_N_LAUNCHES == 1
    a.ph_lo = 0; a.ph_hi = NPHASE; hipLaunchKernelGGL(mk_fwd, dim3(grid), dim3(NWAVES * 64), LDS_BYTES, stream, a);
#else
    for (int p = 0; p < NPHASE; ++p) { a.ph_lo = p; a.ph_hi = p + 1; hipLaunchKernelGGL(mk_fwd, dim3(grid), dim3(NWAVES * 64), LDS_BYTES, stream, a); }
#endif
}
```

```cpp
#include <hip/hip_runtime.h>
#include <cstdint>
#include <cstdio>

typedef unsigned short bf16;
constexpr int BATCH = 4, SEQ = 8192, D = 1024, NH = 16, HD = 64, KVH = 4, FF = 4096, M = BATCH * SEQ;
constexpr int GW = 64, ROWS = SEQ / GW, KR = 8, KC = 16, WINDOW = 128;
constexpr float EPS = 1e-6f, LOG2E = 1.4426950408889634f, C2 = 0.125f * LOG2E;
constexpr size_t MiB = 1u << 20;
constexpr size_t WS_CTL = 0, WS_SSQ = 1 * MiB, WS_TBL = 3 * MiB, WS_SSQ2 = 50 * MiB;
constexpr size_t WS_WQKV0 = 4 * MiB, WS_WO0 = 10 * MiB, WS_WIN0 = 12 * MiB, WS_WOUT0 = 20 * MiB, WS_WQKV1 = 28 * MiB, WS_WO1 = 31 * MiB, WS_WIN1 = 33 * MiB, WS_WOUT1 = 41 * MiB;
constexpr size_t WS_XB = 64 * MiB, WS_Q = 128 * MiB, WS_K = 192 * MiB, WS_V = 256 * MiB, WS_H = 128 * MiB, WS_END = 384 * MiB;

__device__ __forceinline__ unsigned f2bf(float f) { unsigned u = __builtin_bit_cast(unsigned, f); return (u + 0x7fffu + ((u >> 16) & 1u)) >> 16; }
__device__ __forceinline__ float bf2f(bf16 b) { return __builtin_bit_cast(float, (unsigned)b << 16); }
__device__ __forceinline__ float wave_sum(float v) {
#pragma unroll
    for (int o = 1; o < 64; o <<= 1) v += __shfl_xor(v, o);
    return v;
}
__device__ __forceinline__ float row_rstd(const float* ssq, int row) {
    const float4* p = (const float4*)(ssq + (size_t)row * 16);
    float4 a = p[0], b = p[1], c = p[2], d = p[3];
    float s = ((a.x + a.y) + (a.z + a.w)) + ((b.x + b.y) + (b.z + b.w)) + ((c.x + c.y) + (c.z + c.w)) + ((d.x + d.y) + (d.z + d.w));
    return 1.0f / sqrtf(s * (1.0f / D) + EPS);
}


namespace pg8 {
#define PG8_LAS __attribute__((address_space(3)))
typedef unsigned short bf16_t;
typedef short bf16x8 __attribute__((ext_vector_type(8)));
typedef float f32x4 __attribute__((ext_vector_type(4)));
typedef unsigned u32x4 __attribute__((ext_vector_type(4)));
constexpr int BM = 256, BK = 64, HALF = 128, HTB = HALF * BK * 2  , STAGE_BYTES = 8 * HTB, NXCD = 8, WGM = 8;

__host__ __device__ __forceinline__ int lds_byte(int r, int c) { const int st = (r >> 4) * 2 + (c >> 5), rr = r & 15, cc = c & 31, ob = rr * 64 + cc * 2; return st * 1024 + (ob ^ (((ob >> 9) & 1) << 5)); }
__host__ __device__ __forceinline__ void stage_rc(int b, int& R, int& C) { const int st = b / 1024, sb = b % 1024, swz = sb ^ (((sb >> 9) & 1) << 5); R = (st >> 1) * 16 + swz / 64; C = (st & 1) * 32 + (swz % 64) / 2; }
__host__ __device__ __forceinline__ int perm32(int rho) { const int n = rho >> 4, i = rho & 15; return 8 * (i >> 2) + 4 * n + (i & 3); }

struct Unit { int pm, pn; };
struct Gemm { const bf16_t* A; const bf16_t* Bt; int M, N, K; };

struct StaticOrder {
    int nM, nN, nwg, G, c;
    __host__ __device__ void init(int M, int N, int G_, int c_) { nM = M / BM; nN = N / BM; nwg = nM * nN; G = G_; c = c_; }
    __host__ __device__ bool next(int i, Unit& u) const {
        const long L = (long)i * G + c; if (L >= nwg) return false;
        int wgid = (int)L; { const int q = nwg / NXCD, r = nwg % NXCD, xcd = wgid % NXCD, off = wgid / NXCD; wgid = (xcd < r ? xcd * (q + 1) : r * (q + 1) + (xcd - r) * q) + off; }
        const int nig = WGM * nN, gid = wgid / nig, fm = gid * WGM, gsz = (nM - fm) < WGM ? (nM - fm) : WGM;
        u.pm = fm + ((wgid % nig) % gsz); u.pn = (wgid % nig) / gsz; return true;
    }
    __device__ __forceinline__ void a_ready(const Unit&) const {}
    __device__ __forceinline__ void done(const Unit&) const {}
};

__device__ __forceinline__ unsigned cvt_pk_bf16(float lo, float hi) { unsigned r; asm volatile("v_cvt_pk_bf16_f32 %0, %1, %2" : "=v"(r) : "v"(lo), "v"(hi)); return r; }
typedef float f32x2 __attribute__((ext_vector_type(2)));
__device__ __forceinline__ float rstd16(const float* ssq, int row) {
    const f32x4* p = (const f32x4*)(ssq + (size_t)row * 16);
    const f32x4 a = p[0], b = p[1], c = p[2], d = p[3];
    const float s = (((a[0] + a[1]) + (a[2] + a[3])) + ((b[0] + b[1]) + (b[2] + b[3]))) + (((c[0] + c[1]) + (c[2] + c[3])) + ((d[0] + d[1]) + (d[2] + d[3])));
    return __builtin_amdgcn_rsqf(s * (1.0f / 1024.0f) + 1e-6f);
}
__device__ __forceinline__ float row_ssq_q(const float* ssq, int row, int fq) {
    const f32x4 a = *(const f32x4*)(ssq + (size_t)row * 16 + 4 * fq);
    float s = (a[0] + a[1]) + (a[2] + a[3]); s += __shfl_xor(s, 16); s += __shfl_xor(s, 32); return s;
}
struct EpiQKV {
    static constexpr bool PERM = true, AFTER_DRAIN = false;
    bf16_t *Q, *Kp, *V; int kvw; float qscale; const float* ssq;
    __device__ __forceinline__ void operator()(const f32x4 (&acc)[2][2][4][2], const Unit& u, int wr, int wc, int fr, int fq) const {
        int colt = u.pn * BM; bf16_t* base; float sc = 1.f; bool hm = true;
        if (colt < 1024) { base = Q; sc = qscale; hm = false; } else if (colt < 1024 + kvw) { base = Kp; colt -= 1024; } else { base = V; colt -= 1024 + kvw; }
        const int col0 = colt + wc * 32 + 8 * fq, row0 = u.pm * BM + wr * 64 + fr, nhk = kvw >> 6;
#pragma unroll
        for (int ai = 0; ai < 2; ++ai)
#pragma unroll
            for (int m = 0; m < 4; ++m) { const int row = row0 + ai * HALF + m * 16; const float rs = __builtin_amdgcn_rsqf(row_ssq_q(ssq, row, fq) * (1.0f / 1024.0f) + 1e-6f) * sc; const int bb = row >> 13, tk = row & 8191;
#pragma unroll
                for (int bj = 0; bj < 2; ++bj) { const f32x4 v0 = acc[ai][bj][m][0] * rs, v1 = acc[ai][bj][m][1] * rs; const int cc = col0 + bj * HALF;
                    u32x4 w; w.x = cvt_pk_bf16(v0[0], v0[1]); w.y = cvt_pk_bf16(v0[2], v0[3]); w.z = cvt_pk_bf16(v1[0], v1[1]); w.w = cvt_pk_bf16(v1[2], v1[3]);
                    bf16_t* p = hm ? base + ((size_t)(bb * nhk + (cc >> 6)) * 8192 + tk) * 64 + (cc & 63) : base + (size_t)row * 1024 + cc;
                    *(u32x4*)p = w; } }
    }
};
struct EpiUp {
    static constexpr bool PERM = true, AFTER_DRAIN = false;
    bf16_t* Hh;
    __device__ __forceinline__ void operator()(const f32x4 (&acc)[2][2][4][2], const Unit& u, int wr, int wc, int fr, int fq) const {
        const int col0 = u.pn * BM + wc * 32 + 8 * fq, row0 = u.pm * BM + wr * 64 + fr;
#pragma unroll
        for (int ai = 0; ai < 2; ++ai)
#pragma unroll
            for (int m = 0; m < 4; ++m) { const int row = row0 + ai * HALF + m * 16; bf16_t* rowp = Hh + (size_t)row * 4096 + col0;
#pragma unroll
                for (int bj = 0; bj < 2; ++bj) { f32x4 v0 = acc[ai][bj][m][0], v1 = acc[ai][bj][m][1];
#pragma unroll
                    for (int e = 0; e < 4; ++e) { const float a = __builtin_fmaxf(v0[e], 0.f), b = __builtin_fmaxf(v1[e], 0.f); v0[e] = a * a; v1[e] = b * b; }
                    u32x4 w; w.x = cvt_pk_bf16(v0[0], v0[1]); w.y = cvt_pk_bf16(v0[2], v0[3]); w.z = cvt_pk_bf16(v1[0], v1[1]); w.w = cvt_pk_bf16(v1[2], v1[3]);
                    *(u32x4*)(rowp + bj * HALF) = w; } }
    }
};
struct EpiRes {
    static constexpr bool PERM = false, AFTER_DRAIN = false;
    const float* base; float* out; bf16_t* xb; float* ssq;
    __device__ __forceinline__ void operator()(const f32x4 (&acc)[2][2][4][2], const Unit& u, int wr, int wc, int fr, int fq) const {
        typedef unsigned u32x2v __attribute__((ext_vector_type(2)));
        const int col0 = u.pn * BM + wc * 32 + 4 * fq, row0 = u.pm * BM + wr * 64 + fr;
#pragma unroll
        for (int ai = 0; ai < 2; ++ai)
#pragma unroll
            for (int m = 0; m < 4; ++m) { const int row = row0 + ai * HALF + m * 16; const size_t off = (size_t)row * 1024 + col0; float s = 0.f;
#pragma unroll
                for (int bj = 0; bj < 2; ++bj)
#pragma unroll
                    for (int n = 0; n < 2; ++n) { const f32x4 bs = *(const f32x4*)(base + off + bj * HALF + n * 16); const f32x4 o = bs + acc[ai][bj][m][n];
                        *(f32x4*)(out + off + bj * HALF + n * 16) = o; s += (o[0] * o[0] + o[1] * o[1]) + (o[2] * o[2] + o[3] * o[3]);
                        u32x2v w; w.x = cvt_pk_bf16(o[0], o[1]); w.y = cvt_pk_bf16(o[2], o[3]); *(u32x2v*)(xb + off + bj * HALF + n * 16) = w; }
                s += __shfl_xor(s, 16); s += __shfl_xor(s, 32);
                if (fq == 0) ssq[(size_t)row * 16 + u.pn * 4 + wc] = s; }
    }
};
template <bool BASE_F32, bool OUT_F32, bool RSQ> struct EpiRes2 {
    static constexpr bool PERM = true, AFTER_DRAIN = false;
    const float* basef; float* outf; bf16_t* xb; float* ssq; const float* ssq_in;
    __device__ __forceinline__ void operator()(const f32x4 (&acc)[2][2][4][2], const Unit& u, int wr, int wc, int fr, int fq) const {
        const int col0 = u.pn * BM + wc * 32 + 8 * fq, row0 = u.pm * BM + wr * 64 + fr;
#pragma unroll
        for (int ai = 0; ai < 2; ++ai)
#pragma unroll
            for (int m = 0; m < 4; ++m) { const int row = row0 + ai * HALF + m * 16; const size_t off = (size_t)row * 1024 + col0; float s = 0.f;
                float r2 = 1.f; if (RSQ) r2 = 1.0f / (row_ssq_q(ssq_in, row, fq) * (1.0f / 1024.0f) + 1e-6f);
#pragma unroll
                for (int bj = 0; bj < 2; ++bj) { f32x4 b0, b1;
                    if (BASE_F32) { b0 = *(const f32x4*)(basef + off + bj * HALF); b1 = *(const f32x4*)(basef + off + bj * HALF + 4); }
                    else { const u32x4 w = *(const u32x4*)(xb + off + bj * HALF);
                        b0 = (f32x4){__builtin_bit_cast(float, w.x << 16), __builtin_bit_cast(float, w.x & 0xffff0000u), __builtin_bit_cast(float, w.y << 16), __builtin_bit_cast(float, w.y & 0xffff0000u)};
                        b1 = (f32x4){__builtin_bit_cast(float, w.z << 16), __builtin_bit_cast(float, w.z & 0xffff0000u), __builtin_bit_cast(float, w.w << 16), __builtin_bit_cast(float, w.w & 0xffff0000u)}; }
                    const f32x4 o0 = b0 + acc[ai][bj][m][0] * r2, o1 = b1 + acc[ai][bj][m][1] * r2;
                    s += ((o0[0] * o0[0] + o0[1] * o0[1]) + (o0[2] * o0[2] + o0[3] * o0[3])) + ((o1[0] * o1[0] + o1[1] * o1[1]) + (o1[2] * o1[2] + o1[3] * o1[3]));
                    if (OUT_F32) { *(f32x4*)(outf + off + bj * HALF) = o0; *(f32x4*)(outf + off + bj * HALF + 4) = o1; }
                    else { u32x4 w; w.x = cvt_pk_bf16(o0[0], o0[1]); w.y = cvt_pk_bf16(o0[2], o0[3]); w.z = cvt_pk_bf16(o1[0], o1[1]); w.w = cvt_pk_bf16(o1[2], o1[3]); *(u32x4*)(xb + off + bj * HALF) = w; } }
                s += __shfl_xor(s, 16); s += __shfl_xor(s, 32);
                if (fq == 0) ssq[(size_t)row * 16 + u.pn * 4 + wc] = s; }
    }
};
template <class Epi, class Sched, bool ALIGN_EPI = false, bool SP2 = false>
__device__ __forceinline__ void gemm_phase(PG8_LAS unsigned char* lds, const Gemm g, const Sched& S, const Epi& E) {
    const int tid = threadIdx.x, wid = __builtin_amdgcn_readfirstlane(tid >> 6), lane = tid & 63, wr = wid >> 2, wc = wid & 3, fr = lane & 15, fq = lane >> 4;
    const int K = g.K, nt = K / BK;
    unsigned voffA[2], voffB[2];
#pragma unroll
    for (int i = 0; i < 2; ++i) { int R, C; stage_rc(tid * 16 + i * 8192, R, C); const int Rb = Epi::PERM ? ((R & ~31) + perm32(R & 31)) : R;
        voffA[i] = (unsigned)(R * K + C) * 2u; voffB[i] = (unsigned)(Rb * K + C) * 2u; }
    const size_t kstep = (size_t)(BK * 2);
    const size_t hstep = (size_t)HALF * K * 2;
    const size_t tstep = 2 * hstep;
    const unsigned ldsw = (unsigned)wid * 1024u;
    const int aoff = lds_byte(wr * 64 + fr, fq * 8), boff = lds_byte(wc * 32 + fr, fq * 8);
#define PG8_SA(b, h) (((b) * 2 + (h)) * HTB)
#define PG8_SB(b, h) ((4 + (b) * 2 + (h)) * HTB)
#define PG8_STAGE(bufoff, gbase, voff) do { _Pragma("unroll") for (int _i = 0; _i < 2; ++_i) \
        __builtin_amdgcn_global_load_lds((const unsigned*)((const char*)(gbase) + (voff)[_i]), (PG8_LAS unsigned*)(lds + (bufoff) + ldsw + _i * 8192), 16, 0, 0); } while (0)
#define PG8_LDA(dst, b, h) do { _Pragma("unroll") for (int m = 0; m < 4; ++m) _Pragma("unroll") for (int k = 0; k < 2; ++k) dst[m][k] = *(const PG8_LAS bf16x8*)(lds + PG8_SA(b, h) + aoff + m * 2048 + k * 1024); } while (0)
#define PG8_LDB(dst, b, h) do { _Pragma("unroll") for (int n = 0; n < 2; ++n) _Pragma("unroll") for (int k = 0; k < 2; ++k) dst[n][k] = *(const PG8_LAS bf16x8*)(lds + PG8_SB(b, h) + boff + n * 2048 + k * 1024); } while (0)
#define PG8_MMA(ai, bj, At, Bt) do { __builtin_amdgcn_s_setprio(1); _Pragma("unroll") for (int m = 0; m < 4; ++m) _Pragma("unroll") for (int n = 0; n < 2; ++n) _Pragma("unroll") for (int k = 0; k < 2; ++k) \
        acc[ai][bj][m][n] = __builtin_amdgcn_mfma_f32_16x16x32_bf16(Bt[n][k], At[m][k], acc[ai][bj][m][n], 0, 0, 0); __builtin_amdgcn_s_setprio(0); } while (0)
#define PG8_WAIT_V(n) asm volatile("s_waitcnt vmcnt(" #n ")" ::: "memory")
#define PG8_WAIT_L(n) asm volatile("s_waitcnt lgkmcnt(" #n ")" ::: "memory")
#define PG8_BAR __builtin_amdgcn_s_barrier()
#define PG8_SCHED __builtin_amdgcn_sched_barrier(0)
    Unit cur, nxt; int ui = 0;
    if (!S.next(0, cur)) return;
    f32x4 acc[2][2][4][2];
#pragma unroll
    for (int a = 0; a < 2; ++a)
#pragma unroll
        for (int b = 0; b < 2; ++b)
#pragma unroll
            for (int m = 0; m < 4; ++m)
#pragma unroll
                for (int n = 0; n < 2; ++n) acc[a][b][m][n] = (f32x4){0.f, 0.f, 0.f, 0.f};
    bf16x8 At[4][2], B0[2][2], B1[2][2];
    const char* cA = (const char*)g.A + (size_t)cur.pm * tstep; const char* cB = (const char*)g.Bt + (size_t)cur.pn * tstep;
    S.a_ready(cur);
    if constexpr (SP2) {
        PG8_STAGE(PG8_SB(0, 0), cB, voffB); PG8_STAGE(PG8_SB(0, 1), cB + hstep, voffB); PG8_STAGE(PG8_SA(0, 0), cA, voffA); PG8_STAGE(PG8_SA(0, 1), cA + hstep, voffA);
        if (wr == 1) PG8_BAR;
        PG8_WAIT_V(2); PG8_BAR;
        PG8_STAGE(PG8_SB(1, 0), cB + kstep, voffB); PG8_STAGE(PG8_SA(1, 0), cA + kstep, voffA); PG8_STAGE(PG8_SB(1, 1), cB + hstep + kstep, voffB);
        PG8_WAIT_V(6); PG8_BAR;
    } else {
        PG8_STAGE(PG8_SB(0, 0), cB, voffB); PG8_STAGE(PG8_SA(0, 0), cA, voffA); PG8_STAGE(PG8_SB(0, 1), cB + hstep, voffB); PG8_STAGE(PG8_SA(0, 1), cA + hstep, voffA);
        if (wr == 1) PG8_BAR;
        PG8_WAIT_V(4); PG8_BAR;
        PG8_STAGE(PG8_SB(1, 0), cB + kstep, voffB); PG8_STAGE(PG8_SA(1, 0), cA + kstep, voffA); PG8_STAGE(PG8_SB(1, 1), cB + hstep + kstep, voffB);
        PG8_WAIT_V(6); PG8_BAR;
    }
    for (;;) {
        const bool has_next = S.next(ui + 1, nxt);
        const char* nA = has_next ? (const char*)g.A + (size_t)nxt.pm * tstep : cA; const char* nB = has_next ? (const char*)g.Bt + (size_t)nxt.pn * tstep : cB;
#ifdef PROBE_GEMM
        unsigned long long pg_t0 = __builtin_amdgcn_s_memrealtime(), pg_c0 = __builtin_amdgcn_s_memtime();
#endif
        for (int t = 0; t < nt; t += 2) {
            const bool last = (t == nt - 2);
            const char* a1 = cA + (size_t)(t + 1) * kstep;
            const char* a2 = last ? nA : cA + (size_t)(t + 2) * kstep; const char* b2 = last ? nB : cB + (size_t)(t + 2) * kstep;
            const char* a3 = a2 + kstep; const char* b3 = b2 + kstep;
            if (last && has_next) S.a_ready(nxt);
            if constexpr (SP2) {
            PG8_LDB(B0, 0, 0); PG8_LDB(B1, 0, 1); PG8_SCHED; PG8_LDA(At, 0, 0); PG8_STAGE(PG8_SA(1, 1), a1 + hstep, voffA);
            PG8_WAIT_V(8); PG8_WAIT_L(0); PG8_BAR; PG8_MMA(0, 0, At, B0); PG8_MMA(0, 1, At, B1); PG8_BAR; PG8_SCHED;
            PG8_LDA(At, 0, 1); PG8_STAGE(PG8_SB(0, 0), b2, voffB); PG8_STAGE(PG8_SB(0, 1), b2 + hstep, voffB); PG8_STAGE(PG8_SA(0, 0), a2, voffA);
            PG8_WAIT_V(8); PG8_WAIT_L(0); PG8_BAR; PG8_MMA(1, 0, At, B0); PG8_MMA(1, 1, At, B1); PG8_BAR; PG8_SCHED;
            PG8_LDB(B0, 1, 0); PG8_LDB(B1, 1, 1); PG8_SCHED; PG8_LDA(At, 1, 0); PG8_STAGE(PG8_SA(0, 1), a2 + hstep, voffA);
            PG8_WAIT_V(8); PG8_WAIT_L(0); PG8_BAR; PG8_MMA(0, 0, At, B0); PG8_MMA(0, 1, At, B1); PG8_BAR; PG8_SCHED;
            PG8_LDA(At, 1, 1); PG8_STAGE(PG8_SB(1, 0), b3, voffB); PG8_STAGE(PG8_SB(1, 1), b3 + hstep, voffB); PG8_STAGE(PG8_SA(1, 0), a3, voffA);
            PG8_WAIT_V(8); PG8_WAIT_L(0); PG8_BAR; PG8_MMA(1, 0, At, B0); PG8_MMA(1, 1, At, B1); PG8_BAR; PG8_SCHED;
            } else {
            PG8_LDB(B0, 0, 0); PG8_SCHED; PG8_LDA(At, 0, 0); PG8_STAGE(PG8_SA(1, 1), a1 + hstep, voffA);
            PG8_WAIT_L(8); PG8_BAR; PG8_WAIT_L(0); PG8_MMA(0, 0, At, B0); PG8_BAR; PG8_SCHED;
            PG8_LDB(B1, 0, 1); PG8_STAGE(PG8_SB(0, 0), b2, voffB);
            PG8_BAR; PG8_WAIT_L(0); PG8_MMA(0, 1, At, B1); PG8_BAR;
            PG8_LDA(At, 0, 1); PG8_STAGE(PG8_SA(0, 0), a2, voffA);
            PG8_BAR; PG8_WAIT_L(0); PG8_MMA(1, 0, At, B0); PG8_BAR; PG8_SCHED;
            PG8_STAGE(PG8_SB(0, 1), b2 + hstep, voffB);
            PG8_WAIT_V(6); PG8_BAR; PG8_MMA(1, 1, At, B1); PG8_BAR;
            PG8_LDB(B0, 1, 0); PG8_SCHED; PG8_LDA(At, 1, 0); PG8_STAGE(PG8_SA(0, 1), a2 + hstep, voffA);
            PG8_WAIT_L(8); PG8_BAR; PG8_WAIT_L(0); PG8_MMA(0, 0, At, B0); PG8_BAR; PG8_SCHED;
            PG8_LDB(B1, 1, 1); PG8_STAGE(PG8_SB(1, 0), b3, voffB);
            PG8_BAR; PG8_WAIT_L(0); PG8_MMA(0, 1, At, B1); PG8_BAR;
            PG8_LDA(At, 1, 1); PG8_STAGE(PG8_SA(1, 0), a3, voffA);
            PG8_BAR; PG8_WAIT_L(0); PG8_MMA(1, 0, At, B0); PG8_BAR; PG8_SCHED;
            PG8_STAGE(PG8_SB(1, 1), b3 + hstep, voffB);
            PG8_WAIT_V(6); PG8_BAR; PG8_MMA(1, 1, At, B1); PG8_BAR;
            }
        }
#ifdef PROBE_GEMM
        unsigned long long pg_t1 = __builtin_amdgcn_s_memrealtime(), pg_c1 = __builtin_amdgcn_s_memtime();
#endif
        if constexpr (ALIGN_EPI) { if (wr == 0) PG8_BAR; }
        if constexpr (!Epi::AFTER_DRAIN) { E(acc, cur, wr, wc, fr, fq); S.done(cur); }
        if (!has_next) break;
#pragma unroll
        for (int a = 0; a < 2; ++a)
#pragma unroll
            for (int b = 0; b < 2; ++b)
#pragma unroll
                for (int m = 0; m < 4; ++m)
#pragma unroll
                    for (int n = 0; n < 2; ++n) acc[a][b][m][n] = (f32x4){0.f, 0.f, 0.f, 0.f};
#ifdef PROBE_GEMM
        if (ui == 1 && g.N == PROBE_GEMM && blockIdx.x == 0 && tid == 0) { volatile PG8_LAS unsigned* MI = (volatile PG8_LAS unsigned*)(lds + 131072 + 320); MI[40] = (unsigned)(pg_t1 - pg_t0); MI[41] = (unsigned)(pg_c1 - pg_c0); }
#endif
        cur = nxt; cA = nA; cB = nB; ++ui;
        if constexpr (ALIGN_EPI) { if (wr == 1) PG8_BAR; }
    }
    PG8_WAIT_V(0);
    if constexpr (!ALIGN_EPI) { if (wr == 0) PG8_BAR; }
    PG8_BAR;
    if constexpr (Epi::AFTER_DRAIN) { E.fused(acc, cur, wr, wc, fr, fq, lds, wid, lane); S.done(cur); }
#undef PG8_SA
#undef PG8_SB
#undef PG8_STAGE
#undef PG8_LDA
#undef PG8_LDB
#undef PG8_MMA
#undef PG8_WAIT_V
#undef PG8_WAIT_L
#undef PG8_BAR
#undef PG8_SCHED
}
}

#define GAS __attribute__((address_space(1)))
#define LAS __attribute__((address_space(3)))
typedef unsigned v4u __attribute__((ext_vector_type(4)));
typedef float f32x4 __attribute__((ext_vector_type(4)));
typedef short bf16x8 __attribute__((ext_vector_type(8)));
typedef GAS unsigned gu32;
typedef GAS unsigned long long gu64;
#define RLX_AGENT __ATOMIC_RELAXED, __HIP_MEMORY_SCOPE_AGENT
#define LDS_WAIT() asm volatile("s_waitcnt lgkmcnt(0)" ::: "memory")
#define VM_WAIT() asm volatile("s_waitcnt vmcnt(0)" ::: "memory")
__device__ __forceinline__ unsigned long long rt() { return __builtin_amdgcn_s_memrealtime(); }
__device__ __forceinline__ unsigned pk2(float lo, float hi) { return f2bf(lo) | (f2bf(hi) << 16); }

#define XB_TMO      128
#define XB_XCNT(j)  (256  + 64 * (j))
#define XB_XSUB(j)  (1280 + 64 * (j))
#define XB_XGEN(j)  (2304 + 64 * (j))
#define XB_TOP      3328
#define XB_TOPGEN   3392
#define XCD_BAR_WORDS 3456
#define XB_SPIN_CAP (1u << 18)

__device__ __forceinline__ unsigned xb_ld(unsigned* p)              { return __hip_atomic_load(p, __ATOMIC_RELAXED, __HIP_MEMORY_SCOPE_AGENT); }
__device__ __forceinline__ unsigned xb_add(unsigned* p, unsigned v) { return __hip_atomic_fetch_add(p, v, __ATOMIC_RELAXED, __HIP_MEMORY_SCOPE_AGENT); }
__device__ __forceinline__ unsigned xb_xcc_id() { return (unsigned)__builtin_amdgcn_s_getreg((3 << 11) | 20) & 0xFu; }
#define XB_SPIN(cond, bar) do { unsigned _sp = 0; while (cond) { __builtin_amdgcn_s_sleep(1); \
    if ((++_sp & 255u) == 0u) { if (xb_ld(&(bar)[XB_TMO])) break; if (_sp > XB_SPIN_CAP) { atomicAdd(&(bar)[XB_TMO], 1u); break; } } } } while (0)

struct XcdBarrier {
    unsigned* bar; unsigned x;
    volatile LAS unsigned* st;
};

__device__ __forceinline__ XcdBarrier xcd_barrier_post(unsigned* bar, volatile LAS unsigned* st) {
    XcdBarrier b; b.bar = bar; b.x = xb_xcc_id(); b.st = st;
    if (threadIdx.x == 0) (void)xb_add(&bar[XB_XCNT(b.x)], 1u);
    return b;
}
__device__ __forceinline__ void xcd_barrier_complete(unsigned* bar, unsigned x, unsigned& nloc, unsigned& nx) {
    const unsigned G = gridDim.x * gridDim.y * gridDim.z;
    unsigned sum, cnt, mine, sp = 0u;
    for (;;) {
        sum = 0u; cnt = 0u; mine = 0u;
#pragma unroll
        for (unsigned j = 0; j < 16; ++j) { const unsigned c = xb_ld(&bar[XB_XCNT(j)]); sum += c; cnt += (c > 0u) ? 1u : 0u; mine = (j == x) ? c : mine; }
        if (sum == G) break;
        __builtin_amdgcn_s_sleep(1);
        if ((++sp & 255u) == 0u) { if (xb_ld(&bar[XB_TMO])) break; if (sp > XB_SPIN_CAP) { atomicAdd(&bar[XB_TMO], 1u); break; } }
    }
    nloc = mine > 0u ? mine : 1u; nx = cnt > 0u ? cnt : 1u;
}

__device__ __forceinline__ void xcd_barrier(const XcdBarrier& b) {
    asm volatile("s_waitcnt vmcnt(0)" ::: "memory");
    __syncthreads();
    if (threadIdx.x == 0) {
        unsigned* bar = b.bar;
        __builtin_amdgcn_s_waitcnt(0);
        unsigned nloc = b.st[0], nx = b.st[1];
        if (nloc == 0u) { xcd_barrier_complete(bar, b.x, nloc, nx); b.st[0] = nloc; b.st[1] = nx; }
        const unsigned old = xb_add(&bar[XB_XSUB(b.x)], 1u);
        const unsigned gen = old / nloc;
        if (old + 1u == (gen + 1u) * nloc) {
            __builtin_amdgcn_fence(__ATOMIC_RELEASE, "agent");
            asm volatile("s_waitcnt vmcnt(0)" ::: "memory");
            const unsigned og = xb_add(&bar[XB_TOP], 1u);
            const unsigned tg = og / nx;
            if (og + 1u == (tg + 1u) * nx) xb_add(&bar[XB_TOPGEN], 1u);
            else XB_SPIN(xb_ld(&bar[XB_TOPGEN]) == tg, bar);
            __builtin_amdgcn_fence(__ATOMIC_ACQUIRE, "agent");
            xb_add(&bar[XB_XGEN(b.x)], 1u);
            asm volatile("s_waitcnt vmcnt(0)" ::: "memory");
        } else {
            XB_SPIN(xb_ld(&bar[XB_XGEN(b.x)]) == gen, bar);
            __builtin_amdgcn_fence(__ATOMIC_ACQUIRE, "agent");
            asm volatile("s_waitcnt vmcnt(0)" ::: "memory");
        }
    }
    __syncthreads();
}

namespace att {
typedef short bf16x8 __attribute__((ext_vector_type(8)));
typedef short s16x4 __attribute__((ext_vector_type(4)));
typedef float f32x4 __attribute__((ext_vector_type(4)));
typedef unsigned u32x2 __attribute__((ext_vector_type(2)));
typedef LAS const char* lptr;
constexpr float NEG = -INFINITY;
__device__ __forceinline__ int fK(int t) { return (t >> 1) & 7; }
__device__ __forceinline__ int fV(int t) { return (((t >> 1) & 3) << 1) | ((t >> 3) & 1); }
__device__ __forceinline__ s16x4 vtr(lptr p) { typedef short v4i16_t __attribute__((ext_vector_type(4))); return __builtin_bit_cast(s16x4, __builtin_amdgcn_ds_read_tr16_b64_v4i16((LAS v4i16_t*)p)); }
__device__ __forceinline__ unsigned cvtpk(float lo, float hi) { unsigned r; asm volatile("v_cvt_pk_bf16_f32 %0, %1, %2" : "=v"(r) : "v"(lo), "v"(hi)); return r; }
__device__ __forceinline__ float xor16(float v) { return __builtin_bit_cast(float, __builtin_amdgcn_ds_swizzle(__builtin_bit_cast(int, v), 0x401F)); }
__device__ __forceinline__ float max4(float v) { v = __builtin_fmaxf(v, xor16(v)); return __builtin_fmaxf(v, __shfl_xor(v, 32)); }
__device__ __forceinline__ float sum4(float v) { v += xor16(v); return v + __shfl_xor(v, 32); }

struct Item { bf16x8 q0, q1; f32x4 o0, o1, o2, o3; float m, l; int ka, va; };
__device__ __forceinline__ void item_init(Item& it, float m0, float l0) { it.o0 = it.o1 = it.o2 = it.o3 = (f32x4){0.f, 0.f, 0.f, 0.f}; it.m = m0; it.l = l0; }
__device__ __forceinline__ void item_addr(Item& it, int w0, int lane) {
    const int fr = lane & 15, fq = lane >> 4, rk = w0 + fr, rv = w0 + 4 * fq + (fr >> 2);
    it.ka = rk * 128 + ((fq ^ fK(rk)) << 4);
    it.va = 8192 + rv * 128 + (((((fr & 3) >> 1)) ^ fV(rv)) << 4) + 8 * (fr & 1);
}
__device__ __forceinline__ void half_step(Item& it, lptr slot, f32x4 b0, f32x4 b1) {
    lptr kp = slot + it.ka;
    const bf16x8 k00 = *(const LAS bf16x8*)(kp), k01 = *(const LAS bf16x8*)(kp + 2048);
    lptr kp1 = slot + (it.ka ^ 64);
    const bf16x8 k10 = *(const LAS bf16x8*)(kp1), k11 = *(const LAS bf16x8*)(kp1 + 2048);
    f32x4 s0 = __builtin_amdgcn_mfma_f32_16x16x32_bf16(k00, it.q0, b0, 0, 0, 0);
    f32x4 s1 = __builtin_amdgcn_mfma_f32_16x16x32_bf16(k01, it.q0, b1, 0, 0, 0);
    s0 = __builtin_amdgcn_mfma_f32_16x16x32_bf16(k10, it.q1, s0, 0, 0, 0);
    s1 = __builtin_amdgcn_mfma_f32_16x16x32_bf16(k11, it.q1, s1, 0, 0, 0);
    float mx = __builtin_fmaxf(__builtin_fmaxf(__builtin_fmaxf(s0[0], s0[1]), __builtin_fmaxf(s0[2], s0[3])), __builtin_fmaxf(__builtin_fmaxf(s1[0], s1[1]), __builtin_fmaxf(s1[2], s1[3])));
    if (__builtin_expect(__any(mx > it.m + 8.0f), 0)) {
        mx = max4(mx);
        const float mn = __builtin_fmaxf(it.m, mx), al = __builtin_amdgcn_exp2f(it.m - mn);
        it.m = mn; it.l *= al; it.o0 *= al; it.o1 *= al; it.o2 *= al; it.o3 *= al;
    }
    const float mn = it.m;
#pragma unroll
    for (int e = 0; e < 4; ++e) { s0[e] = __builtin_amdgcn_exp2f(s0[e] - mn); s1[e] = __builtin_amdgcn_exp2f(s1[e] - mn); }
    it.l += (((s0[0] + s0[1]) + (s0[2] + s0[3])) + ((s1[0] + s1[1]) + (s1[2] + s1[3])));
    typedef unsigned u32x4 __attribute__((ext_vector_type(4)));
    u32x4 pw; pw.x = cvtpk(s0[0], s0[1]); pw.y = cvtpk(s0[2], s0[3]); pw.z = cvtpk(s1[0], s1[1]); pw.w = cvtpk(s1[2], s1[3]);
    const bf16x8 pf = __builtin_bit_cast(bf16x8, pw);
#define ATT_PV(dt, O) do { lptr vp = slot + (it.va ^ ((dt) << 5)); const s16x4 lo = vtr(vp), hi = vtr(vp + 2048); \
        const bf16x8 vf = (bf16x8){lo[0], lo[1], lo[2], lo[3], hi[0], hi[1], hi[2], hi[3]}; O = __builtin_amdgcn_mfma_f32_16x16x32_bf16(vf, pf, O, 0, 0, 0); } while (0)
    ATT_PV(0, it.o0); ATT_PV(1, it.o1); ATT_PV(2, it.o2); ATT_PV(3, it.o3);
#undef ATT_PV
}
__device__ __forceinline__ void item_store(Item& it, bf16* orow, int lane) {
    const float rl = 1.0f / sum4(it.l); const int fq = lane >> 4;
    u32x2 w;
    w.x = cvtpk(it.o0[0] * rl, it.o0[1] * rl); w.y = cvtpk(it.o0[2] * rl, it.o0[3] * rl); *(u32x2*)(orow + 0 + 4 * fq) = w;
    w.x = cvtpk(it.o1[0] * rl, it.o1[1] * rl); w.y = cvtpk(it.o1[2] * rl, it.o1[3] * rl); *(u32x2*)(orow + 16 + 4 * fq) = w;
    w.x = cvtpk(it.o2[0] * rl, it.o2[1] * rl); w.y = cvtpk(it.o2[2] * rl, it.o2[3] * rl); *(u32x2*)(orow + 32 + 4 * fq) = w;
    w.x = cvtpk(it.o3[0] * rl, it.o3[1] * rl); w.y = cvtpk(it.o3[2] * rl, it.o3[3] * rl); *(u32x2*)(orow + 48 + 4 * fq) = w;
}
__device__ __forceinline__ void glds16(const void* gsrc, unsigned lds_dst) { unsigned keep;
    asm volatile("s_mov_b32 %0, m0\n\ts_mov_b32 m0, %2\n\ts_nop 0\n\tglobal_load_lds_dwordx4 %1, off\n\ts_mov_b32 m0, %0" : "=&s"(keep) : "v"(gsrc), "s"(lds_dst) : "memory"); }
__device__ __forceinline__ unsigned lds_u32(LAS unsigned char* p) { return (unsigned)__builtin_amdgcn_readfirstlane((int)(unsigned)(uintptr_t)p); }
#define ATT_WAITV(n) asm volatile("s_waitcnt vmcnt(" #n ")" ::: "memory")
#define ATT_BAR() do { asm volatile("s_waitcnt lgkmcnt(0)" ::: "memory"); __builtin_amdgcn_s_barrier(); asm volatile("" ::: "memory"); } while (0)
__device__ __forceinline__ void wait_vm(int n) {
    if (n >= 31) ATT_WAITV(31); else if (n >= 28) ATT_WAITV(28); else if (n >= 25) ATT_WAITV(25); else if (n >= 22) ATT_WAITV(22); else if (n >= 19) ATT_WAITV(19); else if (n >= 16) ATT_WAITV(16);
    else if (n >= 10) ATT_WAITV(10); else if (n >= 9) ATT_WAITV(9); else if (n >= 8) ATT_WAITV(8); else if (n >= 6) ATT_WAITV(6); else if (n >= 4) ATT_WAITV(4); else if (n >= 3) ATT_WAITV(3); else if (n >= 2) ATT_WAITV(2); else ATT_WAITV(0);
}

constexpr int NA_SLOT = 24576, NA_NS = 5, NA_PD = 3, NA_TBL = NA_NS * NA_SLOT;
struct NaCtx { LAS unsigned char* L; const bf16 *Q, *Kh, *Vh; bf16* O; const float* rpb; int tid, lane, wid, fr, fq, tok, cp; };
__device__ __forceinline__ void na_item_cols(int ct, int fr, int fq, int lane, Item& it, int& tbi, f32x4 (&mk)[2]) {
    const int w0 = ct == 0 ? 0 : ct == 1 ? 8 : ct == 2 ? 24 : 32, c = ct * 16 + fr; int cs = c - KC / 2; cs = cs < 0 ? 0 : (cs > GW - KC ? GW - KC : cs);
    item_addr(it, w0, lane); tbi = 16 + w0 + 4 * fq - c + 15;
    const int dl = w0 + 4 * fq - cs;
#pragma unroll
    for (int kt = 0; kt < 2; ++kt)
#pragma unroll
        for (int e = 0; e < 4; ++e) { const int x = dl + 16 * kt + e; mk[kt][e] = (x >= 0 && x <= 15) ? 0.f : NEG; }
}
__device__ __forceinline__ void na_table(const NaCtx& c, int h) {
    LAS float* tb = (LAS float*)(c.L + NA_TBL);
    for (int i = c.tid; i < 15 * 64; i += 512) { const int dr = i >> 6, ix = i & 63, dc = ix - 16; const float v = (dc >= 0 && dc < 31) ? c.rpb[(h * 15 + dr) * 31 + dc] * LOG2E : 0.f;
        tb[i] = v; tb[15 * 64 + i] = (ix >= 23 && ix <= 38) ? v : NEG; }
}
__device__ __forceinline__ void na_edge(const NaCtx& c, int b, int h, int r0, int klo) {
    LAS unsigned char* L = c.L; LAS float* tb = (LAS float*)(L + NA_TBL); const int wid = c.wid; int lane = c.lane; asm volatile("" : "+v"(lane));
    const int fr = lane & 15, fq = lane >> 4;
    const size_t plane = ((size_t)(b * NH + h) * SEQ) * HD;
    const bf16* ksrc = c.Kh + plane + (size_t)klo * GW * HD + c.tok * HD + ((c.cp ^ fK(c.tok)) << 3); const bf16* vsrc = c.Vh + plane + (size_t)klo * GW * HD + c.tok * HD + ((c.cp ^ fV(c.tok)) << 3);
    ATT_BAR();
    for (int t = 0; t < NA_PD; ++t) { const unsigned d = lds_u32(L + t * NA_SLOT + wid * 1024); glds16(ksrc + (size_t)t * GW * HD, d); glds16(vsrc + (size_t)t * GW * HD, d + 8192u); }
    na_table(c, h);
    const int r = r0 + (wid >> 1);
    Item it[2]; int tbi[2]; f32x4 mk[2][2];
#pragma unroll
    for (int i = 0; i < 2; ++i) { const int ct = 2 * (wid & 1) + i;
        const bf16* qp = c.Q + ((size_t)b * SEQ + (size_t)r * GW + ct * 16 + fr) * D + h * HD + 8 * fq;
        it[i].q0 = *(const bf16x8*)qp; it[i].q1 = *(const bf16x8*)(qp + 32);
        item_init(it[i], -1e30f, 0.f); na_item_cols(ct, fr, fq, lane, it[i], tbi[i], mk[i]); }
    __builtin_amdgcn_s_waitcnt(0x0F70);
    for (int t = 0; t < KR; ++t) {
        if (t + NA_PD < KR) { const unsigned d = lds_u32(L + ((t + NA_PD) % NA_NS) * NA_SLOT + wid * 1024); glds16(ksrc + (size_t)(t + NA_PD) * GW * HD, d); glds16(vsrc + (size_t)(t + NA_PD) * GW * HD, d + 8192u); }
        wait_vm(2 * (KR - 1 - t < NA_PD ? KR - 1 - t : NA_PD));
        ATT_BAR();
        lptr slot = (lptr)(L + (t % NA_NS) * NA_SLOT); const int dr = klo + t - r + KR - 1;
#pragma unroll
        for (int i = 0; i < 2; ++i) { const LAS float* bp = tb + dr * 64 + tbi[i]; f32x4 b0, b1;
#pragma unroll
            for (int e = 0; e < 4; ++e) { b0[e] = bp[e] + mk[i][0][e]; b1[e] = bp[16 + e] + mk[i][1][e]; }
            half_step(it[i], slot, b0, b1); }
    }
#pragma unroll
    for (int i = 0; i < 2; ++i) { const int cc = (2 * (wid & 1) + i) * 16 + fr; item_store(it[i], c.O + ((size_t)b * SEQ + (size_t)r * GW + cc) * D + h * HD, lane); }
    __builtin_amdgcn_s_waitcnt(0x0F70);
}
__device__ __forceinline__ void na_strip(const NaCtx& c, int b, int h, int ra, int rb) {
    LAS unsigned char* L = c.L; LAS float* tb = (LAS float*)(L + NA_TBL); const int wid = c.wid; int lane = c.lane; asm volatile("" : "+v"(lane));
    const int fr = lane & 15, fq = lane >> 4;
    const int klo = ra - 4, nt = rb - ra + 7;
    const size_t plane = ((size_t)(b * NH + h) * SEQ) * HD;
    const bf16* ksrc = c.Kh + plane + (size_t)klo * GW * HD + c.tok * HD + ((c.cp ^ fK(c.tok)) << 3); const bf16* vsrc = c.Vh + plane + (size_t)klo * GW * HD + c.tok * HD + ((c.cp ^ fV(c.tok)) << 3);
    const bf16* qsrc = c.Q + ((size_t)b * SEQ + c.tok) * D + h * HD + ((c.cp ^ fK(c.tok)) << 3);
#define NA_DMA(step) do { const int s_ = (step); const unsigned d = lds_u32(L + (s_ % NA_NS) * NA_SLOT + wid * 1024); int rq = ra + s_; rq = rq < rb ? rq : rb - 1; \
        glds16(ksrc + (size_t)s_ * GW * HD, d); glds16(vsrc + (size_t)s_ * GW * HD, d + 8192u); glds16(qsrc + (size_t)rq * GW * D, d + 16384u); } while (0)
    ATT_BAR();
    for (int t = 0; t < NA_PD; ++t) NA_DMA(t);
    na_table(c, h);
    Item it[4]; int tbi[4]; f32x4 mk[2][2];
#pragma unroll
    for (int i = 0; i < 4; ++i) { f32x4 dummy[2]; na_item_cols(i, fr, fq, lane, it[i], tbi[i], (i == 0 || i == 3) ? mk[i == 3] : dummy); item_init(it[i], -1e30f, 0.f); it[i].q0 = it[i].q1 = (bf16x8){0, 0, 0, 0, 0, 0, 0, 0}; }
    __builtin_amdgcn_s_waitcnt(0x0F70);
    for (int t = 0; t < nt; ++t) {
        if (t + NA_PD < nt) NA_DMA(t + NA_PD);
        const int j = t - wid, ph = j & 7, r = ra + t - ph;
        if (!(j >= 8 && ph < 2)) wait_vm(3 * (nt - 1 - t < NA_PD ? nt - 1 - t : NA_PD));
        ATT_BAR();
        if (j >= 0 && r < rb) {
            lptr slot = (lptr)(L + (t % NA_NS) * NA_SLOT);
            if (ph == 0) {
#pragma unroll
                for (int i = 0; i < 4; ++i) { const int rk = i * 16 + fr; lptr qp = slot + 16384 + rk * 128; const int sw = fq ^ fK(rk);
                    it[i].q0 = *(const LAS bf16x8*)(qp + (sw << 4)); it[i].q1 = *(const LAS bf16x8*)(qp + ((sw ^ 4) << 4)); item_init(it[i], -1e30f, 0.f); }
            }
            const LAS float* tbr = tb + (ph + 3) * 64;
#pragma unroll
            for (int i = 0; i < 4; ++i) { const LAS float* bp = tbr + tbi[i] + ((i == 1 || i == 2) ? 15 * 64 : 0); f32x4 b0, b1;
#pragma unroll
                for (int e = 0; e < 4; ++e) { b0[e] = bp[e]; b1[e] = bp[16 + e]; if (i == 0 || i == 3) { b0[e] += mk[i == 3][0][e]; b1[e] += mk[i == 3][1][e]; } }
                half_step(it[i], slot, b0, b1);
                if (i == 1) __builtin_amdgcn_sched_barrier(0); }
            if (ph == 7) {
                wait_vm(t + 3 < nt ? 3 : 0);
#pragma unroll
                for (int i = 0; i < 4; ++i) item_store(it[i], c.O + ((size_t)b * SEQ + (size_t)r * GW + i * 16 + fr) * D + h * HD, lane);
            }
        }
    }
#undef NA_DMA
    __builtin_amdgcn_s_waitcnt(0x0F70);
}
__device__ __forceinline__ void na_phase(LAS unsigned char* L, const bf16* Q, const bf16* Kh, const bf16* Vh, bf16* O, const float* rpb, int vcu, int G) {
    NaCtx c; c.L = L; c.Q = Q; c.Kh = Kh; c.Vh = Vh; c.O = O; c.rpb = rpb; c.tid = threadIdx.x; c.lane = c.tid & 63; c.wid = __builtin_amdgcn_readfirstlane(c.tid >> 6); c.fr = c.lane & 15; c.fq = c.lane >> 4;
    c.tok = c.wid * 8 + (c.lane >> 3); c.cp = c.lane & 7;
    for (int task = vcu; task < BATCH * NH * 4; task += G) {
        const int qd = task & 3, h = (task >> 2) % NH, b = task / (4 * NH);
        if (qd == 0) na_edge(c, b, h, 0, 0);
        na_strip(c, b, h, qd == 0 ? 4 : qd == 1 ? 30 : qd == 2 ? 64 : 98, qd == 0 ? 30 : qd == 1 ? 64 : qd == 2 ? 98 : ROWS - 4);
        if (qd == 3) na_edge(c, b, h, ROWS - 4, ROWS - KR);
    }
}

constexpr int SW_SLOT = 16384, SW_NS = 7, SW_TBL = SW_NS * SW_SLOT;
__device__ __forceinline__ void swa_phase(LAS unsigned char* L, const bf16* Q, const bf16* Kh, const bf16* Vh, bf16* O, const float* tblg, int vcu, int G) {
    const int tid = threadIdx.x, lane = tid & 63, wid = __builtin_amdgcn_readfirstlane(tid >> 6), fr = lane & 15, fq = lane >> 4;
    LAS float* tb = (LAS float*)(L + SW_TBL);
    const int tok = wid * 8 + (lane >> 3), cp = lane & 7;
    constexpr int NQB = SEQ / 64, QPT = 8, NTASK = BATCH * KVH * (NQB / QPT);
    for (int task = vcu; task < NTASK; task += G) {
        const int q0 = (task % (NQB / QPT)) * QPT, kv = (task / (NQB / QPT)) % KVH, b = task / (NQB / QPT * KVH);
        const size_t plane = ((size_t)(b * KVH + kv) * SEQ) * HD;
        const bf16* ksrc = Kh + plane + tok * HD + ((cp ^ fK(tok)) << 3); const bf16* vsrc = Vh + plane + tok * HD + ((cp ^ fV(tok)) << 3);
        const int cmax = q0 + QPT + 1 > NQB - 1 ? NQB - 1 : q0 + QPT + 1;
#define SW_DMA(ch) do { const int c_ = (ch); if (c_ >= 0 && c_ <= cmax) { const unsigned d = lds_u32(L + (c_ % SW_NS) * SW_SLOT + wid * 1024); glds16(ksrc + (size_t)c_ * 64 * HD, d); glds16(vsrc + (size_t)c_ * 64 * HD, d + 8192u); } } while (0)
        ATT_BAR();
        for (int ch = q0 - 2; ch <= q0 + 3; ++ch) SW_DMA(ch);
        for (int i = tid; i < 4 * 384; i += 512) { const int g = i / 384, rel = i % 384 - 192; tb[i] = (rel >= -WINDOW && rel <= WINDOW) ? tblg[(kv * 4 + g) * 257 + rel + WINDOW] : NEG; }
        const int g = wid >> 1, hq = kv * 4 + g; const float sink2 = tblg[16 * 257 + hq];
        Item it[2]; int tbi[2]; bf16x8 qn[2][2];
        const bf16* qbase = Q + ((size_t)b * SEQ + fr) * D + hq * HD + 8 * fq;
#pragma unroll
        for (int i = 0; i < 2; ++i) { const int qt = 2 * (wid & 1) + i; const bf16* qp = qbase + (size_t)(64 * q0 + 16 * qt) * D;
            qn[i][0] = *(const bf16x8*)qp; qn[i][1] = *(const bf16x8*)(qp + 32);
            item_addr(it[i], 0, lane); tbi[i] = g * 384 + 192 + 4 * fq - 16 * qt - fr; }
        __builtin_amdgcn_s_waitcnt(0x0F70);
        for (int qb = q0; qb < q0 + QPT; ++qb) {
            ATT_BAR();
            if (qb > q0) SW_DMA(qb + 3);
#pragma unroll
            for (int i = 0; i < 2; ++i) { it[i].q0 = qn[i][0]; it[i].q1 = qn[i][1]; item_init(it[i], sink2, fq == 0 ? 1.f : 0.f); }
            if (qb + 1 < q0 + QPT) {
#pragma unroll
                for (int i = 0; i < 2; ++i) { const int qt = 2 * (wid & 1) + i; const bf16* qp = qbase + (size_t)(64 * (qb + 1) + 16 * qt) * D; qn[i][0] = *(const bf16x8*)qp; qn[i][1] = *(const bf16x8*)(qp + 32); }
            }
            const int clo = qb - 2 < 0 ? 0 : qb - 2, chi_ = qb + 2 > NQB - 1 ? NQB - 1 : qb + 2;
#ifdef PROBE_SW
            unsigned long long pt0 = 0, pc0 = 0; if (qb == q0 + 1 || qb == q0 + 6) { pt0 = __builtin_amdgcn_s_memrealtime(); pc0 = __builtin_amdgcn_s_memtime(); }
#endif
            for (int cb = clo; cb <= chi_; ++cb) {
                lptr slot = (lptr)(L + (cb % SW_NS) * SW_SLOT);
#pragma unroll
                for (int hs = 0; hs < 2; ++hs)
#pragma unroll
                    for (int i = 0; i < 2; ++i) { const int qt = 2 * (wid & 1) + i, k0 = 64 * cb + 32 * hs, tq0 = 64 * qb + 16 * qt;
                        if (k0 + 31 >= tq0 - WINDOW && k0 <= tq0 + 15 + WINDOW) {
                            const LAS float* bp = tb + tbi[i] + 64 * (cb - qb) + 32 * hs; f32x4 b0, b1;
#pragma unroll
                            for (int e = 0; e < 4; ++e) { b0[e] = bp[e]; b1[e] = bp[16 + e]; }
                            half_step(it[i], slot + hs * 4096, b0, b1); } }
            }
#ifdef PROBE_SW
            if (qb == q0 + 1 || qb == q0 + 6) { asm volatile("" :: "v"(it[0].o0), "v"(it[1].o0)); const unsigned long long pt1 = __builtin_amdgcn_s_memrealtime(), pc1 = __builtin_amdgcn_s_memtime();
                if (blockIdx.x == 0 && tid == 0 && task == vcu) { volatile LAS unsigned* MI = (volatile LAS unsigned*)(L + 131072 + 320); MI[qb == q0 + 1 ? 40 : 41] = (unsigned)((pc1 - pc0) * 100 / (pt1 - pt0)); } }
#endif
            __builtin_amdgcn_s_waitcnt(0x0F70);
#pragma unroll
            for (int i = 0; i < 2; ++i) { const int qt = 2 * (wid & 1) + i; item_store(it[i], O + ((size_t)b * SEQ + (size_t)qb * 64 + qt * 16 + fr) * D + hq * HD, lane); }
        }
#undef SW_DMA
    }
}
#undef ATT_WAITV
#undef ATT_BAR
}

#ifndef PG8_SP2
#define PG8_SP2 true
#endif
#ifndef PG8_ALIGN
#define PG8_ALIGN true
#endif
#ifndef MK_N_LAUNCHES
#define MK_N_LAUNCHES 1
#endif
constexpr int NWAVES = 8;
constexpr int RING_OFF = 0, RING_BYTES = 131072, LDSCTL_OFF = RING_BYTES, MISC_OFF = LDSCTL_OFF + 320, LDS_BYTES = 147456;
constexpr int CW_BAR = 4096;
constexpr int NPHASE = 12;

__device__ __forceinline__ void p0_transpose_item(const float* W, const float* g, int K, int N, bf16* WT, LAS float* scr, int item, int lane) {
    const int nblk = N / 32, kb = item / nblk, nb = item % nblk, k0 = 64 * kb, n0 = 32 * nb;
    float wv[32];
#pragma unroll
    for (int i = 0; i < 32; ++i) { const int kk = 2 * i + (lane >> 5); wv[i] = W[(size_t)(k0 + kk) * N + n0 + (lane & 31)]; }
#pragma unroll
    for (int i = 0; i < 32; ++i) { const int kk = 2 * i + (lane >> 5); scr[kk * 33 + (lane & 31)] = wv[i] * (g ? g[k0 + kk] : 1.0f); }
    LDS_WAIT(); asm volatile("" ::: "memory");
    const int c = lane & 7;
#pragma unroll
    for (int j = 0; j < 4; ++j) { const int n = (lane >> 3) + 8 * j; const LAS float* s = scr + (8 * c) * 33 + n;
        v4u o; o.x = pk2(s[0 * 33], s[1 * 33]); o.y = pk2(s[2 * 33], s[3 * 33]); o.z = pk2(s[4 * 33], s[5 * 33]); o.w = pk2(s[6 * 33], s[7 * 33]);
        *(GAS v4u*)(WT + (size_t)(n0 + n) * K + k0 + 8 * c) = o; }
    LDS_WAIT(); asm volatile("" ::: "memory");
}

struct Args { const float* in[13]; float* out; unsigned char* ws; int ph_lo, ph_hi; };
__global__ void __launch_bounds__(NWAVES * 64, 2) mk_fwd(Args args) {
    extern __shared__ __attribute__((aligned(16))) unsigned char lds[];
    LAS unsigned char* L = (LAS unsigned char*)lds;
    volatile LAS unsigned* MISC = (volatile LAS unsigned*)(L + MISC_OFF);
    const int tid = threadIdx.x, lane = tid & 63, wave = __builtin_amdgcn_readfirstlane(tid >> 6);
    unsigned char* ws = args.ws;
    gu32* ctl = (gu32*)(ws + WS_CTL);
    float* ssqA = (float*)(ws + WS_SSQ); float* ssqB = (float*)(ws + WS_SSQ2); float* tblg = (float*)(ws + WS_TBL);
    bf16 *Wqkv0 = (bf16*)(ws + WS_WQKV0), *Wo0 = (bf16*)(ws + WS_WO0), *Win0 = (bf16*)(ws + WS_WIN0), *Wout0 = (bf16*)(ws + WS_WOUT0);
    bf16 *Wqkv1 = (bf16*)(ws + WS_WQKV1), *Wo1 = (bf16*)(ws + WS_WO1), *Win1 = (bf16*)(ws + WS_WIN1), *Wout1 = (bf16*)(ws + WS_WOUT1);
    bf16 *XB = (bf16*)(ws + WS_XB), *Qb = (bf16*)(ws + WS_Q), *Kb = (bf16*)(ws + WS_K), *Vb = (bf16*)(ws + WS_V), *Hb = (bf16*)(ws + WS_H);
    const float* x = args.in[0]; float* out = args.out;
    const int G = gridDim.x; int vcu; { const int bx = blockIdx.x; vcu = (G % 8 == 0) ? (bx % 8) * (G / 8) + bx / 8 : bx; }
    for (int u = tid; u < (LDS_BYTES - LDSCTL_OFF) / 4; u += NWAVES * 64) ((LAS unsigned*)(L + LDSCTL_OFF))[u] = 0u;
    __syncthreads();
    XcdBarrier bar; bar.bar = (unsigned*)(ctl + CW_BAR); bar.x = 0; bar.st = nullptr;
    if (MK_N_LAUNCHES == 1) bar = xcd_barrier_post((unsigned*)(ctl + CW_BAR), MISC + 8);
    const int lo = args.ph_lo, hi = args.ph_hi;
#define IN(k) (lo <= (k) && (k) < hi)
#ifndef PROBE_SCALE
#define PROBE_SCALE 0.01f
#endif
#ifdef PROBE_A
#define STAMP(k) do { if (blockIdx.x == 0 && tid == 0) MISC[16 + (k)] = (unsigned)__builtin_amdgcn_s_memrealtime(); } while (0)
#else
#define STAMP(k) do {} while (0)
#endif
#ifdef PROBE_BAR
#define SEAM(k) do { if (IN(k) && IN((k) + 1)) { const unsigned long long b0_ = __builtin_amdgcn_s_memrealtime(); xcd_barrier(bar); if (blockIdx.x == PROBE_BAR && tid == 0) { MISC[40] += (unsigned)(__builtin_amdgcn_s_memrealtime() - b0_); MISC[42 + (k)] = (unsigned)(__builtin_amdgcn_s_memrealtime() - b0_); } } STAMP((k) + 1); } while (0)
#else
#define SEAM(k) do { if (IN(k) && IN((k) + 1)) xcd_barrier(bar); STAMP((k) + 1); } while (0)
#endif
    STAMP(0);

    if (IN(0)) {
        LAS float* scr = (LAS float*)(L + RING_OFF + wave * 16384);
        const int gw = vcu * NWAVES + wave, NGW = G * NWAVES;
        const float *mix_norm = args.in[1], *mlp_norm = args.in[2], *w_in = args.in[11], *w_out = args.in[12];
        constexpr int I_QKV0 = (D / 64) * (3072 / 32), I_O = (D / 64) * (D / 32), I_IN = (D / 64) * (FF / 32), I_OUT = (FF / 64) * (D / 32), I_QKV1 = (D / 64) * (1536 / 32);
        constexpr int NITEMS = I_QKV0 + I_QKV1 + 2 * (I_O + I_IN + I_OUT);
        for (int it = gw; it < NITEMS; it += NGW) {
            int r = it;
            if (r < I_QKV0) { p0_transpose_item(args.in[4], mix_norm, D, 3072, Wqkv0, scr, r, lane); continue; } r -= I_QKV0;
            if (r < I_O) { p0_transpose_item(args.in[6], nullptr, D, D, Wo0, scr, r, lane); continue; } r -= I_O;
            if (r < I_IN) { p0_transpose_item(w_in, mlp_norm, D, FF, Win0, scr, r, lane); continue; } r -= I_IN;
            if (r < I_OUT) { p0_transpose_item(w_out, nullptr, FF, D, Wout0, scr, r, lane); continue; } r -= I_OUT;
            if (r < I_QKV1) { p0_transpose_item(args.in[7], mix_norm + D, D, 1536, Wqkv1, scr, r, lane); continue; } r -= I_QKV1;
            if (r < I_O) { p0_transpose_item(args.in[9], nullptr, D, D, Wo1, scr, r, lane); continue; } r -= I_O;
            if (r < I_IN) { p0_transpose_item(w_in + (size_t)D * FF, mlp_norm + D, D, FF, Win1, scr, r, lane); continue; } r -= I_IN;
            p0_transpose_item(w_out + (size_t)D * FF, nullptr, FF, D, Wout1, scr, r, lane);
        }
        for (int i = vcu * (NWAVES * 64) + tid; i < 16 * 257 + 16; i += G * NWAVES * 64) {
            if (i < 16 * 257) { const int h = i / 257, rel = i % 257 - 128; const int n = rel < 0 ? -rel : rel; int bk;
                if (n < 8) bk = n; else { const int k = (31 - __clz(n * n)) - 6; bk = 8 + (k < 7 ? k : 7); }
                if (rel > 0) bk += 16;
                tblg[i] = args.in[10][bk * 16 + h] * LOG2E; }
            else tblg[i] = args.in[8][i - 16 * 257] * LOG2E;
        }
        for (int m0 = gw * 4; m0 < M; m0 += NGW * 4) {
            f32x4 v[4][4];
#pragma unroll
            for (int r = 0; r < 4; ++r) { const GAS f32x4* xr = (const GAS f32x4*)(x + (size_t)(m0 + r) * D) + lane;
#pragma unroll
                for (int j = 0; j < 4; ++j) v[r][j] = xr[64 * j]; }
#pragma unroll
            for (int r = 0; r < 4; ++r) { GAS unsigned long long* o8 = (GAS unsigned long long*)(XB + (size_t)(m0 + r) * D) + lane; float s = 0.f;
#pragma unroll
                for (int j = 0; j < 4; ++j) { const f32x4 w = v[r][j]; s += (w.x * w.x + w.y * w.y) + (w.z * w.z + w.w * w.w);
                    o8[64 * j] = (unsigned long long)pk2(w.x, w.y) | ((unsigned long long)pk2(w.z, w.w) << 32); }
                s = wave_sum(s);
                if (lane < 16) ssqB[(size_t)(m0 + r) * 16 + lane] = lane == 0 ? s : 0.f; }
        }
    }
    SEAM(0);
    if (IN(1)) { pg8::Gemm g{XB, Wqkv0, M, 3072, D}; pg8::StaticOrder S; S.init(M, 3072, G, (int)blockIdx.x);
        pg8::EpiQKV E{Qb, Kb, Vb, D, C2, ssqB};
        pg8::gemm_phase<pg8::EpiQKV, pg8::StaticOrder, PG8_ALIGN, PG8_SP2>(L + RING_OFF, g, S, E); }
    SEAM(1);
#ifdef PROBE_NA
    if (IN(2)) { att::na_phase(L + RING_OFF, Qb, Kb, Vb, (bf16*)(ws + 448 * MiB), args.in[5], vcu, G); xcd_barrier(bar); STAMP(13);
                 att::na_phase(L + RING_OFF, Qb, Kb, Vb, (bf16*)(ws + 448 * MiB), args.in[5], vcu, G); xcd_barrier(bar); STAMP(14); }
#endif
    if (IN(2)) att::na_phase(L + RING_OFF, Qb, Kb, Vb, Qb, args.in[5], vcu, G);
    SEAM(2);
    if (IN(3)) { pg8::Gemm g{Qb, Wo0, M, D, D}; pg8::StaticOrder S; S.init(M, D, G, (int)blockIdx.x);
        pg8::EpiRes2<true, false, false> E{x, nullptr, XB, ssqA, nullptr};
        pg8::gemm_phase<pg8::EpiRes2<true, false, false>, pg8::StaticOrder, PG8_ALIGN, PG8_SP2>(L + RING_OFF, g, S, E); }
    SEAM(3);
    if (IN(4)) { pg8::Gemm g{XB, Win0, M, FF, D}; pg8::StaticOrder S; S.init(M, FF, G, (int)blockIdx.x);
        pg8::EpiUp E{Hb};
        pg8::gemm_phase<pg8::EpiUp, pg8::StaticOrder, PG8_ALIGN, PG8_SP2>(L + RING_OFF, g, S, E); }
    SEAM(4);
    if (IN(5)) { pg8::Gemm g{Hb, Wout0, M, D, FF}; pg8::StaticOrder S; S.init(M, D, G, (int)blockIdx.x);
        pg8::EpiRes2<false, false, true> E{nullptr, nullptr, XB, ssqB, ssqA};
        pg8::gemm_phase<pg8::EpiRes2<false, false, true>, pg8::StaticOrder, PG8_ALIGN, PG8_SP2>(L + RING_OFF, g, S, E); }
    SEAM(5);
    if (IN(6)) { pg8::Gemm g{XB, Wqkv1, M, 1536, D}; pg8::StaticOrder S; S.init(M, 1536, G, (int)blockIdx.x);
        pg8::EpiQKV E{Qb, Kb, Vb, 256, C2, ssqB};
        pg8::gemm_phase<pg8::EpiQKV, pg8::StaticOrder, PG8_ALIGN, PG8_SP2>(L + RING_OFF, g, S, E); }
    SEAM(6);
    if (IN(7)) att::swa_phase(L + RING_OFF, Qb, Kb, Vb, Qb, tblg, vcu, G);
    SEAM(7);
    if (IN(8)) { pg8::Gemm g{Qb, Wo1, M, D, D}; pg8::StaticOrder S; S.init(M, D, G, (int)blockIdx.x);
        pg8::EpiRes2<false, false, false> E{nullptr, nullptr, XB, ssqA, nullptr};
        pg8::gemm_phase<pg8::EpiRes2<false, false, false>, pg8::StaticOrder, PG8_ALIGN, PG8_SP2>(L + RING_OFF, g, S, E); }
    SEAM(8);
    if (IN(9)) { pg8::Gemm g{XB, Win1, M, FF, D}; pg8::StaticOrder S; S.init(M, FF, G, (int)blockIdx.x);
        pg8::EpiUp E{Hb};
        pg8::gemm_phase<pg8::EpiUp, pg8::StaticOrder, PG8_ALIGN, PG8_SP2>(L + RING_OFF, g, S, E); }
    SEAM(9);
    if (IN(10)) { pg8::Gemm g{Hb, Wout1, M, D, FF}; pg8::StaticOrder S; S.init(M, D, G, (int)blockIdx.x);
        pg8::EpiRes2<false, false, true> E{nullptr, nullptr, XB, ssqB, ssqA};
        pg8::gemm_phase<pg8::EpiRes2<false, false, true>, pg8::StaticOrder, PG8_ALIGN, PG8_SP2>(L + RING_OFF, g, S, E); }
    SEAM(10);
    if (IN(11)) {
        const int gw = vcu * NWAVES + wave, NGW = G * NWAVES; const GAS f32x4* gr = (const GAS f32x4*)args.in[3] + lane;
        const f32x4 g0 = gr[0], g1 = gr[64], g2 = gr[128], g3 = gr[192];
        for (int m0 = gw * 4; m0 < M; m0 += NGW * 4) {
            unsigned long long w[4][4]; float r[4];
#pragma unroll
            for (int q = 0; q < 4; ++q) { const GAS unsigned long long* xr = (const GAS unsigned long long*)(XB + (size_t)(m0 + q) * D) + lane; r[q] = pg8::rstd16(ssqB, m0 + q);
                w[q][0] = xr[0]; w[q][1] = xr[64]; w[q][2] = xr[128]; w[q][3] = xr[192]; }
#pragma unroll
            for (int q = 0; q < 4; ++q) { GAS f32x4* xo = (GAS f32x4*)(out + (size_t)(m0 + q) * D) + lane;
#pragma unroll
                for (int j = 0; j < 4; ++j) { const unsigned lo = (unsigned)w[q][j], hi = (unsigned)(w[q][j] >> 32);
                    const f32x4 v = (f32x4){__builtin_bit_cast(float, lo << 16), __builtin_bit_cast(float, lo & 0xffff0000u), __builtin_bit_cast(float, hi << 16), __builtin_bit_cast(float, hi & 0xffff0000u)};
                    const f32x4 gg = j == 0 ? g0 : j == 1 ? g1 : j == 2 ? g2 : g3; xo[64 * j] = v * r[q] * gg; } }
        }
    }
#ifdef PROBE_A
    xcd_barrier(bar); STAMP(12);
    if (blockIdx.x == 0) { __syncthreads();
        #if defined(PROBE_BAR)
        const float ta = (float)MISC[40] * 0.01f, tb2 = (float)MISC[42 + PROBE_BARK] * 0.01f;
#elif defined(PROBE_GEMM)
        const float ta = (float)MISC[40] * 0.01f, tb2 = (float)MISC[41] * 0.001f;
#elif defined(PROBE_SW)
        const float ta = (float)MISC[40] * 0.001f, tb2 = (float)MISC[41] * 0.001f;
#elif defined(PROBE_NA)
        const float ta = (float)(MISC[16 + 13] - MISC[16 + 2]) * 0.01f, tb2 = (float)(MISC[16 + 14] - MISC[16 + 13]) * 0.01f;
#else
        const float ta = (float)(MISC[16 + PROBE_A + 1] - MISC[16 + PROBE_A]) * 0.01f, tb2 = (float)(MISC[16 + PROBE_B + 1] - MISC[16 + PROBE_B]) * 0.01f;
#endif
#ifdef PROBE_NOB
        const float tb3 = 0.f;
#else
        const float tb3 = tb2;
#endif
        if (tid == 0) out[0] += ta * PROBE_SCALE;
        out[D + tid] += tb3 * PROBE_SCALE; out[D + 512 + tid] += tb3 * PROBE_SCALE; }
#endif
#undef IN
#undef SEAM
}

extern "C" void kernel_launch(void* const* d_in, const int* in_sizes, int n_in, void* d_out, int out_size, void* d_ws, size_t ws_size, hipStream_t stream) {
    static int grid = 0;
    if (grid == 0) {
        if (n_in != 13 || in_sizes[0] != M * D || out_size != M * D || ws_size < WS_END) { fprintf(stderr, "kernel_launch: unexpected shapes (n_in %d in0 %d out %d ws %zu)\n", n_in, n_in > 0 ? in_sizes[0] : -1, out_size, ws_size); grid = -1; return; }
        int dev = 0, cus = 0, per_cu = 0;
        if (hipGetDevice(&dev) != hipSuccess || hipDeviceGetAttribute(&cus, hipDeviceAttributeMultiprocessorCount, dev) != hipSuccess) { grid = -1; return; }
        if (hipFuncSetAttribute((const void*)mk_fwd, hipFuncAttributeMaxDynamicSharedMemorySize, LDS_BYTES) != hipSuccess) { fprintf(stderr, "kernel_launch: hipFuncSetAttribute failed\n"); grid = -1; return; }
        if (hipOccupancyMaxActiveBlocksPerMultiprocessor(&per_cu, (const void*)mk_fwd, NWAVES * 64, LDS_BYTES) != hipSuccess || per_cu < 1) { fprintf(stderr, "kernel_launch: occupancy query says %d blocks per CU\n", per_cu); grid = -1; (void)hipGetLastError(); return; }
        (void)hipGetLastError();
        grid = cus;
    }
    if (grid < 0) return;
    (void)hipMemsetAsync((unsigned char*)d_ws + WS_CTL, 0, 1 * MiB, stream);
    Args a{}; for (int i = 0; i < 13; ++i) a.in[i] = (const float*)d_in[i]; a.out = (float*)d_out; a.ws = (unsigned char*)d_ws;
#if MK_N_LAUNCHES == 1
    a.ph_lo = 0; a.ph_hi = NPHASE; hipLaunchKernelGGL(mk_fwd, dim3(grid), dim3(NWAVES * 64), LDS_BYTES, stream, a);
#else
    for (int p = 0; p < NPHASE; ++p) { a.ph_lo = p; a.ph_hi = p + 1; hipLaunchKernelGGL(mk_fwd, dim3(grid), dim3(NWAVES * 64), LDS_BYTES, stream, a); }
#endif
}
```
